# Optimizing an MI355X kernel written in HIP

```python
import jax, jax.numpy as jnp
from jax import lax
import numpy as np

D_MODEL = 1024
BATCH = 4
SEQ = 8192
DEPTH = 4

N_MIXERS = 4
D_INNER = D_MODEL
RMS_EPS = 1e-6

RWKV_HEAD = 64
RWKV_HEADS = D_INNER // RWKV_HEAD
RWKV_DECAY_LORA = 64
RWKV_AAA_LORA = 64
RWKV_GN_EPS = 64e-5
RWKV_COLS = 4 * D_INNER + RWKV_DECAY_LORA + RWKV_AAA_LORA
RWKV_SPLITS = (D_INNER, 2 * D_INNER, 3 * D_INNER, 3 * D_INNER + RWKV_DECAY_LORA,
               3 * D_INNER + RWKV_DECAY_LORA + RWKV_AAA_LORA)

HGRN_EXPAND = 128
HGRN_HEADS = D_INNER // HGRN_EXPAND
HGRN_HEAD_V = D_INNER // HGRN_HEADS
HGRN_CHUNK = 32
HGRN_COLS = 4 * D_INNER

CONV_WIDTH = 3
CONV_COLS = 4 * D_INNER

GMLP_CHUNK = 128
GMLP_GROUPS = 8
GMLP_GROUP_CH = D_INNER // GMLP_GROUPS
GMLP_COLS = 3 * D_INNER

N_RWKV = (DEPTH + 3) // 4
N_HGRN = (DEPTH + 2) // 4
N_CONV = (DEPTH + 1) // 4
N_GMLP = DEPTH // 4

kernel_name = "hybrid_rwkv7_hgrn2_shortconv_gmlp_interleaved"


def rmsnorm(x, g):
    xf = x.astype(jnp.float32)
    y = xf * lax.rsqrt(jnp.mean(xf * xf, axis=-1, keepdims=True) + RMS_EPS)
    return (y * g.astype(jnp.float32)).astype(x.dtype)


def shift1(z):
    return jnp.pad(z, ((0, 0), (1, 0), (0, 0)))[:, :-1]


def rwkv7_time_mix(h, w_in, mu, w0, w_w2, a0, w_a2, k_k, k_a, r_k, gn_g, gn_b, w_out):
    B, T, _ = h.shape
    H, N = RWKV_HEADS, RWKV_HEAD
    f32 = jnp.float32
    p = h @ w_in
    p = p + (shift1(p) - p) * mu
    r, k, v, wd, ad, gate = jnp.split(p, RWKV_SPLITS, axis=-1)
    w_log = -jax.nn.softplus(-(w0 + jnp.tanh(wd) @ w_w2).astype(f32)) - 0.5
    decay = jnp.exp(-jnp.exp(w_log))
    a = jax.nn.sigmoid((a0 + ad @ w_a2).astype(f32))
    r = r.astype(f32)
    k = k.astype(f32)
    v = v.astype(f32)
    kk = (k * k_k).reshape(B, T, H, N)
    kk = kk / jnp.maximum(jnp.linalg.norm(kk, axis=-1, keepdims=True), 1e-12)
    k = k * (1.0 + (a - 1.0) * k_a)
    r_h, k_h, v_h, w_h, a_h = (z.reshape(B, T, H, N) for z in (r, k, v, decay, a))
    aa = -kk
    bb = kk * a_h

    def step(S, inp):
        r_t, w_t, k_t, v_t, aa_t, bb_t = inp
        sa = jnp.einsum('bhvk,bhk->bhv', S, aa_t)
        S = S * w_t[:, :, None, :] + sa[..., None] * bb_t[:, :, None, :] + v_t[..., None] * k_t[:, :, None, :]
        return S, jnp.einsum('bhvk,bhk->bhv', S, r_t)

    xs = tuple(jnp.moveaxis(z, 1, 0) for z in (r_h, w_h, k_h, v_h, aa, bb))
    _, y = lax.scan(step, jnp.zeros((B, H, N, N), f32), xs)
    y = jnp.moveaxis(y, 0, 1)
    mean = jnp.mean(y, axis=-1, keepdims=True)
    var = jnp.mean(jnp.square(y - mean), axis=-1, keepdims=True)
    y = ((y - mean) * lax.rsqrt(var + RWKV_GN_EPS)).reshape(B, T, D_INNER) * gn_g + gn_b
    bonus = jnp.sum(r_h * k_h * r_k, axis=-1, keepdims=True) * v_h
    y = (y + bonus.reshape(B, T, D_INNER)) * jax.nn.silu(gate.astype(f32))
    return y.astype(h.dtype) @ w_out


def chunk_gated_linear(q, k, v, g, chunk):
    B, T, H, DK = q.shape
    DV = v.shape[-1]
    NC = T // chunk

    def blk(z):
        return z.reshape(B, NC, chunk, H, z.shape[-1]).transpose(0, 3, 1, 2, 4)

    q, k, v, g = (blk(z.astype(jnp.float32)) for z in (q, k, v, g))
    b = jnp.cumsum(g, axis=3)
    m = b[:, :, :, chunk // 2:chunk // 2 + 1]
    qm = q * jnp.exp(b - m)
    km = k * jnp.exp(m - b)
    att = jnp.einsum('bhnck,bhnsk->bhncs', qm, km)
    causal = jnp.tril(jnp.ones((chunk, chunk), dtype=bool))
    att = jnp.where(causal, att, 0.0)
    o_intra = jnp.einsum('bhncs,bhnsv->bhncv', att, v)
    b_last = b[:, :, :, -1]
    q_in = q * jnp.exp(b)
    k_out = k * jnp.exp(b_last[:, :, :, None, :] - b)

    def step(S, inp):
        q_c, k_c, v_c, d_c = inp
        o = jnp.einsum('bhck,bhkv->bhcv', q_c, S)
        S = S * jnp.exp(d_c)[..., None] + jnp.einsum('bhck,bhcv->bhkv', k_c, v_c)
        return S, o

    xs = tuple(jnp.moveaxis(z, 2, 0) for z in (q_in, k_out, v, b_last))
    _, o_inter = lax.scan(step, jnp.zeros((B, H, DK, DV), jnp.float32), xs)
    o = o_intra + jnp.moveaxis(o_inter, 0, 2)
    return o.transpose(0, 2, 3, 1, 4).reshape(B, T, H, DV)


def hgrn2_mix(h, lb, w_in, gn_g, w_out):
    B, T, _ = h.shape
    f32 = jnp.float32
    p = h @ w_in
    q, f_pre, i_in, gate = jnp.split(p, 4, axis=-1)
    f_pre = f_pre.astype(f32)
    lb = lb.astype(f32)
    log_f = jnp.logaddexp(jnp.log(lb), jnp.log1p(-lb) + jax.nn.log_sigmoid(f_pre))
    k = (1.0 - lb) * jax.nn.sigmoid(-f_pre)
    heads = lambda z: z.reshape(B, T, HGRN_HEADS, -1)
    o = chunk_gated_linear(heads(q), heads(k), heads(i_in), heads(log_f), HGRN_CHUNK)
    o = o * lax.rsqrt(jnp.mean(o * o, axis=-1, keepdims=True) + RMS_EPS)
    o = o.reshape(B, T, D_INNER) * gn_g * jax.nn.silu(gate.astype(f32))
    return o.astype(h.dtype) @ w_out


def hgrn_lower_bound(lb_logits, layer):
    cb = jnp.cumsum(jax.nn.softmax(lb_logits.astype(jnp.float32), axis=0), axis=0)
    return cb[layer] - cb[0]


def short_conv_mix(h, w_in, conv_w, w_out):
    T = h.shape[1]
    p = h @ w_in
    b_gate, c_gate, z, gate = jnp.split(p, 4, axis=-1)
    y = c_gate * z
    yp = jnp.pad(y, ((0, 0), (CONV_WIDTH - 1, 0), (0, 0)))
    yc = sum(conv_w[j] * yp[:, j:j + T] for j in range(CONV_WIDTH))
    return (b_gate * yc * jax.nn.silu(gate)) @ w_out


def gmlp_chunk_mix(h, w_in, v_g, w_s, b_s, w_out):
    B, T, _ = h.shape
    NC = T // GMLP_CHUNK
    p = h @ w_in
    u, v, gate = jnp.split(p, 3, axis=-1)
    v = rmsnorm(v, v_g)
    vb = v.reshape(B, NC, GMLP_CHUNK, GMLP_GROUPS, GMLP_GROUP_CH)
    ws = w_s * jnp.tril(jnp.ones((GMLP_CHUNK, GMLP_CHUNK), w_s.dtype))
    s = jnp.einsum('gts,bnsgc->bntgc', ws, vb) + b_s.T[None, None, :, :, None]
    s = s.reshape(B, T, D_INNER)
    return (u * s * jax.nn.silu(gate)) @ w_out


def setup_inputs(seed: int = 0) -> dict:
    key = jax.random.key(seed)
    ks = iter(jax.random.split(key, 40))
    f32 = jnp.float32

    def nrm(shape, scale):
        return jax.random.normal(next(ks), shape, f32) * scale

    D, DI = D_MODEL, D_INNER
    return {
        "x": nrm((BATCH, SEQ, D), 1.0),
        "norm_g": 1.0 + nrm((DEPTH, D), 0.02),
        "final_g": 1.0 + nrm((D,), 0.02),
        "rwkv_w_in": nrm((N_RWKV, D, RWKV_COLS), D ** -0.5),
        "rwkv_mu": jax.random.uniform(next(ks), (N_RWKV, RWKV_COLS), f32),
        "rwkv_w0": nrm((N_RWKV, DI), 0.5),
        "rwkv_w_w2": nrm((N_RWKV, RWKV_DECAY_LORA, DI), 0.5 * RWKV_DECAY_LORA ** -0.5),
        "rwkv_a0": nrm((N_RWKV, DI), 0.5),
        "rwkv_w_a2": nrm((N_RWKV, RWKV_AAA_LORA, DI), RWKV_AAA_LORA ** -0.5),
        "rwkv_k_k": 0.85 + nrm((N_RWKV, DI), 0.05),
        "rwkv_k_a": 1.0 + nrm((N_RWKV, DI), 0.05),
        "rwkv_r_k": nrm((N_RWKV, RWKV_HEADS, RWKV_HEAD), 0.1),
        "rwkv_gn_g": 1.0 + nrm((N_RWKV, DI), 0.02),
        "rwkv_gn_b": nrm((N_RWKV, DI), 0.02),
        "rwkv_w_out": nrm((N_RWKV, DI, D), DI ** -0.5),
        "hgrn_lb_logits": nrm((DEPTH, DI), 0.1),
        "hgrn_w_in": nrm((N_HGRN, D, HGRN_COLS), D ** -0.5),
        "hgrn_gn_g": 1.0 + nrm((N_HGRN, DI), 0.02),
        "hgrn_w_out": nrm((N_HGRN, DI, D), DI ** -0.5),
        "conv_w_in": nrm((N_CONV, D, CONV_COLS), D ** -0.5),
        "conv_w": nrm((N_CONV, CONV_WIDTH, DI), CONV_WIDTH ** -0.5),
        "conv_w_out": nrm((N_CONV, DI, D), DI ** -0.5),
        "gmlp_w_in": nrm((N_GMLP, D, GMLP_COLS), D ** -0.5),
        "gmlp_v_g": 1.0 + nrm((N_GMLP, DI), 0.02),
        "gmlp_w_s": nrm((N_GMLP, GMLP_GROUPS, GMLP_CHUNK, GMLP_CHUNK), GMLP_CHUNK ** -0.5),
        "gmlp_b_s": 1.0 + nrm((N_GMLP, GMLP_GROUPS, GMLP_CHUNK), 0.1),
        "gmlp_w_out": nrm((N_GMLP, DI, D), DI ** -0.5),
    }


def reference(x, norm_g, final_g,
              rwkv_w_in, rwkv_mu, rwkv_w0, rwkv_w_w2, rwkv_a0, rwkv_w_a2, rwkv_k_k, rwkv_k_a,
              rwkv_r_k, rwkv_gn_g, rwkv_gn_b, rwkv_w_out,
              hgrn_lb_logits, hgrn_w_in, hgrn_gn_g, hgrn_w_out,
              conv_w_in, conv_w, conv_w_out,
              gmlp_w_in, gmlp_v_g, gmlp_w_s, gmlp_b_s, gmlp_w_out):
    h = x
    for i in range(DEPTH):
        hn = rmsnorm(h, norm_g[i])
        m, j = i % N_MIXERS, i // N_MIXERS
        if m == 0:
            y = rwkv7_time_mix(hn, rwkv_w_in[j], rwkv_mu[j], rwkv_w0[j], rwkv_w_w2[j], rwkv_a0[j],
                               rwkv_w_a2[j], rwkv_k_k[j], rwkv_k_a[j], rwkv_r_k[j],
                               rwkv_gn_g[j], rwkv_gn_b[j], rwkv_w_out[j])
        elif m == 1:
            y = hgrn2_mix(hn, hgrn_lower_bound(hgrn_lb_logits, i), hgrn_w_in[j], hgrn_gn_g[j], hgrn_w_out[j])
        elif m == 2:
            y = short_conv_mix(hn, conv_w_in[j], conv_w[j], conv_w_out[j])
        else:
            y = gmlp_chunk_mix(hn, gmlp_w_in[j], gmlp_v_g[j], gmlp_w_s[j], gmlp_b_s[j], gmlp_w_out[j])
        h = h + y.astype(h.dtype)
    return rmsnorm(h, final_g)
```

```cpp
#include <hip/hip_runtime.h>
#include <hip/hip_cooperative_groups.h>
#include <hip/hip_fp16.h>
#include <cstdio>
#include <cstdint>
namespace cg = cooperative_groups;

typedef unsigned short bf16_t;
typedef short bf16x8 __attribute__((ext_vector_type(8)));
typedef float f32x4 __attribute__((ext_vector_type(4)));

constexpr int M_TOK = 32768, DM = 1024, SEQ_T = 8192;
constexpr int NTHREADS = 512;
constexpr int LDS_STAGE = 131072;
constexpr int LDS_BYTES = LDS_STAGE + 16;
constexpr int RW_COLS = 4224;
#ifndef REP_GEMM
#define REP_GEMM 1
#endif
#ifndef REP_RSCAN
#define REP_RSCAN 1
#endif
#ifndef REP_HSCAN
#define REP_HSCAN 1
#endif
#ifndef REP_MISC
#define REP_MISC 1
#endif

constexpr size_t MiB = 1048576;
constexpr size_t OFF_WT_RWKV_IN = 0;
constexpr size_t OFF_WT_RWKV_OUT = OFF_WT_RWKV_IN + (size_t)RW_COLS * 1024 * 2;
constexpr size_t OFF_WT_HGRN_IN = OFF_WT_RWKV_OUT + 2 * MiB;
constexpr size_t OFF_WT_HGRN_OUT = OFF_WT_HGRN_IN + 8 * MiB;
constexpr size_t OFF_WT_CONV_IN = OFF_WT_HGRN_OUT + 2 * MiB;
constexpr size_t OFF_WT_CONV_OUT = OFF_WT_CONV_IN + 8 * MiB;
constexpr size_t OFF_WT_GMLP_IN = OFF_WT_CONV_OUT + 2 * MiB;
constexpr size_t OFF_WT_GMLP_OUT = OFF_WT_GMLP_IN + 6 * MiB;
constexpr size_t OFF_WT_W2 = OFF_WT_GMLP_OUT + 2 * MiB;
constexpr size_t OFF_WT_A2 = OFF_WT_W2 + 131072;
constexpr size_t OFF_WS_GMLP = OFF_WT_A2 + 131072;
constexpr size_t OFF_LB = OFF_WS_GMLP + 262144;
constexpr size_t OFF_BAR = OFF_LB + 4096;
constexpr size_t OFF_P = 39 * MiB;
constexpr size_t OFF_X = OFF_P + 264 * MiB;
constexpr size_t OFF_Y = OFF_X + 128 * MiB;
constexpr size_t OFF_LIN = OFF_Y + 64 * MiB;
constexpr size_t WS_END = OFF_LIN + 8 * MiB;
static_assert(OFF_BAR + 16384 <= OFF_P, "small region overflow");

struct Params {
    const float* in[27];
    float* out;
    unsigned char* ws;
};

__device__ __forceinline__ int otid() { int t = (int)threadIdx.x; asm volatile("" : "+v"(t)); return t; }
__device__ __forceinline__ bf16_t f2bf(float f) { unsigned u = __float_as_uint(f); u += 0x7FFFu + ((u >> 16) & 1u); return (bf16_t)(u >> 16); }
__device__ __forceinline__ float bf2f(unsigned h) { return __uint_as_float(h << 16); }
typedef __bf16 hwbf16x2 __attribute__((ext_vector_type(2)));
typedef float f32x2c __attribute__((ext_vector_type(2)));
__device__ __forceinline__ unsigned pack2bf(float a, float b) { const f32x2c v = {a, b}; const hwbf16x2 r = __builtin_convertvector(v, hwbf16x2); return __builtin_bit_cast(unsigned, r); }
__device__ __forceinline__ float bflo(unsigned u) { return __uint_as_float(u << 16); }
__device__ __forceinline__ float bfhi(unsigned u) { return __uint_as_float(u & 0xFFFF0000u); }
__device__ __forceinline__ float h2f(unsigned short h) { return __half2float(__ushort_as_half(h)); }
__device__ __forceinline__ unsigned short f2h(float f) { return __half_as_ushort(__float2half(f)); }
__device__ __forceinline__ float sigmoidf_(float x) { return __builtin_amdgcn_rcpf(1.0f + __expf(-x)); }
__device__ __forceinline__ float siluf_(float x) { return x * __builtin_amdgcn_rcpf(1.0f + __expf(-x)); }

__device__ __forceinline__ float wave_sum(float v) {
#pragma unroll
    for (int o = 1; o < 64; o <<= 1) v += __shfl_xor(v, o);
    return v;
}
template <int CTRL>
__device__ __forceinline__ float dpp_mov(float x) {
    return __int_as_float(__builtin_amdgcn_update_dpp(0, __float_as_int(x), CTRL, 0xF, 0xF, true));
}
__device__ __forceinline__ float sum16(float x) {
    x += dpp_mov<0xB1>(x);
    x += dpp_mov<0x4E>(x);
    x += dpp_mov<0x141>(x);
    x += dpp_mov<0x140>(x);
    return x;
}

__device__ __forceinline__ int conv_perm(int n) { const int blk = n >> 10, ch = n & 1023, chin = ch & 63; return (ch >> 6) * 256 + (blk >> 1) * 128 + (chin >> 4) * 32 + (blk & 1) * 16 + (chin & 15); }

__device__ __forceinline__ void transpose_convert(const float* __restrict__ W, int K, int N, bf16_t* __restrict__ WT, bool perm, float* tile) {
    const int tid = otid();
    const int nnb = N / 64, items = (K / 64) * nnb;
    for (int it = blockIdx.x; it < items; it += gridDim.x) {
        const int kb = it / nnb, nb = it % nnb, k0 = kb * 64, n0 = nb * 64;
#pragma unroll
        for (int i = 0; i < 2; ++i) {
            const int idx = tid + i * 512, kk = idx >> 4, n4 = (idx & 15) * 4;
            const f32x4 v = *(const f32x4*)(W + (size_t)(k0 + kk) * N + n0 + n4);
            float* d = tile + kk * 65 + n4;
            d[0] = v.x; d[1] = v.y; d[2] = v.z; d[3] = v.w;
        }
        __syncthreads();
        {
            const int n = tid >> 3, k8 = (tid & 7) * 8;
            const float* s = tile + k8 * 65 + n;
            uint4 o;
            o.x = pack2bf(s[0 * 65], s[1 * 65]); o.y = pack2bf(s[2 * 65], s[3 * 65]);
            o.z = pack2bf(s[4 * 65], s[5 * 65]); o.w = pack2bf(s[6 * 65], s[7 * 65]);
            const int ncol = n0 + n, nrow = perm ? conv_perm(ncol) : ncol;
            *(uint4*)(WT + (size_t)nrow * K + k0 + k8) = o;
        }
        __syncthreads();
    }
}

__device__ __forceinline__ void phase_weights(const Params& p, char* smem) {
    float* tile = (float*)smem;
    unsigned char* ws = p.ws;
    transpose_convert(p.in[3], 1024, RW_COLS, (bf16_t*)(ws + OFF_WT_RWKV_IN), false, tile);
    transpose_convert(p.in[14], 1024, 1024, (bf16_t*)(ws + OFF_WT_RWKV_OUT), false, tile);
    transpose_convert(p.in[16], 1024, 4096, (bf16_t*)(ws + OFF_WT_HGRN_IN), false, tile);
    transpose_convert(p.in[18], 1024, 1024, (bf16_t*)(ws + OFF_WT_HGRN_OUT), false, tile);
    transpose_convert(p.in[19], 1024, 4096, (bf16_t*)(ws + OFF_WT_CONV_IN), true, tile);
    transpose_convert(p.in[21], 1024, 1024, (bf16_t*)(ws + OFF_WT_CONV_OUT), false, tile);
    transpose_convert(p.in[22], 1024, 3072, (bf16_t*)(ws + OFF_WT_GMLP_IN), false, tile);
    transpose_convert(p.in[26], 1024, 1024, (bf16_t*)(ws + OFF_WT_GMLP_OUT), false, tile);
    transpose_convert(p.in[6], 64, 1024, (bf16_t*)(ws + OFF_WT_W2), false, tile);
    transpose_convert(p.in[8], 64, 1024, (bf16_t*)(ws + OFF_WT_A2), false, tile);
    const int gtid = blockIdx.x * NTHREADS + otid(), gsz = gridDim.x * NTHREADS;
    {
        const float* w = p.in[24]; bf16_t* o = (bf16_t*)(ws + OFF_WS_GMLP);
        for (int i = gtid; i < 8 * 128 * 128; i += gsz) { const int t = (i >> 7) & 127, s = i & 127; o[i] = (s <= t) ? f2bf(w[i]) : (bf16_t)0; }
    }
    {
        const float* l = p.in[15]; float* lb = (float*)(ws + OFF_LB);
        for (int c = gtid; c < 1024; c += gsz) {
            const float l0 = l[c], l1 = l[1024 + c], l2 = l[2048 + c], l3 = l[3072 + c];
            const float m = fmaxf(fmaxf(l0, l1), fmaxf(l2, l3));
            const float e0 = expf(l0 - m), e1 = expf(l1 - m), e2 = expf(l2 - m), e3 = expf(l3 - m);
            lb[c] = e1 / (e0 + e1 + e2 + e3);
        }
    }
}

template <bool OUT_BF16>
__device__ __forceinline__ void rmsnorm_phase(const float* in, const float* __restrict__ g, void* outp) {
    const int lane = otid() & 63, wid = otid() >> 6;
    const int gw = blockIdx.x * 8 + wid, ngw = gridDim.x * 8;
    f32x4 gv[4];
#pragma unroll
    for (int j = 0; j < 4; ++j) gv[j] = *(const f32x4*)(g + lane * 4 + j * 256);
    for (int row = gw; row < M_TOK; row += ngw) {
        const float* xr = in + (size_t)row * 1024 + lane * 4;
        f32x4 v[4]; float ss = 0.f;
#pragma unroll
        for (int j = 0; j < 4; ++j) { v[j] = *(const f32x4*)(xr + j * 256); ss += v[j].x * v[j].x + v[j].y * v[j].y + v[j].z * v[j].z + v[j].w * v[j].w; }
        ss = wave_sum(ss);
        const float rs = rsqrtf(ss * (1.0f / 1024.0f) + 1e-6f);
#pragma unroll
        for (int j = 0; j < 4; ++j) {
            const f32x4 o = v[j] * rs * gv[j];
            if (OUT_BF16) {
                uint2 pk; pk.x = pack2bf(o.x, o.y); pk.y = pack2bf(o.z, o.w);
                *(uint2*)((bf16_t*)outp + (size_t)row * 1024 + lane * 4 + j * 256) = pk;
            } else {
                *(f32x4*)((float*)outp + (size_t)row * 1024 + lane * 4 + j * 256) = o;
            }
        }
    }
}

constexpr int G_BM = 256, G_BN = 128, G_BK = 64, G_LS = 72;
constexpr int G_ASTAGE = G_BM * G_LS, G_BSTAGE = G_BN * G_LS;

template <class Epi>
__device__ __forceinline__ void gemm_phase(const bf16_t* A, int lda, const bf16_t* Bt, int ldb, int N, int K, const Epi epi, char* smem) {
    const int tid = otid(), lane = tid & 63, wid = tid >> 6, wr = wid >> 1, wc = wid & 1, fr = lane & 15, fq = lane >> 4;
    bf16_t* As = (bf16_t*)smem;
    bf16_t* Bs = As + 2 * G_ASTAGE;
    const int nTn = N / G_BN, nT = (M_TOK / G_BM) * nTn, nk = K / G_BK;
    const int lrow = tid >> 3, lc = (tid & 7) * 8;
    for (int tile = blockIdx.x; tile < nT; tile += gridDim.x) {
        const int tm = tile / nTn, tn = tile % nTn;
        const bf16_t* Ag = A + (size_t)(tm * G_BM + lrow) * lda + lc;
        const bf16_t* Bg = Bt + (size_t)(tn * G_BN + lrow) * ldb + lc;
        f32x4 acc[4][4];
#pragma unroll
        for (int i = 0; i < 4; ++i)
#pragma unroll
            for (int j = 0; j < 4; ++j) acc[i][j] = (f32x4){0.f, 0.f, 0.f, 0.f};
        uint4 ra[4], rb[2];
#pragma unroll
        for (int i = 0; i < 4; ++i) ra[i] = *(const uint4*)(Ag + (size_t)i * 64 * lda);
#pragma unroll
        for (int i = 0; i < 2; ++i) rb[i] = *(const uint4*)(Bg + (size_t)i * 64 * ldb);
#pragma unroll
        for (int i = 0; i < 4; ++i) *(uint4*)(As + (lrow + i * 64) * G_LS + lc) = ra[i];
#pragma unroll
        for (int i = 0; i < 2; ++i) *(uint4*)(Bs + (lrow + i * 64) * G_LS + lc) = rb[i];
        __syncthreads();
        for (int kt = 0; kt < nk; ++kt) {
            const int buf = kt & 1;
            const bool more = (kt + 1 < nk);
            if (more) {
#pragma unroll
                for (int i = 0; i < 4; ++i) ra[i] = *(const uint4*)(Ag + (size_t)i * 64 * lda + (kt + 1) * G_BK);
#pragma unroll
                for (int i = 0; i < 2; ++i) rb[i] = *(const uint4*)(Bg + (size_t)i * 64 * ldb + (kt + 1) * G_BK);
            }
            const bf16_t* as = As + buf * G_ASTAGE + (wr * 64 + fr) * G_LS + fq * 8;
            const bf16_t* bs = Bs + buf * G_BSTAGE + (wc * 64 + fr) * G_LS + fq * 8;
#pragma unroll
            for (int ks = 0; ks < 2; ++ks) {
                bf16x8 af[4], bfr[4];
#pragma unroll
                for (int i = 0; i < 4; ++i) { af[i] = *(const bf16x8*)(as + i * 16 * G_LS + ks * 32); bfr[i] = *(const bf16x8*)(bs + i * 16 * G_LS + ks * 32); }
#pragma unroll
                for (int mi = 0; mi < 4; ++mi)
#pragma unroll
                    for (int ni = 0; ni < 4; ++ni) acc[mi][ni] = __builtin_amdgcn_mfma_f32_16x16x32_bf16(bfr[ni], af[mi], acc[mi][ni], 0, 0, 0);
            }
            if (more) {
                bf16_t* ad = As + (buf ^ 1) * G_ASTAGE; bf16_t* bd = Bs + (buf ^ 1) * G_BSTAGE;
#pragma unroll
                for (int i = 0; i < 4; ++i) *(uint4*)(ad + (lrow + i * 64) * G_LS + lc) = ra[i];
#pragma unroll
                for (int i = 0; i < 2; ++i) *(uint4*)(bd + (lrow + i * 64) * G_LS + lc) = rb[i];
            }
            __syncthreads();
        }
        epi(acc, tm * G_BM + wr * 64, tn * G_BN + wc * 64, fr, fq);
    }
}

struct EpiStoreBf16 {
    bf16_t* C; int ldc;
    __device__ __forceinline__ void operator()(f32x4 (&acc)[4][4], int row0, int col0, int fr, int fq) const {
#pragma unroll
        for (int mi = 0; mi < 4; ++mi)
#pragma unroll
            for (int ni = 0; ni < 4; ++ni) {
                const f32x4 a = acc[mi][ni]; uint2 pk; pk.x = pack2bf(a.x, a.y); pk.y = pack2bf(a.z, a.w);
                *(uint2*)(C + (size_t)(row0 + mi * 16 + fr) * ldc + col0 + ni * 16 + fq * 4) = pk;
            }
    }
};
struct EpiHgrn {
    bf16_t* C; const float* lb;
    __device__ __forceinline__ void operator()(f32x4 (&acc)[4][4], int row0, int col0, int fr, int fq) const {
        const int blk = col0 >> 10;
#pragma unroll
        for (int mi = 0; mi < 4; ++mi)
#pragma unroll
            for (int ni = 0; ni < 4; ++ni) {
                f32x4 a = acc[mi][ni]; const int col = col0 + ni * 16 + fq * 4; uint2 pk;
                if (blk == 1) {
                    const f32x4 l = *(const f32x4*)(lb + (col - 1024));
                    a.x = (1.f - l.x) * sigmoidf_(-a.x); a.y = (1.f - l.y) * sigmoidf_(-a.y); a.z = (1.f - l.z) * sigmoidf_(-a.z); a.w = (1.f - l.w) * sigmoidf_(-a.w);
                    pk.x = (unsigned)f2h(a.x) | ((unsigned)f2h(a.y) << 16); pk.y = (unsigned)f2h(a.z) | ((unsigned)f2h(a.w) << 16);
                } else {
                    if (blk == 3) { a.x = siluf_(a.x); a.y = siluf_(a.y); a.z = siluf_(a.z); a.w = siluf_(a.w); }
                    pk.x = pack2bf(a.x, a.y); pk.y = pack2bf(a.z, a.w);
                }
                *(uint2*)(C + (size_t)(row0 + mi * 16 + fr) * 4096 + col) = pk;
            }
    }
};
struct EpiConv {
    bf16_t* Yc; bf16_t* U;
    __device__ __forceinline__ void operator()(f32x4 (&acc)[4][4], int row0, int col0, int fr, int fq) const {
        const int ch = (col0 >> 6) * 16 + fq * 4;
#pragma unroll
        for (int mi = 0; mi < 4; ++mi) {
            const f32x4 b = acc[mi][0], c = acc[mi][1], z = acc[mi][2], g = acc[mi][3];
            const size_t o = (size_t)(row0 + mi * 16 + fr) * 1024 + ch;
            uint2 py, pu;
            py.x = pack2bf(c.x * z.x, c.y * z.y); py.y = pack2bf(c.z * z.z, c.w * z.w);
            pu.x = pack2bf(b.x * siluf_(g.x), b.y * siluf_(g.y)); pu.y = pack2bf(b.z * siluf_(g.z), b.w * siluf_(g.w));
            *(uint2*)(Yc + o) = py; *(uint2*)(U + o) = pu;
        }
    }
};
struct EpiGmlp {
    bf16_t* C;
    __device__ __forceinline__ void operator()(f32x4 (&acc)[4][4], int row0, int col0, int fr, int fq) const {
        const int blk = col0 >> 10;
#pragma unroll
        for (int mi = 0; mi < 4; ++mi)
#pragma unroll
            for (int ni = 0; ni < 4; ++ni) {
                f32x4 a = acc[mi][ni];
                if (blk == 2) { a.x = siluf_(a.x); a.y = siluf_(a.y); a.z = siluf_(a.z); a.w = siluf_(a.w); }
                uint2 pk; pk.x = pack2bf(a.x, a.y); pk.y = pack2bf(a.z, a.w);
                *(uint2*)(C + (size_t)(row0 + mi * 16 + fr) * 3072 + col0 + ni * 16 + fq * 4) = pk;
            }
    }
};
struct EpiResid {
    const float* R; float* O;
    __device__ __forceinline__ void operator()(f32x4 (&acc)[4][4], int row0, int col0, int fr, int fq) const {
#pragma unroll
        for (int mi = 0; mi < 4; ++mi)
#pragma unroll
            for (int ni = 0; ni < 4; ++ni) {
                const size_t o = (size_t)(row0 + mi * 16 + fr) * 1024 + col0 + ni * 16 + fq * 4;
                const f32x4 r = *(const f32x4*)(R + o);
                *(f32x4*)(O + o) = r + acc[mi][ni];
            }
    }
};
__device__ __forceinline__ float rwkv_decay(float v) {
    return __expf(-0.60653065971263342f * sigmoidf_(v));
}
struct EpiLoraW {
    const float* w0; float* Wd;
    __device__ __forceinline__ void operator()(f32x4 (&acc)[4][4], int row0, int col0, int fr, int fq) const {
#pragma unroll
        for (int mi = 0; mi < 4; ++mi)
#pragma unroll
            for (int ni = 0; ni < 4; ++ni) {
                const int col = col0 + ni * 16 + fq * 4;
                const f32x4 b = *(const f32x4*)(w0 + col); const f32x4 a = acc[mi][ni] + b;
                f32x4 o; o.x = rwkv_decay(a.x); o.y = rwkv_decay(a.y); o.z = rwkv_decay(a.z); o.w = rwkv_decay(a.w);
                *(f32x4*)(Wd + (size_t)(row0 + mi * 16 + fr) * 1024 + col) = o;
            }
    }
};
struct EpiLoraA {
    const float* a0; unsigned short* Ai;
    __device__ __forceinline__ void operator()(f32x4 (&acc)[4][4], int row0, int col0, int fr, int fq) const {
#pragma unroll
        for (int mi = 0; mi < 4; ++mi)
#pragma unroll
            for (int ni = 0; ni < 4; ++ni) {
                const int col = col0 + ni * 16 + fq * 4;
                const f32x4 b = *(const f32x4*)(a0 + col); const f32x4 a = acc[mi][ni] + b;
                uint2 pk;
                pk.x = (unsigned)f2h(sigmoidf_(a.x)) | ((unsigned)f2h(sigmoidf_(a.y)) << 16);
                pk.y = (unsigned)f2h(sigmoidf_(a.z)) | ((unsigned)f2h(sigmoidf_(a.w)) << 16);
                *(uint2*)(Ai + (size_t)(row0 + mi * 16 + fr) * 1024 + col) = pk;
            }
    }
};


namespace pg8 {
#define PG8_LAS __attribute__((address_space(3)))
constexpr int BM = 256, BK = 64, HALF = 128, HTB = HALF * BK * 2, NXCD = 8, WGM = 8;
__device__ __forceinline__ int lds_byte(int r, int c) { const int st = (r >> 4) * 2 + (c >> 5), rr = r & 15, cc = c & 31, ob = rr * 64 + cc * 2; return st * 1024 + (ob ^ (((ob >> 9) & 1) << 5)); }
__device__ __forceinline__ void stage_rc(int b, int& R, int& C) { const int st = b / 1024, sb = b % 1024, swz = sb ^ (((sb >> 9) & 1) << 5); R = (st >> 1) * 16 + swz / 64; C = (st & 1) * 32 + (swz % 64) / 2; }
struct Unit { int pm, pn; };
struct Gemm { const bf16_t* A; const bf16_t* Bt; int M, N, K; };
struct StaticOrder {
    int nM, nN, nwg, G, c;
    __device__ void init(int M, int N, int G_, int c_) { nM = M / BM; nN = N / BM; nwg = nM * nN; G = G_; c = c_; }
    __device__ bool next(int i, Unit& u) const {
        const long L = (long)i * G + c; if (L >= nwg) return false;
        int wgid = (int)L; { const int q = nwg / NXCD, r = nwg % NXCD, xcd = wgid % NXCD, off = wgid / NXCD; wgid = (xcd < r ? xcd * (q + 1) : r * (q + 1) + (xcd - r) * q) + off; }
        const int nig = WGM * nN, gid = wgid / nig, fm = gid * WGM, gsz = (nM - fm) < WGM ? (nM - fm) : WGM;
        u.pm = fm + ((wgid % nig) % gsz); u.pn = (wgid % nig) / gsz; return true;
    }
};
template <class Epi>
__device__ __forceinline__ void gemm_phase(PG8_LAS unsigned char* lds, const Gemm g, const StaticOrder& S, const Epi& E) {
    const int tid = otid(), wid = __builtin_amdgcn_readfirstlane(tid >> 6), lane = tid & 63, wr = wid >> 2, wc = wid & 3, fr = lane & 15, fq = lane >> 4;
    const int K = g.K, nt = K / BK;
    unsigned voffA[2], voffB[2];
#pragma unroll
    for (int i = 0; i < 2; ++i) { int R, C; stage_rc(tid * 16 + i * 8192, R, C); voffA[i] = (unsigned)(R * K + C) * 2u; voffB[i] = (unsigned)(R * K + C) * 2u; }
    const size_t kstep = (size_t)(BK * 2);
    const size_t hstep = (size_t)HALF * K * 2;
    const size_t tstep = 2 * hstep;
    const unsigned ldsw = (unsigned)wid * 1024u;
    const int aoff = lds_byte(wr * 64 + fr, fq * 8), boff = lds_byte(wc * 32 + fr, fq * 8);
#define PG8_SA(b, h) (((b) * 2 + (h)) * HTB)
#define PG8_SB(b, h) ((4 + (b) * 2 + (h)) * HTB)
#define PG8_STAGE(bufoff, gbase, voff) do { _Pragma("unroll") for (int _i = 0; _i < 2; ++_i) \
        __builtin_amdgcn_global_load_lds((const unsigned*)((const char*)(gbase) + (voff)[_i]), (PG8_LAS unsigned*)(lds + (bufoff) + ldsw + _i * 8192), 16, 0, 0); } while (0)
#define PG8_LDA(dst, b, h) do { _Pragma("unroll") for (int m = 0; m < 4; ++m) _Pragma("unroll") for (int k = 0; k < 2; ++k) dst[m][k] = *(const PG8_LAS bf16x8*)(lds + PG8_SA(b, h) + aoff + m * 2048 + k * 1024); } while (0)
#define PG8_LDB(dst, b, h) do { _Pragma("unroll") for (int n = 0; n < 2; ++n) _Pragma("unroll") for (int k = 0; k < 2; ++k) dst[n][k] = *(const PG8_LAS bf16x8*)(lds + PG8_SB(b, h) + boff + n * 2048 + k * 1024); } while (0)
#define PG8_MMA(ai, bj, At, Bt) do { __builtin_amdgcn_s_setprio(1); _Pragma("unroll") for (int m = 0; m < 4; ++m) _Pragma("unroll") for (int n = 0; n < 2; ++n) _Pragma("unroll") for (int k = 0; k < 2; ++k) \
        acc[ai][bj][m][n] = __builtin_amdgcn_mfma_f32_16x16x32_bf16(Bt[n][k], At[m][k], acc[ai][bj][m][n], 0, 0, 0); __builtin_amdgcn_s_setprio(0); } while (0)
#define PG8_WAIT_V(n) asm volatile("s_waitcnt vmcnt(" #n ")" ::: "memory")
#define PG8_WAIT_L(n) asm volatile("s_waitcnt lgkmcnt(" #n ")" ::: "memory")
#define PG8_BAR __builtin_amdgcn_s_barrier()
#define PG8_SCHED __builtin_amdgcn_sched_barrier(0)
    Unit cur, nxt; int ui = 0;
    if (!S.next(0, cur)) return;
    f32x4 acc[2][2][4][2];
#pragma unroll
    for (int a = 0; a < 2; ++a)
#pragma unroll
        for (int b = 0; b < 2; ++b)
#pragma unroll
            for (int m = 0; m < 4; ++m)
#pragma unroll
                for (int n = 0; n < 2; ++n) acc[a][b][m][n] = (f32x4){0.f, 0.f, 0.f, 0.f};
    bf16x8 At[4][2], B0[2][2], B1[2][2];
    const char* cA = (const char*)g.A + (size_t)cur.pm * tstep; const char* cB = (const char*)g.Bt + (size_t)cur.pn * tstep;
    PG8_STAGE(PG8_SB(0, 0), cB, voffB); PG8_STAGE(PG8_SA(0, 0), cA, voffA); PG8_STAGE(PG8_SB(0, 1), cB + hstep, voffB); PG8_STAGE(PG8_SA(0, 1), cA + hstep, voffA);
    if (wr == 1) PG8_BAR;
    PG8_WAIT_V(4); PG8_BAR;
    PG8_STAGE(PG8_SB(1, 0), cB + kstep, voffB); PG8_STAGE(PG8_SA(1, 0), cA + kstep, voffA); PG8_STAGE(PG8_SB(1, 1), cB + hstep + kstep, voffB);
    PG8_WAIT_V(6); PG8_BAR;
    for (;;) {
        const bool has_next = S.next(ui + 1, nxt);
        const char* nA = has_next ? (const char*)g.A + (size_t)nxt.pm * tstep : cA; const char* nB = has_next ? (const char*)g.Bt + (size_t)nxt.pn * tstep : cB;
        for (int t = 0; t < nt; t += 2) {
            const bool last = (t == nt - 2);
            const char* a1 = cA + (size_t)(t + 1) * kstep;
            const char* a2 = last ? nA : cA + (size_t)(t + 2) * kstep; const char* b2 = last ? nB : cB + (size_t)(t + 2) * kstep;
            const char* a3 = a2 + kstep; const char* b3 = b2 + kstep;
            PG8_LDB(B0, 0, 0); PG8_SCHED; PG8_LDA(At, 0, 0); PG8_STAGE(PG8_SA(1, 1), a1 + hstep, voffA);
            PG8_WAIT_L(8); PG8_BAR; PG8_WAIT_L(0); PG8_MMA(0, 0, At, B0); PG8_BAR; PG8_SCHED;
            PG8_LDB(B1, 0, 1); PG8_STAGE(PG8_SB(0, 0), b2, voffB);
            PG8_BAR; PG8_WAIT_L(0); PG8_MMA(0, 1, At, B1); PG8_BAR;
            PG8_LDA(At, 0, 1); PG8_STAGE(PG8_SA(0, 0), a2, voffA);
            PG8_BAR; PG8_WAIT_L(0); PG8_MMA(1, 0, At, B0); PG8_BAR; PG8_SCHED;
            PG8_STAGE(PG8_SB(0, 1), b2 + hstep, voffB);
            PG8_WAIT_V(6); PG8_BAR; PG8_MMA(1, 1, At, B1); PG8_BAR;
            PG8_LDB(B0, 1, 0); PG8_SCHED; PG8_LDA(At, 1, 0); PG8_STAGE(PG8_SA(0, 1), a2 + hstep, voffA);
            PG8_WAIT_L(8); PG8_BAR; PG8_WAIT_L(0); PG8_MMA(0, 0, At, B0); PG8_BAR; PG8_SCHED;
            PG8_LDB(B1, 1, 1); PG8_STAGE(PG8_SB(1, 0), b3, voffB);
            PG8_BAR; PG8_WAIT_L(0); PG8_MMA(0, 1, At, B1); PG8_BAR;
            PG8_LDA(At, 1, 1); PG8_STAGE(PG8_SA(1, 0), a3, voffA);
            PG8_BAR; PG8_WAIT_L(0); PG8_MMA(1, 0, At, B0); PG8_BAR; PG8_SCHED;
            PG8_STAGE(PG8_SB(1, 1), b3 + hstep, voffB);
            PG8_WAIT_V(6); PG8_BAR; PG8_MMA(1, 1, At, B1); PG8_BAR;
        }
        E(acc, cur, wr, wc, fr, fq);
        if (!has_next) break;
#pragma unroll
        for (int a = 0; a < 2; ++a)
#pragma unroll
            for (int b = 0; b < 2; ++b)
#pragma unroll
                for (int m = 0; m < 4; ++m)
#pragma unroll
                    for (int n = 0; n < 2; ++n) acc[a][b][m][n] = (f32x4){0.f, 0.f, 0.f, 0.f};
        cur = nxt; cA = nA; cB = nB; ++ui;
    }
    PG8_WAIT_V(0);
    if (wr == 0) PG8_BAR;
    PG8_BAR;
#undef PG8_SA
#undef PG8_SB
#undef PG8_STAGE
#undef PG8_LDA
#undef PG8_LDB
#undef PG8_MMA
#undef PG8_WAIT_V
#undef PG8_WAIT_L
#undef PG8_BAR
#undef PG8_SCHED
}
#define PG8_FOREACH(body) \
    _Pragma("unroll") for (int ai = 0; ai < 2; ++ai) _Pragma("unroll") for (int m = 0; m < 4; ++m) { const int row = u.pm * 256 + ai * 128 + wr * 64 + m * 16 + fr; \
    _Pragma("unroll") for (int bj = 0; bj < 2; ++bj) _Pragma("unroll") for (int n = 0; n < 2; ++n) { const int col = u.pn * 256 + bj * 128 + wc * 32 + n * 16 + fq * 4; f32x4 a = acc[ai][bj][m][n]; body } }
struct EStoreBf16 {
    bf16_t* C; int ldc; int ncols;
    __device__ __forceinline__ void operator()(const f32x4 (&acc)[2][2][4][2], const Unit& u, int wr, int wc, int fr, int fq) const {
        const int nbj = (u.pn * 256 + 256 <= ncols) ? 2 : 1;
#pragma unroll
        for (int ai = 0; ai < 2; ++ai)
#pragma unroll
            for (int m = 0; m < 4; ++m) { const int row = u.pm * 256 + ai * 128 + wr * 64 + m * 16 + fr;
                for (int bj = 0; bj < nbj; ++bj)
#pragma unroll
                    for (int n = 0; n < 2; ++n) { const int col = u.pn * 256 + bj * 128 + wc * 32 + n * 16 + fq * 4; const f32x4 a = acc[ai][bj][m][n];
                        uint2 pk; pk.x = pack2bf(a.x, a.y); pk.y = pack2bf(a.z, a.w); *(uint2*)(C + (size_t)row * ldc + col) = pk; } }
    }
};
struct EHgrn {
    bf16_t* C; const float* lb;
    __device__ __forceinline__ void operator()(const f32x4 (&acc)[2][2][4][2], const Unit& u, int wr, int wc, int fr, int fq) const {
        const int blk = (u.pn * 256) >> 10;
        PG8_FOREACH( uint2 pk;
            if (blk == 1) { const f32x4 l = *(const f32x4*)(lb + (col - 1024));
                a.x = (1.f - l.x) * sigmoidf_(-a.x); a.y = (1.f - l.y) * sigmoidf_(-a.y); a.z = (1.f - l.z) * sigmoidf_(-a.z); a.w = (1.f - l.w) * sigmoidf_(-a.w);
                pk.x = (unsigned)f2h(a.x) | ((unsigned)f2h(a.y) << 16); pk.y = (unsigned)f2h(a.z) | ((unsigned)f2h(a.w) << 16);
            } else { if (blk == 3) { a.x = siluf_(a.x); a.y = siluf_(a.y); a.z = siluf_(a.z); a.w = siluf_(a.w); }
                pk.x = pack2bf(a.x, a.y); pk.y = pack2bf(a.z, a.w); }
            *(uint2*)(C + (size_t)row * 4096 + col) = pk; )
    }
};
struct EGmlp {
    bf16_t* C;
    __device__ __forceinline__ void operator()(const f32x4 (&acc)[2][2][4][2], const Unit& u, int wr, int wc, int fr, int fq) const {
        const int blk = (u.pn * 256) >> 10;
        PG8_FOREACH( if (blk == 2) { a.x = siluf_(a.x); a.y = siluf_(a.y); a.z = siluf_(a.z); a.w = siluf_(a.w); }
            uint2 pk; pk.x = pack2bf(a.x, a.y); pk.y = pack2bf(a.z, a.w); *(uint2*)(C + (size_t)row * 3072 + col) = pk; )
    }
};
struct EResid {
    const float* R; float* O;
    __device__ __forceinline__ void operator()(const f32x4 (&acc)[2][2][4][2], const Unit& u, int wr, int wc, int fr, int fq) const {
        PG8_FOREACH( const size_t o = (size_t)row * 1024 + col; const f32x4 r = *(const f32x4*)(R + o); *(f32x4*)(O + o) = r + a; )
    }
};
struct EConv {
    bf16_t* Yc; bf16_t* U;
    __device__ __forceinline__ void operator()(const f32x4 (&acc)[2][2][4][2], const Unit& u, int wr, int wc, int fr, int fq) const {
        const int ch = u.pn * 64 + wc * 16 + fq * 4;
#pragma unroll
        for (int ai = 0; ai < 2; ++ai)
#pragma unroll
            for (int m = 0; m < 4; ++m) {
                const int row = u.pm * 256 + ai * 128 + wr * 64 + m * 16 + fr;
                const f32x4 b = acc[ai][0][m][0], c = acc[ai][0][m][1], z = acc[ai][1][m][0], g = acc[ai][1][m][1];
                const size_t o = (size_t)row * 1024 + ch;
                uint2 py, pu;
                py.x = pack2bf(c.x * z.x, c.y * z.y); py.y = pack2bf(c.z * z.z, c.w * z.w);
                pu.x = pack2bf(b.x * siluf_(g.x), b.y * siluf_(g.y)); pu.y = pack2bf(b.z * siluf_(g.z), b.w * siluf_(g.w));
                *(uint2*)(Yc + o) = py; *(uint2*)(U + o) = pu;
            }
    }
};
template <class Epi>
__device__ __forceinline__ void run(char* smem, const bf16_t* A, const bf16_t* Bt, int N, const Epi& E) {
    StaticOrder S; S.init(M_TOK, N, (int)gridDim.x, (int)blockIdx.x);
    gemm_phase((PG8_LAS unsigned char*)smem, Gemm{A, Bt, M_TOK, N, 1024}, S, E);
    __syncthreads();
}
}

__device__ __forceinline__ void rwkv_lin_phase(const bf16_t* P, const float* __restrict__ mu, bf16_t* Lin) {
    const int gtid = blockIdx.x * NTHREADS + otid(), gsz = gridDim.x * NTHREADS;
    for (int idx = gtid; idx < M_TOK * 64; idx += gsz) {
        const int tok = idx >> 6, cp = (idx & 63) * 2, col = 3072 + cp;
        const unsigned pc = *(const unsigned*)(P + (size_t)tok * RW_COLS + col);
        unsigned pp = 0u;
        if ((tok & (SEQ_T - 1)) != 0) pp = *(const unsigned*)(P + (size_t)(tok - 1) * RW_COLS + col);
        const float m0 = mu[col], m1 = mu[col + 1];
        float x0 = bflo(pc) + (bflo(pp) - bflo(pc)) * m0;
        float x1 = bfhi(pc) + (bfhi(pp) - bfhi(pc)) * m1;
        if (cp < 64) { x0 = tanhf(x0); x1 = tanhf(x1); }
        *(unsigned*)(Lin + (size_t)tok * 128 + cp) = pack2bf(x0, x1);
    }
}

constexpr int RW_TC = 32;
typedef float f32x2 __attribute__((ext_vector_type(2)));
struct RwRaw { uint2 cr, ck, cv, pr, pk, pv, a; f32x4 w; };
__device__ __forceinline__ RwRaw rw_load_raw(const bf16_t* P, const float* Wd, const unsigned short* Ai, size_t tokbase, int t, int hcol) {
    RwRaw r;
    const size_t tok = tokbase + t;
    const bf16_t* pr = P + tok * RW_COLS + hcol;
    r.cr = *(const uint2*)(pr); r.ck = *(const uint2*)(pr + 1024); r.cv = *(const uint2*)(pr + 2048);
    { const bf16_t* pp = (t > 0) ? pr - RW_COLS : pr; r.pr = *(const uint2*)(pp); r.pk = *(const uint2*)(pp + 1024); r.pv = *(const uint2*)(pp + 2048);
      const unsigned msk = (t > 0) ? 0xFFFFFFFFu : 0u; r.pr.x &= msk; r.pr.y &= msk; r.pk.x &= msk; r.pk.y &= msk; r.pv.x &= msk; r.pv.y &= msk; }
    r.w = *(const f32x4*)(Wd + tok * 1024 + hcol);
    r.a = *(const uint2*)(Ai + tok * 1024 + hcol);
    return r;
}
__device__ __forceinline__ void rw_process(const RwRaw& x, const f32x4 mur, const f32x4 muk, const f32x4 muv, const f32x4 kkc, const f32x4 kac, float* d) {
    f32x4 rc = {bflo(x.cr.x), bfhi(x.cr.x), bflo(x.cr.y), bfhi(x.cr.y)}, rp = {bflo(x.pr.x), bfhi(x.pr.x), bflo(x.pr.y), bfhi(x.pr.y)};
    f32x4 kc = {bflo(x.ck.x), bfhi(x.ck.x), bflo(x.ck.y), bfhi(x.ck.y)}, kp = {bflo(x.pk.x), bfhi(x.pk.x), bflo(x.pk.y), bfhi(x.pk.y)};
    f32x4 vc = {bflo(x.cv.x), bfhi(x.cv.x), bflo(x.cv.y), bfhi(x.cv.y)}, vp = {bflo(x.pv.x), bfhi(x.pv.x), bflo(x.pv.y), bfhi(x.pv.y)};
    const f32x4 a = {h2f((unsigned short)(x.a.x & 0xFFFFu)), h2f((unsigned short)(x.a.x >> 16)), h2f((unsigned short)(x.a.y & 0xFFFFu)), h2f((unsigned short)(x.a.y >> 16))};
    const f32x4 r1 = rc + (rp - rc) * mur, k1 = kc + (kp - kc) * muk, v1 = vc + (vp - vc) * muv;
    const f32x4 kkv = k1 * kkc;
    float n2 = kkv.x * kkv.x + kkv.y * kkv.y + kkv.z * kkv.z + kkv.w * kkv.w;
    n2 = sum16(n2);
    const float inv = rsqrtf(fmaxf(n2, 1e-24f));
    const f32x4 kk = kkv * inv;
    const f32x4 k2 = k1 * (1.f + (a - 1.f) * kac);
    *(f32x4*)(d) = r1; *(f32x4*)(d + 64) = x.w; *(f32x4*)(d + 128) = k2; *(f32x4*)(d + 192) = v1; *(f32x4*)(d + 256) = -kk; *(f32x4*)(d + 320) = kk * a;
}
__device__ __forceinline__ void rwkv_scan_phase(const Params& p, char* smem) {
    float* buf = (float*)smem;
    const bf16_t* P = (const bf16_t*)(p.ws + OFF_P);
    const float* Wd = (const float*)(p.ws + OFF_X);
    const unsigned short* Ai = (const unsigned short*)(p.ws + OFF_Y);
    float* Y = p.out;
    const float* mu = p.in[4]; const float* k_k = p.in[9]; const float* k_a = p.in[10];
    const int tid = otid(), lane = tid & 63, wid = __builtin_amdgcn_readfirstlane(tid >> 6);
    constexpr int NCH = SEQ_T / RW_TC;
    const int sub = lane >> 4, q = lane & 15;
    for (int unit = blockIdx.x; unit < 256; unit += gridDim.x) {
        const int bh = unit >> 2, rg = unit & 3, b = bh >> 4, h = bh & 15;
        const size_t tokbase = (size_t)b * SEQ_T;
        __syncthreads();
        if (wid >= 4) {
            const int hcol = h * 64 + q * 4, lw = wid - 4;
            const f32x4 mur = *(const f32x4*)(mu + hcol), muk = *(const f32x4*)(mu + 1024 + hcol), muv = *(const f32x4*)(mu + 2048 + hcol);
            const f32x4 kkc = *(const f32x4*)(k_k + hcol), kac = *(const f32x4*)(k_a + hcol);
            const int tl0 = lw * 4 + sub, tl1 = 16 + lw * 4 + sub;
            RwRaw x0 = rw_load_raw(P, Wd, Ai, tokbase, tl0, hcol), x1 = rw_load_raw(P, Wd, Ai, tokbase, tl1, hcol);
            for (int c = -1; c < NCH; ++c) {
                if (c + 1 < NCH) {
                    const int cn = c + 1; float* db = buf + (cn & 1) * (RW_TC * 384) + q * 4;
                    rw_process(x0, mur, muk, muv, kkc, kac, db + tl0 * 384);
                    rw_process(x1, mur, muk, muv, kkc, kac, db + tl1 * 384);
                    { const int cl = (cn + 1 < NCH) ? cn + 1 : cn; x0 = rw_load_raw(P, Wd, Ai, tokbase, cl * RW_TC + tl0, hcol); x1 = rw_load_raw(P, Wd, Ai, tokbase, cl * RW_TC + tl1, hcol); }
                }
                __syncthreads();
            }
        } else {
            f32x2 Sa = {0.f, 0.f}, Sb = {0.f, 0.f};
            const int rowl = wid * 4 + sub;
            float* ybase = Y + tokbase * 1024 + h * 64 + rg * 16 + rowl;
            __syncthreads();
            for (int c = 0; c < NCH; ++c) {
                const float* cb = buf + (c & 1) * (RW_TC * 384) + q * 4;
                const float* vb = buf + (c & 1) * (RW_TC * 384) + 192 + rg * 16 + rowl;
                f32x4 r4 = *(const f32x4*)(cb), w4 = *(const f32x4*)(cb + 64), k4 = *(const f32x4*)(cb + 128), a4 = *(const f32x4*)(cb + 256), b4 = *(const f32x4*)(cb + 320);
                float vv = vb[0];
                float ykeep = 0.f;
#pragma unroll
                for (int tl = 0; tl < RW_TC; ++tl) {
                    f32x4 nr = r4, nw = w4, nk = k4, na = a4, nb = b4; float nv = vv;
                    if (tl + 1 < RW_TC) {
                        const float* s = cb + (tl + 1) * 384;
                        nr = *(const f32x4*)(s); nw = *(const f32x4*)(s + 64); nk = *(const f32x4*)(s + 128); na = *(const f32x4*)(s + 256); nb = *(const f32x4*)(s + 320);
                        nv = vb[(tl + 1) * 384];
                    }
                    __builtin_amdgcn_sched_barrier(0);
                    f32x2 pa = Sa * (f32x2){a4.x, a4.y};
                    pa = __builtin_elementwise_fma(Sb, (f32x2){a4.z, a4.w}, pa);
                    const float sa = sum16(pa.x + pa.y);
                    const f32x2 ta = __builtin_elementwise_fma((f32x2){k4.x, k4.y}, (f32x2){vv, vv}, (f32x2){b4.x, b4.y} * sa);
                    const f32x2 tb = __builtin_elementwise_fma((f32x2){k4.z, k4.w}, (f32x2){vv, vv}, (f32x2){b4.z, b4.w} * sa);
                    Sa = __builtin_elementwise_fma(Sa, (f32x2){w4.x, w4.y}, ta);
                    Sb = __builtin_elementwise_fma(Sb, (f32x2){w4.z, w4.w}, tb);
                    f32x2 py = Sa * (f32x2){r4.x, r4.y};
                    py = __builtin_elementwise_fma(Sb, (f32x2){r4.z, r4.w}, py);
                    const float y = sum16(py.x + py.y);
                    ykeep = (q == (tl & 15)) ? y : ykeep;
                    if ((tl & 15) == 15) ybase[(size_t)(c * RW_TC + (tl - 15) + q) * 1024] = ykeep;
                    __builtin_amdgcn_sched_barrier(0);
                    r4 = nr; w4 = nw; k4 = nk; a4 = na; b4 = nb; vv = nv;
                }
                __syncthreads();
            }
        }
    }
}

constexpr int RC = 16, RNCH = SEQ_T / RC;
constexpr int RS_AT = 0, RS_RT = 2048, RS_BKT = 4096, RS_AKP = 8192, RS_BRP = 9216, RS_TP = 10240, RS_VT = 11264, RS_WC = 11776, RS_SLOT = 12032;
constexpr int RS_SCR = 8 * RS_SLOT, RS_ST = RS_SCR + 7 * 4096;
static_assert(RS_ST + 16 * 72 * 2 + 128 <= LDS_STAGE, "rwkv chunk LDS overflow");
__device__ __forceinline__ float wave_sum64(float x) {
    x = sum16(x);
    unsigned xi = __float_as_uint(x);
    const auto r = __builtin_amdgcn_permlane16_swap(xi, xi, false, false);
    x = __uint_as_float(r[0]) + __uint_as_float(r[1]);
    xi = __float_as_uint(x);
    const auto r2 = __builtin_amdgcn_permlane32_swap(xi, xi, false, false);
    return __uint_as_float(r2[0]) + __uint_as_float(r2[1]);
}
__device__ __forceinline__ bf16x8 mk_frag(unsigned a, unsigned b, unsigned c, unsigned d) { const uint4 u = make_uint4(a, b, c, d); return __builtin_bit_cast(bf16x8, u); }
template <int L>
__device__ __forceinline__ float rw_nfetch(int g, float dep) {
    int r;
    asm volatile("v_readlane_b32 %0, %1, %2\n\ts_nop 0" : "=s"(r) : "v"(g), "n"(L), "v"(dep));
    return __int_as_float(r);
}
struct RwStg {
    float W, pr, pk, pv;
    float bt[16], kt[16];
    unsigned short nr[4], nk[4], nv[4], na[4]; float nw[4];
    unsigned short ppr, ppk, ppv;
    int gx, gy, gz, gw;
};
__device__ __forceinline__ void rwkv_chunk_phase(const Params& p, char* smem) {
    const bf16_t* P = (const bf16_t*)(p.ws + OFF_P);
    const float* Wd = (const float*)(p.ws + OFF_X);
    const unsigned short* Ai = (const unsigned short*)(p.ws + OFF_Y);
    float* Y = p.out;
    const float* mu = p.in[4]; const float* k_k = p.in[9]; const float* k_a = p.in[10];
    const int tid = otid(), lane = tid & 63, wid = __builtin_amdgcn_readfirstlane(tid >> 6), fr = lane & 15, fq = lane >> 4;
    for (int unit = blockIdx.x; unit < 256; unit += gridDim.x) {
        const int bh = unit >> 2, rg = unit & 3, b = bh >> 4, h = bh & 15;
        const size_t tokbase = (size_t)b * SEQ_T;
        __syncthreads();
        f32x4 accS[4];
#pragma unroll
        for (int i = 0; i < 4; ++i) accS[i] = (f32x4){0.f, 0.f, 0.f, 0.f};
        RwStg st; st.W = 1.f; st.pr = 0.f; st.pk = 0.f; st.pv = 0.f;
        const int col = h * 64 + lane;
        const float mur = mu[col], muk = mu[1024 + col], muv = mu[2048 + col], kkc = k_k[col], kac = k_a[col];
        const int sw = wid - 1;
        bf16_t* BTs = (bf16_t*)(smem + RS_SCR + (sw < 0 ? 0 : sw) * 4096);
        bf16_t* KTs = BTs + 1024;
        const bf16_t* Pl = P + tokbase * RW_COLS + col; const float* Wl = Wd + tokbase * 1024 + col; const unsigned short* Al = Ai + tokbase * 1024 + col;
#define RW_LD(S, TOK) do { const unsigned tr_ = (unsigned)__builtin_amdgcn_readfirstlane((int)((TOK) - tokbase)); const bf16_t* pr_ = Pl + tr_ * (unsigned)RW_COLS; st.nr[S] = pr_[0]; st.nk[S] = pr_[1024]; st.nv[S] = pr_[2048]; \
            st.nw[S] = Wl[tr_ * 1024u]; st.na[S] = Al[tr_ * 1024u]; } while (0)
#define RW_LDPREV(CH) do { const int ch_ = (CH); const unsigned tr_ = (unsigned)__builtin_amdgcn_readfirstlane(ch_ > 0 ? ch_ * RC - 1 : 0); const bf16_t* pp_ = Pl + tr_ * (unsigned)RW_COLS; \
            st.ppr = pp_[0]; st.ppk = pp_[1024]; st.ppv = pp_[2048]; } while (0)
        if (wid == 0) {
            for (int i = lane; i < 16 * 72 / 2; i += 64) *(unsigned*)(smem + RS_ST + i * 4) = 0u;
        } else {
            const int c0 = (sw < RNCH) ? sw : RNCH - 1;
            RW_LD(0, tokbase + (size_t)c0 * RC + 0); RW_LD(1, tokbase + (size_t)c0 * RC + 1); RW_LD(2, tokbase + (size_t)c0 * RC + 2); RW_LD(3, tokbase + (size_t)c0 * RC + 3); RW_LDPREV(c0);
        }
        __syncthreads();
        if (wid == 0) {
            for (int per = 0; per < RNCH + 7; ++per) {
                const int c = per - 7;
                if (c >= 0) {
                    const char* sl = smem + (c & 7) * RS_SLOT;
                    const bf16_t* STr = (const bf16_t*)(smem + RS_ST) + fr * 72 + fq * 8;
                    const bf16x8 st0 = *(const bf16x8*)(STr), st1 = *(const bf16x8*)(STr + 32);
                    const bf16_t* ATr = (const bf16_t*)(sl + RS_AT) + fr * 64 + fq * 8;
                    const bf16x8 a0 = *(const bf16x8*)(ATr), a1 = *(const bf16x8*)(ATr + 32);
                    const bf16_t* RTr = (const bf16_t*)(sl + RS_RT) + fr * 64 + fq * 8;
                    const bf16x8 r0 = *(const bf16x8*)(RTr), r1 = *(const bf16x8*)(RTr + 32);
                    const bf16x8 akp = *(const bf16x8*)((const bf16_t*)(sl + RS_AKP) + fr * 32 + fq * 8);
                    const bf16x8 brp = *(const bf16x8*)((const bf16_t*)(sl + RS_BRP) + fr * 32 + fq * 8);
                    const bf16x8 tpf = *(const bf16x8*)((const bf16_t*)(sl + RS_TP) + fr * 32 + fq * 8);
                    const uint2 vt = *(const uint2*)((const bf16_t*)(sl + RS_VT) + fr * 16 + fq * 4);
                    bf16x8 bk[4]; f32x4 wc4[4];
#pragma unroll
                    for (int kt = 0; kt < 4; ++kt) { bk[kt] = *(const bf16x8*)((const bf16_t*)(sl + RS_BKT) + (kt * 16 + fr) * 32 + fq * 8); wc4[kt] = *(const f32x4*)((const float*)(sl + RS_WC) + kt * 16 + fq * 4); }
                    f32x4 u = {0.f, 0.f, 0.f, 0.f};
                    u = __builtin_amdgcn_mfma_f32_16x16x32_bf16(a0, st0, u, 0, 0, 0);
                    u = __builtin_amdgcn_mfma_f32_16x16x32_bf16(a1, st1, u, 0, 0, 0);
                    u = __builtin_amdgcn_mfma_f32_16x16x32_bf16(akp, mk_frag(vt.x, vt.y, 0u, 0u), u, 0, 0, 0);
                    f32x4 sv = {0.f, 0.f, 0.f, 0.f};
                    sv = __builtin_amdgcn_mfma_f32_16x16x32_bf16(tpf, mk_frag(pack2bf(u.x, u.y), pack2bf(u.z, u.w), 0u, 0u), sv, 0, 0, 0);
                    const bf16x8 f3 = mk_frag(pack2bf(sv.x, sv.y), pack2bf(sv.z, sv.w), vt.x, vt.y);
                    f32x4 yv = {0.f, 0.f, 0.f, 0.f};
                    yv = __builtin_amdgcn_mfma_f32_16x16x32_bf16(st0, r0, yv, 0, 0, 0);
                    yv = __builtin_amdgcn_mfma_f32_16x16x32_bf16(st1, r1, yv, 0, 0, 0);
                    yv = __builtin_amdgcn_mfma_f32_16x16x32_bf16(f3, brp, yv, 0, 0, 0);
                    *(f32x4*)(Y + (tokbase + (size_t)c * RC + fr) * 1024 + h * 64 + rg * 16 + fq * 4) = yv;
#pragma unroll
                    for (int kt = 0; kt < 4; ++kt) {
                        accS[kt] = accS[kt] * wc4[kt];
                        accS[kt] = __builtin_amdgcn_mfma_f32_16x16x32_bf16(bk[kt], f3, accS[kt], 0, 0, 0);
                        uint2 pk; pk.x = pack2bf(accS[kt].x, accS[kt].y); pk.y = pack2bf(accS[kt].z, accS[kt].w);
                        *(uint2*)((bf16_t*)(smem + RS_ST) + fr * 72 + kt * 16 + fq * 4) = pk;
                    }
                }
                __syncthreads();
            }
        } else {
            for (int per = 0; per < RNCH + 7; ++per) {
                const int q = per - sw;
                const int c = (q >= 0) ? 7 * (q / 7) + sw : RNCH;
                if (c < RNCH) {
                    const int part = q % 7;
                    char* sl = smem + (c & 7) * RS_SLOT;
                    bf16_t* ATw = (bf16_t*)(sl + RS_AT); bf16_t* RTw = (bf16_t*)(sl + RS_RT);
                    const size_t tok0 = tokbase + (size_t)c * RC;
                    unsigned short cr[4], ck[4], cv[4], ca[4]; float cw[4];
#pragma unroll
                    for (int i = 0; i < 4; ++i) { cr[i] = st.nr[i]; ck[i] = st.nk[i]; cv[i] = st.nv[i]; ca[i] = st.na[i]; cw[i] = st.nw[i]; }
#define RW_TS(J, S) do { const float r0_ = bf2f(cr[S]), k0_ = bf2f(ck[S]), v0_ = bf2f(cv[S]); const float w_ = cw[S], a_ = h2f(ca[S]); \
                        const float r1_ = r0_ + (st.pr - r0_) * mur, k1_ = k0_ + (st.pk - k0_) * muk, v1_ = v0_ + (st.pv - v0_) * muv; st.pr = r0_; st.pk = k0_; st.pv = v0_; \
                        const float kkv_ = k1_ * kkc; const float n2_ = wave_sum64(kkv_ * kkv_); const float kk_ = kkv_ * rsqrtf(fmaxf(n2_, 1e-24f)); \
                        const float k2_ = k1_ * (1.f + (a_ - 1.f) * kac); \
                        const float at_ = -kk_ * st.W; st.W *= w_; const float rt_ = r1_ * st.W; const float iw_ = __builtin_amdgcn_rcpf(st.W); \
                        const float bt_ = kk_ * a_ * iw_, kt_ = k2_ * iw_; st.bt[J] = bt_; st.kt[J] = kt_; \
                        ATw[(J) * 64 + lane] = f2bf(at_); RTw[(J) * 64 + lane] = f2bf(rt_); BTs[(J) * 64 + lane] = f2bf(bt_); KTs[(J) * 64 + lane] = f2bf(kt_); \
                        *((fq == rg) ? ((bf16_t*)(sl + RS_VT) + fr * 16 + (J)) : ((bf16_t*)(smem + RS_ST + 2304) + lane)) = f2bf(v1_); } while (0)
                    switch (part) {
                    case 0: {
                        RW_LD(0, tok0 + 4); RW_LD(1, tok0 + 5); RW_LD(2, tok0 + 6); RW_LD(3, tok0 + 7);
                        st.W = 1.f;
                        if (c > 0) { st.pr = bf2f(st.ppr); st.pk = bf2f(st.ppk); st.pv = bf2f(st.ppv); } else { st.pr = 0.f; st.pk = 0.f; st.pv = 0.f; }
                        RW_TS(0, 0); RW_TS(1, 1); RW_TS(2, 2); RW_TS(3, 3);
                    } break;
                    case 1: { RW_LD(0, tok0 + 8); RW_LD(1, tok0 + 9); RW_LD(2, tok0 + 10); RW_LD(3, tok0 + 11); RW_TS(4, 0); RW_TS(5, 1); RW_TS(6, 2); RW_TS(7, 3); } break;
                    case 2: { RW_LD(0, tok0 + 12); RW_LD(1, tok0 + 13); RW_LD(2, tok0 + 14); RW_LD(3, tok0 + 15); RW_TS(8, 0); RW_TS(9, 1); RW_TS(10, 2); RW_TS(11, 3); } break;
                    case 3: {
                        RW_TS(12, 0); RW_TS(13, 1); RW_TS(14, 2); RW_TS(15, 3);
                        const float WC = st.W;
                        ((float*)(sl + RS_WC))[lane] = WC;
                        bf16_t* BKw = (bf16_t*)(sl + RS_BKT) + lane * 32;
#define RW_BKG(G) do { uint4 o; \
                            o.x = pack2bf(st.bt[4 * (G) + 0] * WC, st.bt[4 * (G) + 1] * WC); o.y = pack2bf(st.bt[4 * (G) + 2] * WC, st.bt[4 * (G) + 3] * WC); \
                            o.z = pack2bf(st.kt[4 * (G) + 0] * WC, st.kt[4 * (G) + 1] * WC); o.w = pack2bf(st.kt[4 * (G) + 2] * WC, st.kt[4 * (G) + 3] * WC); \
                            *(uint4*)(BKw + (G) * 8) = o; } while (0)
                        RW_BKG(0); RW_BKG(1); RW_BKG(2); RW_BKG(3);
#undef RW_BKG
                    } break;
                    case 4: {
                        const bf16_t* ATr = ATw + fr * 64 + fq * 8; const bf16_t* RTr = RTw + fr * 64 + fq * 8; const bf16_t* BTr = BTs + fr * 64 + fq * 8; const bf16_t* KTr = KTs + fr * 64 + fq * 8;
                        const bf16x8 a0 = *(const bf16x8*)(ATr), a1 = *(const bf16x8*)(ATr + 32), r0 = *(const bf16x8*)(RTr), r1 = *(const bf16x8*)(RTr + 32);
                        const bf16x8 b0 = *(const bf16x8*)(BTr), b1 = *(const bf16x8*)(BTr + 32), k0 = *(const bf16x8*)(KTr), k1 = *(const bf16x8*)(KTr + 32);
                        f32x4 gab = {0.f, 0.f, 0.f, 0.f}, gak = gab, grb = gab, grk = gab;
                        gab = __builtin_amdgcn_mfma_f32_16x16x32_bf16(b0, a0, gab, 0, 0, 0); gab = __builtin_amdgcn_mfma_f32_16x16x32_bf16(b1, a1, gab, 0, 0, 0);
                        gak = __builtin_amdgcn_mfma_f32_16x16x32_bf16(k0, a0, gak, 0, 0, 0); gak = __builtin_amdgcn_mfma_f32_16x16x32_bf16(k1, a1, gak, 0, 0, 0);
                        grb = __builtin_amdgcn_mfma_f32_16x16x32_bf16(b0, r0, grb, 0, 0, 0); grb = __builtin_amdgcn_mfma_f32_16x16x32_bf16(b1, r1, grb, 0, 0, 0);
                        grk = __builtin_amdgcn_mfma_f32_16x16x32_bf16(k0, r0, grk, 0, 0, 0); grk = __builtin_amdgcn_mfma_f32_16x16x32_bf16(k1, r1, grk, 0, 0, 0);
                        const int j0 = fq * 4;
                        gab.x = (j0 + 0 < fr) ? gab.x : 0.f; gab.y = (j0 + 1 < fr) ? gab.y : 0.f; gab.z = (j0 + 2 < fr) ? gab.z : 0.f; gab.w = (j0 + 3 < fr) ? gab.w : 0.f;
                        gak.x = (j0 + 0 < fr) ? gak.x : 0.f; gak.y = (j0 + 1 < fr) ? gak.y : 0.f; gak.z = (j0 + 2 < fr) ? gak.z : 0.f; gak.w = (j0 + 3 < fr) ? gak.w : 0.f;
                        grb.x = (j0 + 0 <= fr) ? grb.x : 0.f; grb.y = (j0 + 1 <= fr) ? grb.y : 0.f; grb.z = (j0 + 2 <= fr) ? grb.z : 0.f; grb.w = (j0 + 3 <= fr) ? grb.w : 0.f;
                        grk.x = (j0 + 0 <= fr) ? grk.x : 0.f; grk.y = (j0 + 1 <= fr) ? grk.y : 0.f; grk.z = (j0 + 2 <= fr) ? grk.z : 0.f; grk.w = (j0 + 3 <= fr) ? grk.w : 0.f;
                        *(uint4*)((bf16_t*)(sl + RS_AKP) + fr * 32 + fq * 8) = make_uint4(pack2bf(gak.x, gak.y), pack2bf(gak.z, gak.w), 0u, 0u);
                        *(uint4*)((bf16_t*)(sl + RS_BRP) + fr * 32 + fq * 8) = make_uint4(pack2bf(grb.x, grb.y), pack2bf(grb.z, grb.w), pack2bf(grk.x, grk.y), pack2bf(grk.z, grk.w));
                        st.gx = __float_as_int(gab.x); st.gy = __float_as_int(gab.y); st.gz = __float_as_int(gab.z); st.gw = __float_as_int(gab.w);
                    } break;
#define RW_GSEL(J) ((((J) & 3) == 0) ? st.gx : ((((J) & 3) == 1) ? st.gy : ((((J) & 3) == 2) ? st.gz : st.gw)))
#define RW_TJ(T, J) do { if ((J) < (T)) acc = fmaf(rw_nfetch<(T) + 16 * ((J) >> 2)>(RW_GSEL(J), acc), Tr[(J)], acc); } while (0)
#define RW_TROW(T) do { float acc = ((T) == fr) ? 1.f : 0.f; RW_TJ(T, 0); RW_TJ(T, 1); RW_TJ(T, 2); RW_TJ(T, 3); RW_TJ(T, 4); RW_TJ(T, 5); RW_TJ(T, 6); RW_TJ(T, 7); \
                        RW_TJ(T, 8); RW_TJ(T, 9); RW_TJ(T, 10); RW_TJ(T, 11); RW_TJ(T, 12); RW_TJ(T, 13); RW_TJ(T, 14); RW_TJ(T, 15); Tr[(T)] = acc; } while (0)
                    case 5: {
                        float Tr[16];
                        RW_TROW(0); RW_TROW(1); RW_TROW(2); RW_TROW(3); RW_TROW(4); RW_TROW(5); RW_TROW(6); RW_TROW(7); RW_TROW(8); RW_TROW(9); RW_TROW(10);
                        float* TS_ = (float*)BTs + lane;
#define RW_TSV(T) TS_[(T) * 64] = Tr[(T)]
                        RW_TSV(0); RW_TSV(1); RW_TSV(2); RW_TSV(3); RW_TSV(4); RW_TSV(5); RW_TSV(6); RW_TSV(7); RW_TSV(8); RW_TSV(9); RW_TSV(10);
#undef RW_TSV
                    } break;
                    default: {
                        { const int cn = (c + 7 < RNCH) ? c + 7 : c; const size_t tn = tokbase + (size_t)cn * RC; RW_LD(0, tn + 0); RW_LD(1, tn + 1); RW_LD(2, tn + 2); RW_LD(3, tn + 3); RW_LDPREV(cn); }
                        float Tr[16];
                        const float* TS_ = (const float*)BTs + lane;
#define RW_TLD(T) Tr[(T)] = TS_[(T) * 64]
                        RW_TLD(0); RW_TLD(1); RW_TLD(2); RW_TLD(3); RW_TLD(4); RW_TLD(5); RW_TLD(6); RW_TLD(7); RW_TLD(8); RW_TLD(9); RW_TLD(10);
#undef RW_TLD
                        RW_TROW(11); RW_TROW(12); RW_TROW(13); RW_TROW(14); RW_TROW(15);
                        if (fq < 2) {
                            bf16_t* TPw = (bf16_t*)(sl + RS_TP) + (fr >> 2) * 8 + (fr & 3) + fq * 4;
#define RW_TPW(T) TPw[(T) * 32] = (fq == 0) ? f2bf(Tr[(T)]) : (bf16_t)0
                            RW_TPW(0); RW_TPW(1); RW_TPW(2); RW_TPW(3); RW_TPW(4); RW_TPW(5); RW_TPW(6); RW_TPW(7); RW_TPW(8); RW_TPW(9); RW_TPW(10); RW_TPW(11); RW_TPW(12); RW_TPW(13); RW_TPW(14); RW_TPW(15);
#undef RW_TPW
                        }
                    } break;
#undef RW_TROW
#undef RW_TJ
#undef RW_GSEL
                    }
#undef RW_TS
                }
                __syncthreads();
            }
        }
#undef RW_LD
#undef RW_LDPREV
    }
}

__device__ __forceinline__ float half_sum32(float v);
__device__ __forceinline__ void rwkv_elem_phase(const Params& p) {
    bf16_t* P = (bf16_t*)(p.ws + OFF_P);
    float* Wd = (float*)(p.ws + OFF_X);
    unsigned short* Ai = (unsigned short*)(p.ws + OFF_Y);
    bf16_t* KT2 = (bf16_t*)p.out + (size_t)M_TOK * 1024;
    float* BON = (float*)(p.ws + OFF_LIN);
    const float* mu = p.in[4]; const float* k_k = p.in[9]; const float* k_a = p.in[10]; const float* r_k = p.in[11];
    const int tid = otid(), lane = tid & 63, wid = __builtin_amdgcn_readfirstlane(tid >> 6);
    const int gw = blockIdx.x * 8 + wid, ngw = gridDim.x * 8;
    for (int u = gw; u < 64 * RNCH; u += ngw) {
        const int bh = u >> 9, c = u & (RNCH - 1), b = bh >> 4, h = bh & 15, col = h * 64 + lane;
        const size_t tok0 = (size_t)b * SEQ_T + (size_t)c * RC;
        const float mur = mu[col], muk = mu[1024 + col], kkc = k_k[col], kac = k_a[col], rkc = r_k[col];
        unsigned short rr[16], rk[16], ra[16]; float rw[16];
        const bf16_t* pr = P + tok0 * RW_COLS + col;
        const bf16_t* pp = (c > 0) ? pr - RW_COLS : pr;
        const unsigned short p0r = pp[0], p0k = pp[1024];
#pragma unroll
        for (int j = 0; j < 16; ++j) { rr[j] = pr[(size_t)j * RW_COLS]; rk[j] = pr[(size_t)j * RW_COLS + 1024]; rw[j] = Wd[(tok0 + j) * 1024 + col]; ra[j] = Ai[(tok0 + j) * 1024 + col]; }
        asm volatile("s_waitcnt vmcnt(0)" ::: "memory");
        float W = 1.f, prv = (c > 0) ? bf2f(p0r) : 0.f, pkv = (c > 0) ? bf2f(p0k) : 0.f;
#pragma unroll
        for (int j = 0; j < 16; ++j) {
            const float r0 = bf2f(rr[j]), k0 = bf2f(rk[j]), w = rw[j], a = h2f(ra[j]);
            const float r1 = r0 + (prv - r0) * mur, k1 = k0 + (pkv - k0) * muk; prv = r0; pkv = k0;
            const float kkv = k1 * kkc; const float n2 = wave_sum64(kkv * kkv); const float kk = kkv * rsqrtf(fmaxf(n2, 1e-24f));
            const float k2 = k1 * (1.f + (a - 1.f) * kac);
            const float bon = wave_sum64(r1 * k2 * rkc);
            const float at = -kk * W; W *= w; const float rt = r1 * W; const float iw = __builtin_amdgcn_rcpf(W);
            const float bt = kk * a * iw, kt = k2 * iw;
            bf16_t* ar = (bf16_t*)(Wd + (tok0 + j) * 1024 + h * 64);
            ar[lane] = f2bf(at); ar[64 + lane] = f2bf(rt);
            Ai[(tok0 + j) * 1024 + col] = f2bf(bt);
            KT2[(tok0 + j) * 1024 + col] = f2bf(kt);
            if (lane == 0) BON[(tok0 + j) * 16 + h] = bon;
        }
        ((float*)(P + (tok0 + h) * RW_COLS + 3072))[lane] = W;
    }
}
#ifndef XLAS
#define XLAS __attribute__((address_space(3)))
#endif
struct RwStg2 { int gx, gy, gz, gw; };
__device__ __forceinline__ void rwkv_chunk2_phase(const Params& p, char* smem) {
    const bf16_t* P = (const bf16_t*)(p.ws + OFF_P);
    const char* WdB = (const char*)(p.ws + OFF_X);
    const bf16_t* BT2 = (const bf16_t*)(p.ws + OFF_Y);
    const bf16_t* KT2 = (const bf16_t*)p.out + (size_t)M_TOK * 1024;
    bf16_t* Yb = (bf16_t*)p.out;
    const float* mu = p.in[4];
    const int tid = otid(), lane = tid & 63, wid = __builtin_amdgcn_readfirstlane(tid >> 6), fr = lane & 15, fq = lane >> 4;
    for (int unit = blockIdx.x; unit < 256; unit += gridDim.x) {
        const int bh = unit >> 2, rg = unit & 3, b = bh >> 4, h = bh & 15;
        const size_t tokbase = (size_t)b * SEQ_T;
        __syncthreads();
        f32x4 accS[4];
#pragma unroll
        for (int i = 0; i < 4; ++i) accS[i] = (f32x4){0.f, 0.f, 0.f, 0.f};
        RwStg2 st; st.gx = 0; st.gy = 0; st.gz = 0; st.gw = 0;
        const int sw = wid - 1;
        const int scr_off = RS_SCR + (sw < 0 ? 0 : sw) * 4096;
        bf16_t* BTs = (bf16_t*)(smem + scr_off);
        bf16_t* KTs = BTs + 1024;
        const float muv = mu[2048 + h * 64 + rg * 16 + fr];
        if (wid == 0) {
            for (int i = lane; i < 16 * 72 / 2; i += 64) *(unsigned*)(smem + RS_ST + i * 4) = 0u;
        }
        __syncthreads();
        if (wid == 0) {
            __builtin_amdgcn_s_setprio(2);
            bf16x8 pa0 = {}, pa1 = {}, pr0 = {}, pr1 = {}, pakp = {}, pbrp = {}; uint2 pvt = make_uint2(0u, 0u); bf16x8 pbk[4] = {}; f32x4 pwc[4] = {};
            for (int per = 0; per < RNCH + 7; ++per) {
                const int c = per - 7;
                if (c >= 0) {
                    const char* sl = smem + (c & 7) * RS_SLOT;
                    const bf16_t* STr = (const bf16_t*)(smem + RS_ST) + fr * 72 + fq * 8;
                    const bf16x8 st0 = *(const bf16x8*)(STr), st1 = *(const bf16x8*)(STr + 32);
                    const bf16x8 tpf = *(const bf16x8*)((const bf16_t*)(sl + RS_TP) + fr * 32 + fq * 8);
                    const bf16x8 a0 = pa0, a1 = pa1, r0 = pr0, r1 = pr1, akp = pakp, brp = pbrp; const uint2 vt = pvt;
                    f32x4 u = {0.f, 0.f, 0.f, 0.f};
                    u = __builtin_amdgcn_mfma_f32_16x16x32_bf16(a0, st0, u, 0, 0, 0);
                    u = __builtin_amdgcn_mfma_f32_16x16x32_bf16(a1, st1, u, 0, 0, 0);
                    u = __builtin_amdgcn_mfma_f32_16x16x32_bf16(akp, mk_frag(vt.x, vt.y, 0u, 0u), u, 0, 0, 0);
                    f32x4 sv = {0.f, 0.f, 0.f, 0.f};
                    sv = __builtin_amdgcn_mfma_f32_16x16x32_bf16(tpf, mk_frag(pack2bf(u.x, u.y), pack2bf(u.z, u.w), 0u, 0u), sv, 0, 0, 0);
                    const bf16x8 f3 = mk_frag(pack2bf(sv.x, sv.y), pack2bf(sv.z, sv.w), vt.x, vt.y);
                    f32x4 yv = {0.f, 0.f, 0.f, 0.f};
                    yv = __builtin_amdgcn_mfma_f32_16x16x32_bf16(st0, r0, yv, 0, 0, 0);
                    yv = __builtin_amdgcn_mfma_f32_16x16x32_bf16(st1, r1, yv, 0, 0, 0);
                    yv = __builtin_amdgcn_mfma_f32_16x16x32_bf16(f3, brp, yv, 0, 0, 0);
                    { uint2 py; py.x = pack2bf(yv.x, yv.y); py.y = pack2bf(yv.z, yv.w); *(uint2*)(Yb + (tokbase + (size_t)c * RC + fr) * 1024 + h * 64 + rg * 16 + fq * 4) = py; }
#pragma unroll
                    for (int kt = 0; kt < 4; ++kt) {
                        accS[kt] = accS[kt] * pwc[kt];
                        accS[kt] = __builtin_amdgcn_mfma_f32_16x16x32_bf16(pbk[kt], f3, accS[kt], 0, 0, 0);
                        uint2 pk; pk.x = pack2bf(accS[kt].x, accS[kt].y); pk.y = pack2bf(accS[kt].z, accS[kt].w);
                        *(uint2*)((bf16_t*)(smem + RS_ST) + fr * 72 + kt * 16 + fq * 4) = pk;
                    }
                }
                if (c + 1 >= 0 && c + 1 < RNCH) {
                    const char* sn = smem + ((c + 1) & 7) * RS_SLOT;
                    const bf16_t* ATr = (const bf16_t*)(sn + RS_AT) + fr * 128;
                    pa0 = *(const bf16x8*)(ATr + ((fq) ^ fr) * 8); pa1 = *(const bf16x8*)(ATr + ((4 + fq) ^ fr) * 8);
                    pr0 = *(const bf16x8*)(ATr + ((8 + fq) ^ fr) * 8); pr1 = *(const bf16x8*)(ATr + ((12 + fq) ^ fr) * 8);
                    pakp = *(const bf16x8*)((const bf16_t*)(sn + RS_AKP) + fr * 32 + fq * 8);
                    pbrp = *(const bf16x8*)((const bf16_t*)(sn + RS_BRP) + fr * 32 + fq * 8);
                    pvt = *(const uint2*)((const bf16_t*)(sn + RS_VT) + fr * 16 + fq * 4);
#pragma unroll
                    for (int kt = 0; kt < 4; ++kt) { pbk[kt] = *(const bf16x8*)((const bf16_t*)(sn + RS_BKT) + (kt * 16 + fr) * 32 + fq * 8); pwc[kt] = *(const f32x4*)((const float*)(sn + RS_WC) + kt * 16 + fq * 4); }
                }
                asm volatile("s_waitcnt lgkmcnt(0)" ::: "memory"); __builtin_amdgcn_s_barrier(); asm volatile("" ::: "memory");
            }
            __builtin_amdgcn_s_setprio(0);
        } else {
            for (int per = 0; per < RNCH + 7; ++per) {
                const int q = per - sw;
                const int c = (q >= 0) ? 7 * (q / 7) + sw : RNCH;
                if (c < RNCH) {
                    const int part = q % 7;
                    const int sl_off = (c & 7) * RS_SLOT;
                    char* sl = smem + sl_off;
                    bf16_t* ATw = (bf16_t*)(sl + RS_AT);
                    switch (part) {
                    case 0: {
                        const size_t t0 = tokbase + (size_t)c * RC;
#pragma unroll
                        for (int i = 0; i < 4; ++i)
                            __builtin_amdgcn_global_load_lds((const unsigned*)(WdB + ((t0 + i * 4 + fq) * 1024 + h * 64) * 4 + (fr ^ (i * 4 + fq)) * 16), (XLAS unsigned*)(smem + sl_off + RS_AT + i * 1024), 16, 0, 0);
                        __builtin_amdgcn_global_load_lds((const unsigned*)((const float*)(P + (t0 + h) * RW_COLS + 3072) + lane), (XLAS unsigned*)(smem + sl_off + RS_WC), 4, 0, 0);
                    } break;
                    case 1: {
                        const size_t t0 = tokbase + (size_t)c * RC;
#pragma unroll
                        for (int i = 0; i < 2; ++i) {
                            const size_t o = (t0 + i * 8 + (lane >> 3)) * 1024 + h * 64 + (lane & 7) * 8;
                            __builtin_amdgcn_global_load_lds((const unsigned*)(BT2 + o), (XLAS unsigned*)(smem + scr_off + i * 1024), 16, 0, 0);
                            __builtin_amdgcn_global_load_lds((const unsigned*)(KT2 + o), (XLAS unsigned*)(smem + scr_off + 2048 + i * 1024), 16, 0, 0);
                        }
#pragma unroll
                        for (int i = 0; i < 3; ++i) {
                            const int idx = i * 64 + lane; int row = idx >> 3; row = row > 16 ? 16 : row; const int dwq = idx & 7;
                            int tt = c * RC - 1 + row; tt = tt < 0 ? 0 : tt;
                            __builtin_amdgcn_global_load_lds((const unsigned*)(P + (tokbase + tt) * RW_COLS + 2048 + h * 64 + rg * 16 + dwq * 2), (XLAS unsigned*)(smem + sl_off + RS_TP + i * 256), 4, 0, 0);
                        }
                    } break;
                    case 2: {
                        asm volatile("s_waitcnt vmcnt(0)" ::: "memory");
                    } break;
                    case 3: {
                        { const unsigned short* vr = (const unsigned short*)(sl + RS_TP) + (fq * 4) * 16 + fr;
                          const float pv = (c == 0 && fq == 0) ? 0.f : bf2f(vr[0]);
                          const float v0 = bf2f(vr[16]), v1 = bf2f(vr[32]), v2 = bf2f(vr[48]), v3 = bf2f(vr[64]);
                          uint2 o; o.x = pack2bf(v0 + (pv - v0) * muv, v1 + (v0 - v1) * muv); o.y = pack2bf(v2 + (v1 - v2) * muv, v3 + (v2 - v3) * muv);
                          *(uint2*)((bf16_t*)(sl + RS_VT) + fr * 16 + fq * 4) = o; }
                        const float WC = ((const float*)(sl + RS_WC))[lane];
                        bf16_t* BKw = (bf16_t*)(sl + RS_BKT) + lane * 32;
#define RW_BKG(G) do { uint4 o; \
                            o.x = pack2bf(bf2f(BTs[(4 * (G) + 0) * 64 + lane]) * WC, bf2f(BTs[(4 * (G) + 1) * 64 + lane]) * WC); o.y = pack2bf(bf2f(BTs[(4 * (G) + 2) * 64 + lane]) * WC, bf2f(BTs[(4 * (G) + 3) * 64 + lane]) * WC); \
                            o.z = pack2bf(bf2f(KTs[(4 * (G) + 0) * 64 + lane]) * WC, bf2f(KTs[(4 * (G) + 1) * 64 + lane]) * WC); o.w = pack2bf(bf2f(KTs[(4 * (G) + 2) * 64 + lane]) * WC, bf2f(KTs[(4 * (G) + 3) * 64 + lane]) * WC); \
                            *(uint4*)(BKw + (G) * 8) = o; } while (0)
                        RW_BKG(0); RW_BKG(1); RW_BKG(2); RW_BKG(3);
#undef RW_BKG
                    } break;
                    case 4: {
                        const bf16_t* ATr = ATw + fr * 128; const bf16_t* BTr = BTs + fr * 64 + fq * 8; const bf16_t* KTr = KTs + fr * 64 + fq * 8;
                        const bf16x8 a0 = *(const bf16x8*)(ATr + ((fq) ^ fr) * 8), a1 = *(const bf16x8*)(ATr + ((4 + fq) ^ fr) * 8), r0 = *(const bf16x8*)(ATr + ((8 + fq) ^ fr) * 8), r1 = *(const bf16x8*)(ATr + ((12 + fq) ^ fr) * 8);
                        const bf16x8 b0 = *(const bf16x8*)(BTr), b1 = *(const bf16x8*)(BTr + 32), k0 = *(const bf16x8*)(KTr), k1 = *(const bf16x8*)(KTr + 32);
                        f32x4 gab = {0.f, 0.f, 0.f, 0.f}, gak = gab, grb = gab, grk = gab;
                        gab = __builtin_amdgcn_mfma_f32_16x16x32_bf16(b0, a0, gab, 0, 0, 0); gab = __builtin_amdgcn_mfma_f32_16x16x32_bf16(b1, a1, gab, 0, 0, 0);
                        gak = __builtin_amdgcn_mfma_f32_16x16x32_bf16(k0, a0, gak, 0, 0, 0); gak = __builtin_amdgcn_mfma_f32_16x16x32_bf16(k1, a1, gak, 0, 0, 0);
                        grb = __builtin_amdgcn_mfma_f32_16x16x32_bf16(b0, r0, grb, 0, 0, 0); grb = __builtin_amdgcn_mfma_f32_16x16x32_bf16(b1, r1, grb, 0, 0, 0);
                        grk = __builtin_amdgcn_mfma_f32_16x16x32_bf16(k0, r0, grk, 0, 0, 0); grk = __builtin_amdgcn_mfma_f32_16x16x32_bf16(k1, r1, grk, 0, 0, 0);
                        const int j0 = fq * 4;
                        gab.x = (j0 + 0 < fr) ? gab.x : 0.f; gab.y = (j0 + 1 < fr) ? gab.y : 0.f; gab.z = (j0 + 2 < fr) ? gab.z : 0.f; gab.w = (j0 + 3 < fr) ? gab.w : 0.f;
                        gak.x = (j0 + 0 < fr) ? gak.x : 0.f; gak.y = (j0 + 1 < fr) ? gak.y : 0.f; gak.z = (j0 + 2 < fr) ? gak.z : 0.f; gak.w = (j0 + 3 < fr) ? gak.w : 0.f;
                        grb.x = (j0 + 0 <= fr) ? grb.x : 0.f; grb.y = (j0 + 1 <= fr) ? grb.y : 0.f; grb.z = (j0 + 2 <= fr) ? grb.z : 0.f; grb.w = (j0 + 3 <= fr) ? grb.w : 0.f;
                        grk.x = (j0 + 0 <= fr) ? grk.x : 0.f; grk.y = (j0 + 1 <= fr) ? grk.y : 0.f; grk.z = (j0 + 2 <= fr) ? grk.z : 0.f; grk.w = (j0 + 3 <= fr) ? grk.w : 0.f;
                        *(uint4*)((bf16_t*)(sl + RS_AKP) + fr * 32 + fq * 8) = make_uint4(pack2bf(gak.x, gak.y), pack2bf(gak.z, gak.w), 0u, 0u);
                        *(uint4*)((bf16_t*)(sl + RS_BRP) + fr * 32 + fq * 8) = make_uint4(pack2bf(grb.x, grb.y), pack2bf(grb.z, grb.w), pack2bf(grk.x, grk.y), pack2bf(grk.z, grk.w));
                        st.gx = __float_as_int(gab.x); st.gy = __float_as_int(gab.y); st.gz = __float_as_int(gab.z); st.gw = __float_as_int(gab.w);
                    } break;
#define RW_GSEL(J) ((((J) & 3) == 0) ? st.gx : ((((J) & 3) == 1) ? st.gy : ((((J) & 3) == 2) ? st.gz : st.gw)))
#define RW_TJ(T, J) do { if ((J) < (T)) { const float n_ = rw_nfetch<(T) + 16 * ((J) >> 2)>(RW_GSEL(J), rowdep); if ((J) & 1) acc1 = fmaf(n_, Tr[(J)], acc1); else acc0 = fmaf(n_, Tr[(J)], acc0); } } while (0)
#define RW_TROW(T) do { float acc0 = ((T) == fr) ? 1.f : 0.f, acc1 = 0.f; RW_TJ(T, 0); RW_TJ(T, 1); RW_TJ(T, 2); RW_TJ(T, 3); RW_TJ(T, 4); RW_TJ(T, 5); RW_TJ(T, 6); RW_TJ(T, 7); \
                        RW_TJ(T, 8); RW_TJ(T, 9); RW_TJ(T, 10); RW_TJ(T, 11); RW_TJ(T, 12); RW_TJ(T, 13); RW_TJ(T, 14); RW_TJ(T, 15); Tr[(T)] = acc0 + acc1; rowdep = Tr[(T)]; } while (0)
                    case 5: {
                        float Tr[16]; float rowdep = 0.f;
                        RW_TROW(0); RW_TROW(1); RW_TROW(2); RW_TROW(3); RW_TROW(4); RW_TROW(5); RW_TROW(6); RW_TROW(7); RW_TROW(8); RW_TROW(9); RW_TROW(10);
                        float* TS_ = (float*)BTs + lane;
#define RW_TSV(T) TS_[(T) * 64] = Tr[(T)]
                        RW_TSV(0); RW_TSV(1); RW_TSV(2); RW_TSV(3); RW_TSV(4); RW_TSV(5); RW_TSV(6); RW_TSV(7); RW_TSV(8); RW_TSV(9); RW_TSV(10);
#undef RW_TSV
                    } break;
                    default: {
                        float Tr[16]; float rowdep = 0.f;
                        const float* TS_ = (const float*)BTs + lane;
#define RW_TLD(T) Tr[(T)] = TS_[(T) * 64]
                        RW_TLD(0); RW_TLD(1); RW_TLD(2); RW_TLD(3); RW_TLD(4); RW_TLD(5); RW_TLD(6); RW_TLD(7); RW_TLD(8); RW_TLD(9); RW_TLD(10);
#undef RW_TLD
                        RW_TROW(11); RW_TROW(12); RW_TROW(13); RW_TROW(14); RW_TROW(15);
                        if (fq < 2) {
                            bf16_t* TPw = (bf16_t*)(sl + RS_TP) + (fr >> 2) * 8 + (fr & 3) + fq * 4;
#define RW_TPW(T) TPw[(T) * 32] = (fq == 0) ? f2bf(Tr[(T)]) : (bf16_t)0
                            RW_TPW(0); RW_TPW(1); RW_TPW(2); RW_TPW(3); RW_TPW(4); RW_TPW(5); RW_TPW(6); RW_TPW(7); RW_TPW(8); RW_TPW(9); RW_TPW(10); RW_TPW(11); RW_TPW(12); RW_TPW(13); RW_TPW(14); RW_TPW(15);
#undef RW_TPW
                        }
                    } break;
#undef RW_TROW
#undef RW_TJ
#undef RW_GSEL
                    }
                }
                asm volatile("s_waitcnt lgkmcnt(0)" ::: "memory"); __builtin_amdgcn_s_barrier(); asm volatile("" ::: "memory");
            }
        }
    }
}
__device__ __forceinline__ void rwkv_post2_phase(const Params& p) {
    const bf16_t* P = (const bf16_t*)(p.ws + OFF_P);
    const bf16_t* Yb = (const bf16_t*)p.out;
    const float* BON = (const float*)(p.ws + OFF_LIN);
    bf16_t* Z = (bf16_t*)(p.ws + OFF_X);
    const float* mu = p.in[4];
    const int ch = otid() * 2;
    const float mv0 = mu[2048 + ch], mv1 = mu[2049 + ch], mg0 = mu[3200 + ch], mg1 = mu[3201 + ch];
    const float gg0 = p.in[12][ch], gg1 = p.in[12][ch + 1], gb0 = p.in[13][ch], gb1 = p.in[13][ch + 1];
    for (int tok = blockIdx.x; tok < M_TOK; tok += gridDim.x) {
        const bf16_t* pr = P + (size_t)tok * RW_COLS + ch;
        const unsigned uv = *(const unsigned*)(pr + 2048), ug = *(const unsigned*)(pr + 3200);
        unsigned pv_ = 0u, pg_ = 0u;
        if ((tok & (SEQ_T - 1)) != 0) { const bf16_t* pp = pr - RW_COLS; pv_ = *(const unsigned*)(pp + 2048); pg_ = *(const unsigned*)(pp + 3200); }
        const unsigned yu = *(const unsigned*)(Yb + (size_t)tok * 1024 + ch);
        const float y0 = bflo(yu), y1 = bfhi(yu);
        const float sb = BON[(size_t)tok * 16 + (ch >> 6)];
        const float v0 = bflo(uv) + (bflo(pv_) - bflo(uv)) * mv0, v1 = bfhi(uv) + (bfhi(pv_) - bfhi(uv)) * mv1;
        const float g0 = bflo(ug) + (bflo(pg_) - bflo(ug)) * mg0, g1 = bfhi(ug) + (bfhi(pg_) - bfhi(ug)) * mg1;
        const float mean = half_sum32(y0 + y1) * (1.f / 64.f);
        const float d0 = y0 - mean, d1 = y1 - mean;
        const float var = half_sum32(d0 * d0 + d1 * d1) * (1.f / 64.f);
        const float rstd = rsqrtf(var + 64e-5f);
        const float o0 = (d0 * rstd * gg0 + gb0 + sb * v0) * siluf_(g0);
        const float o1 = (d1 * rstd * gg1 + gb1 + sb * v1) * siluf_(g1);
        *(unsigned*)(Z + (size_t)tok * 1024 + ch) = pack2bf(o0, o1);
    }
}

__device__ __forceinline__ float half_sum32(float v) {
#pragma unroll
    for (int o = 1; o < 32; o <<= 1) v += __shfl_xor(v, o);
    return v;
}
__device__ __forceinline__ void rwkv_post_phase(const Params& p) {
    const bf16_t* P = (const bf16_t*)(p.ws + OFF_P);
    const unsigned short* Ai = (const unsigned short*)(p.ws + OFF_Y);
    const float* Y = p.out;
    bf16_t* Z = (bf16_t*)(p.ws + OFF_X);
    const float* mu = p.in[4];
    const int ch = otid() * 2;
    const float mr0 = mu[ch], mr1 = mu[ch + 1], mk0 = mu[1024 + ch], mk1 = mu[1025 + ch], mv0 = mu[2048 + ch], mv1 = mu[2049 + ch], mg0 = mu[3200 + ch], mg1 = mu[3201 + ch];
    const float ka0 = p.in[10][ch], ka1 = p.in[10][ch + 1], rk0 = p.in[11][ch], rk1 = p.in[11][ch + 1];
    const float gg0 = p.in[12][ch], gg1 = p.in[12][ch + 1], gb0 = p.in[13][ch], gb1 = p.in[13][ch + 1];
    for (int tok = blockIdx.x; tok < M_TOK; tok += gridDim.x) {
        const bf16_t* pr = P + (size_t)tok * RW_COLS + ch;
        const unsigned ur = *(const unsigned*)(pr), uk = *(const unsigned*)(pr + 1024), uv = *(const unsigned*)(pr + 2048), ug = *(const unsigned*)(pr + 3200);
        unsigned pr_ = 0u, pk_ = 0u, pv_ = 0u, pg_ = 0u;
        if ((tok & (SEQ_T - 1)) != 0) { const bf16_t* pp = pr - RW_COLS; pr_ = *(const unsigned*)(pp); pk_ = *(const unsigned*)(pp + 1024); pv_ = *(const unsigned*)(pp + 2048); pg_ = *(const unsigned*)(pp + 3200); }
        const unsigned ua = *(const unsigned*)(Ai + (size_t)tok * 1024 + ch);
        const float a0 = h2f((unsigned short)(ua & 0xFFFFu)), a1 = h2f((unsigned short)(ua >> 16));
        const float2 y2 = *(const float2*)(Y + (size_t)tok * 1024 + ch);
        const float r0 = bflo(ur) + (bflo(pr_) - bflo(ur)) * mr0, r1 = bfhi(ur) + (bfhi(pr_) - bfhi(ur)) * mr1;
        float k0 = bflo(uk) + (bflo(pk_) - bflo(uk)) * mk0, k1 = bfhi(uk) + (bfhi(pk_) - bfhi(uk)) * mk1;
        const float v0 = bflo(uv) + (bflo(pv_) - bflo(uv)) * mv0, v1 = bfhi(uv) + (bfhi(pv_) - bfhi(uv)) * mv1;
        const float g0 = bflo(ug) + (bflo(pg_) - bflo(ug)) * mg0, g1 = bfhi(ug) + (bfhi(pg_) - bfhi(ug)) * mg1;
        k0 = k0 * (1.f + (a0 - 1.f) * ka0); k1 = k1 * (1.f + (a1 - 1.f) * ka1);
        const float mean = half_sum32(y2.x + y2.y) * (1.f / 64.f);
        const float d0 = y2.x - mean, d1 = y2.y - mean;
        const float var = half_sum32(d0 * d0 + d1 * d1) * (1.f / 64.f);
        const float rstd = rsqrtf(var + 64e-5f);
        const float sb = half_sum32(r0 * k0 * rk0 + r1 * k1 * rk1);
        const float o0 = (d0 * rstd * gg0 + gb0 + sb * v0) * siluf_(g0);
        const float o1 = (d1 * rstd * gg1 + gb1 + sb * v1) * siluf_(g1);
        *(unsigned*)(Z + (size_t)tok * 1024 + ch) = pack2bf(o0, o1);
    }
}

constexpr int HG_TC = 32, HG_STRIDE = 272;
struct HgRaw { uint4 q, k, v; };
__device__ __forceinline__ HgRaw hg_load_raw(const bf16_t* P, size_t tok, int h, int vg, int q) {
    HgRaw r;
    const bf16_t* pr = P + tok * 4096 + h * 128 + 8 * q;
    r.q = *(const uint4*)(pr); r.k = *(const uint4*)(pr + 1024);
    r.v = *(const uint4*)(P + tok * 4096 + 2048 + h * 128 + vg * 16 + 8 * (q & 1));
    return r;
}
__device__ __forceinline__ void hg_process(const HgRaw& x, float* d, int q) {
    *(f32x4*)(d + 8 * q) = (f32x4){bflo(x.q.x), bfhi(x.q.x), bflo(x.q.y), bfhi(x.q.y)};
    *(f32x4*)(d + 8 * q + 4) = (f32x4){bflo(x.q.z), bfhi(x.q.z), bflo(x.q.w), bfhi(x.q.w)};
    *(f32x4*)(d + 128 + 8 * q) = (f32x4){h2f((unsigned short)(x.k.x & 0xFFFFu)), h2f((unsigned short)(x.k.x >> 16)), h2f((unsigned short)(x.k.y & 0xFFFFu)), h2f((unsigned short)(x.k.y >> 16))};
    *(f32x4*)(d + 128 + 8 * q + 4) = (f32x4){h2f((unsigned short)(x.k.z & 0xFFFFu)), h2f((unsigned short)(x.k.z >> 16)), h2f((unsigned short)(x.k.w & 0xFFFFu)), h2f((unsigned short)(x.k.w >> 16))};
    if (q < 2) {
        *(f32x4*)(d + 256 + 8 * q) = (f32x4){bflo(x.v.x), bfhi(x.v.x), bflo(x.v.y), bfhi(x.v.y)};
        *(f32x4*)(d + 256 + 8 * q + 4) = (f32x4){bflo(x.v.z), bfhi(x.v.z), bflo(x.v.w), bfhi(x.v.w)};
    }
}
__device__ __forceinline__ void hgrn_scan_phase(const Params& p, char* smem) {
    float* buf = (float*)smem;
    const bf16_t* P = (const bf16_t*)(p.ws + OFF_P);
    float* O = (float*)(p.ws + OFF_X);
    const int tid = otid(), lane = tid & 63, wid = __builtin_amdgcn_readfirstlane(tid >> 6);
    constexpr int NCH = SEQ_T / HG_TC;
    const int sub = lane >> 4, q = lane & 15;
    for (int unit = blockIdx.x; unit < 256; unit += gridDim.x) {
        const int bh = unit >> 3, vg = unit & 7, b = bh >> 3, h = bh & 7;
        const size_t tokbase = (size_t)b * SEQ_T;
        __syncthreads();
        if (wid >= 4) {
            const int lw = wid - 4, tl0 = lw * 4 + sub, tl1 = 16 + lw * 4 + sub;
            HgRaw x0 = hg_load_raw(P, tokbase + tl0, h, vg, q), x1 = hg_load_raw(P, tokbase + tl1, h, vg, q);
            for (int c = -1; c < NCH; ++c) {
                if (c + 1 < NCH) {
                    const int cn = c + 1; float* db = buf + (cn & 1) * (HG_TC * HG_STRIDE);
                    hg_process(x0, db + tl0 * HG_STRIDE, q);
                    hg_process(x1, db + tl1 * HG_STRIDE, q);
                    if (cn + 1 < NCH) { x0 = hg_load_raw(P, tokbase + (cn + 1) * HG_TC + tl0, h, vg, q); x1 = hg_load_raw(P, tokbase + (cn + 1) * HG_TC + tl1, h, vg, q); }
                }
                __syncthreads();
            }
        } else {
            f32x2 S[4];
#pragma unroll
            for (int e = 0; e < 4; ++e) S[e] = (f32x2){0.f, 0.f};
            const int rowl = wid * 4 + sub;
            float* obase = O + tokbase * 1024 + h * 128 + vg * 16 + rowl;
            __syncthreads();
            for (int c = 0; c < NCH; ++c) {
                const float* cb = buf + (c & 1) * (HG_TC * HG_STRIDE) + q * 8;
                const float* vb = buf + (c & 1) * (HG_TC * HG_STRIDE) + 256 + rowl;
                f32x4 q0 = *(const f32x4*)(cb), q1 = *(const f32x4*)(cb + 4), k0 = *(const f32x4*)(cb + 128), k1 = *(const f32x4*)(cb + 132);
                float vv = vb[0];
                float okeep = 0.f;
#pragma unroll
                for (int tl = 0; tl < HG_TC; ++tl) {
                    f32x4 nq0 = q0, nq1 = q1, nk0 = k0, nk1 = k1; float nv = vv;
                    if (tl + 1 < HG_TC) {
                        const float* s = cb + (tl + 1) * HG_STRIDE;
                        nq0 = *(const f32x4*)(s); nq1 = *(const f32x4*)(s + 4); nk0 = *(const f32x4*)(s + 128); nk1 = *(const f32x4*)(s + 132);
                        nv = vb[(tl + 1) * HG_STRIDE];
                    }
                    __builtin_amdgcn_sched_barrier(0);
                    const f32x2 v2 = {vv, vv};
                    S[0] = __builtin_elementwise_fma((f32x2){k0.x, k0.y}, v2 - S[0], S[0]);
                    S[1] = __builtin_elementwise_fma((f32x2){k0.z, k0.w}, v2 - S[1], S[1]);
                    S[2] = __builtin_elementwise_fma((f32x2){k1.x, k1.y}, v2 - S[2], S[2]);
                    S[3] = __builtin_elementwise_fma((f32x2){k1.z, k1.w}, v2 - S[3], S[3]);
                    f32x2 po = S[0] * (f32x2){q0.x, q0.y};
                    f32x2 pp = S[1] * (f32x2){q0.z, q0.w};
                    po = __builtin_elementwise_fma(S[2], (f32x2){q1.x, q1.y}, po);
                    pp = __builtin_elementwise_fma(S[3], (f32x2){q1.z, q1.w}, pp);
                    po = po + pp;
                    const float o = sum16(po.x + po.y);
                    okeep = (q == (tl & 15)) ? o : okeep;
                    if ((tl & 15) == 15) obase[(size_t)(c * HG_TC + (tl - 15) + q) * 1024] = okeep;
                    __builtin_amdgcn_sched_barrier(0);
                    q0 = nq0; q1 = nq1; k0 = nk0; k1 = nk1; vv = nv;
                }
                __syncthreads();
            }
        }
    }
}
constexpr int HCK = 32;
constexpr size_t OFF_ATTG = OFF_X, OFF_DLG = OFF_X + 16 * MiB;
struct HcRaw { unsigned short q[8], k[8]; };
__device__ __forceinline__ void hc_load(HcRaw& r, const bf16_t* P, size_t tok0, int h, int tid) {
    const int k = tid & 127, tg = tid >> 7;
    const bf16_t* pr = P + (tok0 + tg * 8) * 4096 + h * 128 + k;
#pragma unroll
    for (int j = 0; j < 8; ++j) { r.q[j] = pr[(size_t)j * 4096]; r.k[j] = pr[(size_t)j * 4096 + 1024]; }
}
__device__ __forceinline__ void hgrn_prep_phase(const Params& p, char* smem) {
    bf16_t* P = (bf16_t*)(p.ws + OFF_P);
    bf16_t* ATTg = (bf16_t*)(p.ws + OFF_ATTG);
    float* DLg = (float*)(p.ws + OFF_DLG);
    const int tid = otid(), lane = tid & 63, wid = __builtin_amdgcn_readfirstlane(tid >> 6), fr = lane & 15, fq = lane >> 4;
    const int kch = tid & 127, tg = tid >> 7;
    float* TOT = (float*)(smem);
    bf16_t* QM = (bf16_t*)(smem + 4096);
    bf16_t* KM = (bf16_t*)(smem + 4096 + 8704);
    const int G = gridDim.x;
    __syncthreads();
    HcRaw rawA, rawB;
    {   const int u0 = blockIdx.x, u1 = blockIdx.x + G;
        const int u1c = (u1 < 8192) ? u1 : u0;
        hc_load(rawA, P, (size_t)(u0 >> 11) * SEQ_T + (size_t)(u0 & 255) * HCK, (u0 >> 8) & 7, tid);
        hc_load(rawB, P, (size_t)(u1c >> 11) * SEQ_T + (size_t)(u1c & 255) * HCK, (u1c >> 8) & 7, tid); }
#define HP_BODY(RAW, U) do { \
        const int u_ = (U); const int h_ = (u_ >> 8) & 7; const size_t tok0 = (size_t)(u_ >> 11) * SEQ_T + (size_t)(u_ & 255) * HCK; \
        float kf[8], l[8], qf[8]; \
        { float run = 0.f; _Pragma("unroll") for (int j = 0; j < 8; ++j) { kf[j] = h2f(RAW.k[j]); qf[j] = bf2f(RAW.q[j]); run += __logf(1.0f - kf[j]); l[j] = run; } } \
        { const int un = (u_ + 2 * G < 8192) ? u_ + 2 * G : u_; hc_load(RAW, P, (size_t)(un >> 11) * SEQ_T + (size_t)(un & 255) * HCK, (un >> 8) & 7, tid); } \
        TOT[tg * 128 + kch] = l[7]; if (tg == 2) TOT[4 * 128 + kch] = l[0]; \
        __syncthreads(); \
        { const float t0 = TOT[kch], t1 = TOT[128 + kch], t2 = TOT[256 + kch], t3 = TOT[384 + kch], g16 = TOT[512 + kch]; \
          const float off = (tg > 0 ? t0 : 0.f) + (tg > 1 ? t1 : 0.f) + (tg > 2 ? t2 : 0.f); \
          const float m = t0 + t1 + g16, blast = (t0 + t1) + (t2 + t3); \
          const float em = __expf(m), elm = __expf(blast - m); \
          bf16_t* pq = P + (tok0 + tg * 8) * 4096 + h_ * 128 + kch; float ko8[8]; \
          _Pragma("unroll") for (int j = 0; j < 8; ++j) { const int t = tg * 8 + j; const float bb = off + l[j]; \
              const float e1 = __expf(bb - m), e2 = __builtin_amdgcn_rcpf(e1); const float qm = qf[j] * e1, km = kf[j] * e2; \
              QM[t * 136 + kch] = f2bf(qm); KM[t * 136 + kch] = f2bf(km); pq[(size_t)j * 4096] = f2bf(qm * em); ko8[j] = km * elm; } \
          { uint4 kt; kt.x = pack2bf(ko8[0], ko8[1]); kt.y = pack2bf(ko8[2], ko8[3]); kt.z = pack2bf(ko8[4], ko8[5]); kt.w = pack2bf(ko8[6], ko8[7]); \
            const int idx = kch * 64 + tg * 16;   \
            *(uint4*)(P + (tok0 + (idx >> 8)) * 4096 + 1024 + h_ * 128 + ((idx & 255) >> 1)) = kt; } \
          if (tg == 0) DLg[(size_t)u_ * 128 + kch] = __expf(blast); } \
        __syncthreads(); \
        if (wid < 4) { \
            const int mi = wid >> 1, ni = wid & 1; f32x4 at = {0.f, 0.f, 0.f, 0.f}; \
            if (ni <= mi) { const bf16_t* KMr = KM + (ni * 16 + fr) * 136 + fq * 8; const bf16_t* QMr = QM + (mi * 16 + fr) * 136 + fq * 8; \
                _Pragma("unroll") for (int ks = 0; ks < 4; ++ks) at = __builtin_amdgcn_mfma_f32_16x16x32_bf16(*(const bf16x8*)(KMr + ks * 32), *(const bf16x8*)(QMr + ks * 32), at, 0, 0, 0); } \
            const int t = mi * 16 + fr, s0 = ni * 16 + fq * 4; \
            at.x = (s0 + 0 <= t) ? at.x : 0.f; at.y = (s0 + 1 <= t) ? at.y : 0.f; at.z = (s0 + 2 <= t) ? at.z : 0.f; at.w = (s0 + 3 <= t) ? at.w : 0.f; \
            uint2 pk; pk.x = pack2bf(at.x, at.y); pk.y = pack2bf(at.z, at.w); \
            *(uint2*)(ATTg + (size_t)u_ * 1024 + t * 32 + s0) = pk; \
        } \
    } while (0)
    for (int u = blockIdx.x; u < 8192; u += 2 * G) { HP_BODY(rawA, u); if (u + G < 8192) HP_BODY(rawB, u + G); }
#undef HP_BODY
}
constexpr int H2_QI = 0, H2_KOT = 8704, H2_VT = 18944, H2_ATT = 20224, H2_DL = 22784, H2_PAR = 23296, H2_ST = 2 * H2_PAR, H2_STSZ = 4352;
struct H2Raw { uint4 qi, ko, v, att; f32x4 dl; };
__device__ __forceinline__ void h2_load(H2Raw& r, const bf16_t* P, const bf16_t* ATTg, const float* DLg, size_t tok0, int u, int h, int vg, int tid) {
    const int row = tid >> 4, seg = tid & 15;
    const bf16_t* pr = P + (tok0 + row) * 4096 + h * 128 + seg * 8;
    r.qi = *(const uint4*)(pr); r.ko = *(const uint4*)(pr + 1024);
    r.v = *(const uint4*)(P + (tok0 + ((tid & 63) >> 1)) * 4096 + 2048 + h * 128 + vg * 16 + (tid & 1) * 8);
    r.att = *(const uint4*)(ATTg + (size_t)u * 1024 + (tid & 127) * 8);
    r.dl = *(const f32x4*)(DLg + (size_t)u * 128 + (tid & 31) * 4);
}
__device__ __forceinline__ void hgrn_chunk_phase(const Params& p, char* smem) {
    bf16_t* P = (bf16_t*)(p.ws + OFF_P);
    const bf16_t* ATTg = (const bf16_t*)(p.ws + OFF_ATTG);
    const float* DLg = (const float*)(p.ws + OFF_DLG);
    const int tid = otid(), lane = tid & 63, wid = __builtin_amdgcn_readfirstlane(tid >> 6), fr = lane & 15, fq = lane >> 4;
    constexpr int NCH = SEQ_T / HCK;
    for (int unit = blockIdx.x; unit < 256; unit += gridDim.x) {
        const int bh = unit >> 3, vg = unit & 7, b = bh >> 3, h = bh & 7;
        const size_t tokbase = (size_t)b * SEQ_T;
        __syncthreads();
        for (int i = tid; i < H2_STSZ / 4; i += NTHREADS) *(unsigned*)(smem + H2_ST + i * 4) = 0u;
        f32x4 accS = {0.f, 0.f, 0.f, 0.f};
        H2Raw rawA, rawB;
        h2_load(rawA, P, ATTg, DLg, tokbase, bh * 256, h, vg, tid);
        h2_load(rawB, P, ATTg, DLg, tokbase + HCK, bh * 256 + 1, h, vg, tid);
#define H2_BODY(RAW, C) do { \
        const int c_ = (C); char* pb = smem + (c_ & 1) * H2_PAR; \
        { const int row = tid >> 4, seg = tid & 15; \
          *(uint4*)((bf16_t*)(pb + H2_QI) + row * 136 + seg * 8) = RAW.qi; \
            \
          { uint4 kov; kov.x = RAW.ko.x; kov.y = RAW.ko.y; kov.z = RAW.ko.z; kov.w = RAW.ko.w; *(uint4*)((bf16_t*)(pb + H2_KOT) + (tid >> 2) * 40 + (tid & 3) * 8) = kov; } \
          if (tid < 64) { bf16_t* VT = (bf16_t*)(pb + H2_VT) + ((tid & 1) * 8) * 40 + (tid >> 1); \
              VT[0] = (bf16_t)(RAW.v.x & 0xFFFFu); VT[40] = (bf16_t)(RAW.v.x >> 16); VT[80] = (bf16_t)(RAW.v.y & 0xFFFFu); VT[120] = (bf16_t)(RAW.v.y >> 16); \
              VT[160] = (bf16_t)(RAW.v.z & 0xFFFFu); VT[200] = (bf16_t)(RAW.v.z >> 16); VT[240] = (bf16_t)(RAW.v.w & 0xFFFFu); VT[280] = (bf16_t)(RAW.v.w >> 16); } \
          if (tid < 128) *(uint4*)((bf16_t*)(pb + H2_ATT) + (tid >> 2) * 40 + (tid & 3) * 8) = RAW.att; \
          if (tid < 32) *(f32x4*)((float*)(pb + H2_DL) + tid * 4) = RAW.dl; } \
        { const int cn_ = (c_ + 2 < NCH) ? c_ + 2 : NCH - 1; h2_load(RAW, P, ATTg, DLg, tokbase + (size_t)cn_ * HCK, bh * 256 + cn_, h, vg, tid); } \
        __syncthreads(); \
        if (wid >= 4 && wid < 6) { \
            const int mi = wid - 4; f32x4 acco = {0.f, 0.f, 0.f, 0.f}; \
            const bf16_t* STr = (const bf16_t*)(smem + H2_ST + (c_ & 1) * H2_STSZ) + fr * 136 + fq * 8; const bf16_t* QIr = (const bf16_t*)(pb + H2_QI) + (mi * 16 + fr) * 136 + fq * 8; \
            _Pragma("unroll") for (int ks = 0; ks < 4; ++ks) acco = __builtin_amdgcn_mfma_f32_16x16x32_bf16(*(const bf16x8*)(STr + ks * 32), *(const bf16x8*)(QIr + ks * 32), acco, 0, 0, 0); \
            const bf16x8 va = *(const bf16x8*)((const bf16_t*)(pb + H2_VT) + fr * 40 + fq * 8); \
            const bf16x8 ab = *(const bf16x8*)((const bf16_t*)(pb + H2_ATT) + (mi * 16 + fr) * 40 + fq * 8); \
            acco = __builtin_amdgcn_mfma_f32_16x16x32_bf16(va, ab, acco, 0, 0, 0); \
            uint2 po; po.x = pack2bf(acco.x, acco.y); po.y = pack2bf(acco.z, acco.w); \
            *(uint2*)(P + (tokbase + (size_t)c_ * HCK + mi * 16 + fr) * 4096 + 2048 + h * 128 + vg * 16 + fq * 4) = po; \
        } \
        { const f32x4 dl = *(const f32x4*)((const float*)(pb + H2_DL) + wid * 16 + fq * 4); accS = accS * dl; \
          const bf16x8 ka = *(const bf16x8*)((const bf16_t*)(pb + H2_KOT) + (wid * 16 + fr) * 40 + fq * 8); \
          const bf16x8 vb = *(const bf16x8*)((const bf16_t*)(pb + H2_VT) + fr * 40 + fq * 8); \
          accS = __builtin_amdgcn_mfma_f32_16x16x32_bf16(ka, vb, accS, 0, 0, 0); \
          uint2 pk; pk.x = pack2bf(accS.x, accS.y); pk.y = pack2bf(accS.z, accS.w); \
          *(uint2*)((bf16_t*)(smem + H2_ST + ((c_ + 1) & 1) * H2_STSZ) + fr * 136 + wid * 16 + fq * 4) = pk; } \
    } while (0)
        for (int c = 0; c < NCH; c += 2) { H2_BODY(rawA, c); H2_BODY(rawB, c + 1); }
#undef H2_BODY
    }
}

__device__ __forceinline__ void hgrn_post_phase(const Params& p) {
    const bf16_t* P = (const bf16_t*)(p.ws + OFF_P);
    bf16_t* Z = (bf16_t*)(p.ws + OFF_Y);
    const int ch = otid() * 2;
    const float g0 = p.in[17][ch], g1 = p.in[17][ch + 1];
    for (int tok = blockIdx.x; tok < M_TOK; tok += gridDim.x) {
        const unsigned ou = *(const unsigned*)(P + (size_t)tok * 4096 + 2048 + ch);
        const float2 o2 = make_float2(bflo(ou), bfhi(ou));
        const unsigned sg = *(const unsigned*)(P + (size_t)tok * 4096 + 3072 + ch);
        const float ss = wave_sum(o2.x * o2.x + o2.y * o2.y);
        const float rs = rsqrtf(ss * (1.f / 128.f) + 1e-6f);
        *(unsigned*)(Z + (size_t)tok * 1024 + ch) = pack2bf(o2.x * rs * g0 * bflo(sg), o2.y * rs * g1 * bfhi(sg));
    }
}

__device__ __forceinline__ void conv_post_phase(const Params& p) {
    const bf16_t* Yc = (const bf16_t*)(p.ws + OFF_P);
    const bf16_t* U = Yc + (size_t)M_TOK * 1024;
    bf16_t* Z = (bf16_t*)(p.ws + OFF_X);
    const float* cw = p.in[20];
    const int ch = otid() * 2;
    const float w00 = cw[ch], w01 = cw[ch + 1], w10 = cw[1024 + ch], w11 = cw[1025 + ch], w20 = cw[2048 + ch], w21 = cw[2049 + ch];
    for (int tok = blockIdx.x; tok < M_TOK; tok += gridDim.x) {
        const int t = tok & (SEQ_T - 1);
        const unsigned y0 = *(const unsigned*)(Yc + (size_t)tok * 1024 + ch);
        unsigned y1 = 0u, y2 = 0u;
        if (t >= 1) y1 = *(const unsigned*)(Yc + (size_t)(tok - 1) * 1024 + ch);
        if (t >= 2) y2 = *(const unsigned*)(Yc + (size_t)(tok - 2) * 1024 + ch);
        const unsigned u = *(const unsigned*)(U + (size_t)tok * 1024 + ch);
        const float c0 = w00 * bflo(y2) + w10 * bflo(y1) + w20 * bflo(y0);
        const float c1 = w01 * bfhi(y2) + w11 * bfhi(y1) + w21 * bfhi(y0);
        *(unsigned*)(Z + (size_t)tok * 1024 + ch) = pack2bf(bflo(u) * c0, bfhi(u) * c1);
    }
}

constexpr int SG_LS = 136;
__device__ __forceinline__ void gmlp_spatial_phase(const Params& p, char* smem) {
    float* rsA = (float*)smem;
    bf16_t* Aw = (bf16_t*)(smem + 1024);
    bf16_t* VT = Aw + 128 * SG_LS;
    const bf16_t* P = (const bf16_t*)(p.ws + OFF_P);
    const bf16_t* Wsb = (const bf16_t*)(p.ws + OFF_WS_GMLP);
    bf16_t* Z = (bf16_t*)(p.ws + OFF_X);
    const float* vg = p.in[23]; const float* bs = p.in[25];
    const int tid = otid(), lane = tid & 63, wid = tid >> 6, wr = wid >> 1, wc = wid & 1, fr = lane & 15, fq = lane >> 4;
    for (int unit = blockIdx.x; unit < 256; unit += gridDim.x) {
        const size_t tok0 = (size_t)unit * 128;
        __syncthreads();
        for (int i = 0; i < 16; ++i) {
            const int r = wid * 16 + i;
            const bf16_t* vr = P + (tok0 + r) * 3072 + 1024 + lane * 16;
            const uint4 a = *(const uint4*)(vr), b = *(const uint4*)(vr + 8);
            const unsigned w[8] = {a.x, a.y, a.z, a.w, b.x, b.y, b.z, b.w};
            float ss = 0.f;
#pragma unroll
            for (int e = 0; e < 8; ++e) { const float lo = bflo(w[e]), hi = bfhi(w[e]); ss += lo * lo + hi * hi; }
            ss = wave_sum(ss);
            if (lane == 0) rsA[r] = rsqrtf(ss * (1.f / 1024.f) + 1e-6f);
        }
        __syncthreads();
        for (int g = 0; g < 8; ++g) {
#pragma unroll
            for (int i = 0; i < 4; ++i) {
                const int idx = tid + i * 512, row = idx >> 4, c16 = idx & 15;
                *(uint4*)(Aw + row * SG_LS + c16 * 8) = *(const uint4*)(Wsb + (size_t)g * 16384 + row * 128 + c16 * 8);
            }
            {
                const int s = tid >> 2, cp = tid & 3;
                const float rs = rsA[s];
                const bf16_t* vr = P + (tok0 + s) * 3072 + 1024 + g * 128 + cp * 32;
#pragma unroll
                for (int i = 0; i < 4; ++i) {
                    const uint4 a = *(const uint4*)(vr + i * 8);
                    const unsigned w[4] = {a.x, a.y, a.z, a.w};
#pragma unroll
                    for (int e = 0; e < 4; ++e) {
                        const int c = cp * 32 + i * 8 + e * 2;
                        const float g0 = vg[g * 128 + c], g1 = vg[g * 128 + c + 1];
                        VT[c * SG_LS + s] = f2bf(bflo(w[e]) * rs * g0);
                        VT[(c + 1) * SG_LS + s] = f2bf(bfhi(w[e]) * rs * g1);
                    }
                }
            }
            __syncthreads();
            f32x4 acc[2][4];
#pragma unroll
            for (int i = 0; i < 2; ++i)
#pragma unroll
                for (int j = 0; j < 4; ++j) acc[i][j] = (f32x4){0.f, 0.f, 0.f, 0.f};
#pragma unroll
            for (int ks = 0; ks < 4; ++ks) {
                bf16x8 af[2], bfr[4];
#pragma unroll
                for (int i = 0; i < 2; ++i) af[i] = *(const bf16x8*)(Aw + (wr * 32 + i * 16 + fr) * SG_LS + ks * 32 + fq * 8);
#pragma unroll
                for (int i = 0; i < 4; ++i) bfr[i] = *(const bf16x8*)(VT + (wc * 64 + i * 16 + fr) * SG_LS + ks * 32 + fq * 8);
#pragma unroll
                for (int mi = 0; mi < 2; ++mi)
#pragma unroll
                    for (int ni = 0; ni < 4; ++ni) acc[mi][ni] = __builtin_amdgcn_mfma_f32_16x16x32_bf16(bfr[ni], af[mi], acc[mi][ni], 0, 0, 0);
            }
#pragma unroll
            for (int mi = 0; mi < 2; ++mi) {
                const int t = wr * 32 + mi * 16 + fr;
                const float bias = bs[g * 128 + t];
                const bf16_t* pr = P + (tok0 + t) * 3072;
#pragma unroll
                for (int ni = 0; ni < 4; ++ni) {
                    const int c = g * 128 + wc * 64 + ni * 16 + fq * 4;
                    const uint2 uu = *(const uint2*)(pr + c), sg = *(const uint2*)(pr + 2048 + c);
                    const f32x4 a = acc[mi][ni];
                    uint2 pk;
                    pk.x = pack2bf(bflo(uu.x) * (a.x + bias) * bflo(sg.x), bfhi(uu.x) * (a.y + bias) * bfhi(sg.x));
                    pk.y = pack2bf(bflo(uu.y) * (a.z + bias) * bflo(sg.y), bfhi(uu.y) * (a.w + bias) * bfhi(sg.y));
                    *(uint2*)(Z + (tok0 + t) * 1024 + c) = pk;
                }
            }
            __syncthreads();
        }
    }
}


#define XB_TMO      128
#define XB_XCNT(j)  (256  + 64 * (j))
#define XB_XSUB(j)  (1280 + 64 * (j))
#define XB_XGEN(j)  (2304 + 64 * (j))
#define XB_TOP      3328
#define XB_TOPGEN   3392
#define XCD_BAR_WORDS 3456
#define XB_SPIN_CAP (1u << 20)
#define XLAS __attribute__((address_space(3)))
__device__ __forceinline__ unsigned xb_ld(unsigned* p)              { return __hip_atomic_load(p, __ATOMIC_RELAXED, __HIP_MEMORY_SCOPE_AGENT); }
__device__ __forceinline__ unsigned xb_add(unsigned* p, unsigned v) { return __hip_atomic_fetch_add(p, v, __ATOMIC_RELAXED, __HIP_MEMORY_SCOPE_AGENT); }
__device__ __forceinline__ unsigned xb_xcc_id() { return (unsigned)__builtin_amdgcn_s_getreg((3 << 11) | 20) & 0xFu; }
#define XB_SPIN(cond, bar) do { unsigned _sp = 0; while (cond) { __builtin_amdgcn_s_sleep(1); \
    if ((++_sp & 255u) == 0u) { if (xb_ld(&(bar)[XB_TMO])) break; if (_sp > XB_SPIN_CAP) { atomicAdd(&(bar)[XB_TMO], 1u); break; } } } } while (0)
struct XcdBarrier { unsigned* bar; unsigned x; volatile XLAS unsigned* st; };
__device__ __forceinline__ XcdBarrier xcd_barrier_post(unsigned* bar, volatile XLAS unsigned* st) {
    XcdBarrier b; b.bar = bar; b.x = xb_xcc_id(); b.st = st;
    if (otid() == 0) (void)xb_add(&bar[XB_XCNT(b.x)], 1u);
    return b;
}
__device__ __forceinline__ void xcd_barrier_complete(unsigned* bar, unsigned x, unsigned& nloc, unsigned& nx) {
    const unsigned G = gridDim.x * gridDim.y * gridDim.z;
    unsigned sum, cnt, mine, sp = 0u;
    for (;;) {
        sum = 0u; cnt = 0u; mine = 0u;
#pragma unroll
        for (unsigned j = 0; j < 16; ++j) { const unsigned c = xb_ld(&bar[XB_XCNT(j)]); sum += c; cnt += (c > 0u) ? 1u : 0u; mine = (j == x) ? c : mine; }
        if (sum == G) break;
        __builtin_amdgcn_s_sleep(1);
        if ((++sp & 255u) == 0u) { if (xb_ld(&bar[XB_TMO])) break; if (sp > XB_SPIN_CAP) { atomicAdd(&bar[XB_TMO], 1u); break; } }
    }
    nloc = mine > 0u ? mine : 1u; nx = cnt > 0u ? cnt : 1u;
}
__device__ __forceinline__ void xcd_barrier(const XcdBarrier& b) {
    asm volatile("s_waitcnt vmcnt(0)" ::: "memory");
    __syncthreads();
    if (otid() == 0) {
        unsigned* bar = b.bar;
        __builtin_amdgcn_s_waitcnt(0);
        unsigned nloc = b.st[0], nx = b.st[1];
        if (nloc == 0u) { xcd_barrier_complete(bar, b.x, nloc, nx); b.st[0] = nloc; b.st[1] = nx; }
        const unsigned old = xb_add(&bar[XB_XSUB(b.x)], 1u);
        const unsigned gen = old / nloc;
        if (old + 1u == (gen + 1u) * nloc) {
            __builtin_amdgcn_fence(__ATOMIC_RELEASE, "agent");
            asm volatile("s_waitcnt vmcnt(0)" ::: "memory");
            const unsigned og = xb_add(&bar[XB_TOP], 1u);
            const unsigned tg = og / nx;
            if (og + 1u == (tg + 1u) * nx) xb_add(&bar[XB_TOPGEN], 1u);
            else XB_SPIN(xb_ld(&bar[XB_TOPGEN]) == tg, bar);
            __builtin_amdgcn_fence(__ATOMIC_ACQUIRE, "agent");
            xb_add(&bar[XB_XGEN(b.x)], 1u);
            asm volatile("s_waitcnt vmcnt(0)" ::: "memory");
        } else {
            XB_SPIN(xb_ld(&bar[XB_XGEN(b.x)]) == gen, bar);
            __builtin_amdgcn_fence(__ATOMIC_ACQUIRE, "agent");
            asm volatile("s_waitcnt vmcnt(0)" ::: "memory");
        }
    }
    __syncthreads();
}

__global__ void __launch_bounds__(NTHREADS) fwd_megakernel(Params p) {
    extern __shared__ __attribute__((aligned(16))) char smem[];
    cg::grid_group grid = cg::this_grid();
    unsigned char* ws = p.ws;
    bf16_t* HN = (bf16_t*)(ws + OFF_X);
    bf16_t* Pb = (bf16_t*)(ws + OFF_P);
    bf16_t* Zx = (bf16_t*)(ws + OFF_X);
    bf16_t* Zy = (bf16_t*)(ws + OFF_Y);
    bf16_t* Lin = (bf16_t*)(ws + OFF_LIN);
    const float* ng = p.in[1];
    volatile XLAS unsigned* xst = (volatile XLAS unsigned*)(smem + LDS_STAGE);
    if (threadIdx.x == 0) { xst[0] = 0u; xst[1] = 0u; }
    __syncthreads();
    const XcdBarrier xbar = xcd_barrier_post((unsigned*)(ws + OFF_BAR), xst);

    phase_weights(p, smem);
    rmsnorm_phase<true>(p.in[0], ng, HN);
    grid.sync();
    for (int rep = 0; rep < REP_GEMM; ++rep) {
    pg8::run(smem, HN, (const bf16_t*)(ws + OFF_WT_RWKV_IN), 4352, pg8::EStoreBf16{Pb, RW_COLS, RW_COLS});
    xcd_barrier(xbar); }
    rwkv_lin_phase(Pb, p.in[4], Lin);
    xcd_barrier(xbar);
    gemm_phase(Lin, 128, (const bf16_t*)(ws + OFF_WT_W2), 64, 1024, 64, EpiLoraW{p.in[5], (float*)(ws + OFF_X)}, smem);
    gemm_phase(Lin + 64, 128, (const bf16_t*)(ws + OFF_WT_A2), 64, 1024, 64, EpiLoraA{p.in[7], (unsigned short*)(ws + OFF_Y)}, smem);
    xcd_barrier(xbar);
    for (int rep = 0; rep < REP_RSCAN; ++rep) {
    rwkv_elem_phase(p);
    xcd_barrier(xbar);
    rwkv_chunk2_phase(p, smem);
    xcd_barrier(xbar); }
    for (int rep = 0; rep < REP_MISC; ++rep) {
    rwkv_post2_phase(p);
    xcd_barrier(xbar); }
    pg8::run(smem, Zx, (const bf16_t*)(ws + OFF_WT_RWKV_OUT), 1024, pg8::EResid{p.in[0], p.out});
    xcd_barrier(xbar);
    rmsnorm_phase<true>(p.out, ng + 1024, HN);
    xcd_barrier(xbar);
    for (int rep = 0; rep < REP_GEMM; ++rep) {
    pg8::run(smem, HN, (const bf16_t*)(ws + OFF_WT_HGRN_IN), 4096, pg8::EHgrn{Pb, (const float*)(ws + OFF_LB)});
    xcd_barrier(xbar); }
    for (int rep = 0; rep < REP_HSCAN; ++rep) {
    hgrn_prep_phase(p, smem);
    xcd_barrier(xbar);
    hgrn_chunk_phase(p, smem);
    xcd_barrier(xbar); }
    for (int rep = 0; rep < REP_MISC; ++rep) {
    hgrn_post_phase(p);
    xcd_barrier(xbar); }
    pg8::run(smem, Zy, (const bf16_t*)(ws + OFF_WT_HGRN_OUT), 1024, pg8::EResid{p.out, p.out});
    xcd_barrier(xbar);
    rmsnorm_phase<true>(p.out, ng + 2048, HN);
    xcd_barrier(xbar);
    for (int rep = 0; rep < REP_GEMM; ++rep) {
    pg8::run(smem, HN, (const bf16_t*)(ws + OFF_WT_CONV_IN), 4096, pg8::EConv{Pb, Pb + (size_t)M_TOK * 1024});
    xcd_barrier(xbar); }
    for (int rep = 0; rep < REP_MISC; ++rep) {
    conv_post_phase(p);
    xcd_barrier(xbar); }
    pg8::run(smem, Zx, (const bf16_t*)(ws + OFF_WT_CONV_OUT), 1024, pg8::EResid{p.out, p.out});
    xcd_barrier(xbar);
    rmsnorm_phase<true>(p.out, ng + 3072, HN);
    xcd_barrier(xbar);
    for (int rep = 0; rep < REP_GEMM; ++rep) {
    pg8::run(smem, HN, (const bf16_t*)(ws + OFF_WT_GMLP_IN), 3072, pg8::EGmlp{Pb});
    xcd_barrier(xbar); }
    for (int rep = 0; rep < REP_MISC; ++rep) {
    gmlp_spatial_phase(p, smem);
    xcd_barrier(xbar); }
    pg8::run(smem, Zx, (const bf16_t*)(ws + OFF_WT_GMLP_OUT), 1024, pg8::EResid{p.out, p.out});
    xcd_barrier(xbar);
    rmsnorm_phase<false>(p.out, p.in[2], p.out);
}

extern "C" void kernel_launch(void* const* d_in, const int* in_sizes, int n_in, void* d_out, int out_size, void* d_ws, size_t ws_size, hipStream_t stream) {
    static int grid = 0;
    if (grid == 0) {
        if (n_in != 27 || out_size != M_TOK * DM || ws_size < WS_END) {
            fprintf(stderr, "kernel_launch: unexpected problem (n_in %d, out %d, ws %zu, need %zu)\n", n_in, out_size, ws_size, (size_t)WS_END);
            grid = -1; return;
        }
        int dev = 0, cus = 0, per_cu = 0;
        hipGetDevice(&dev);
        hipDeviceGetAttribute(&cus, hipDeviceAttributeMultiprocessorCount, dev);
        if (hipFuncSetAttribute((const void*)fwd_megakernel, hipFuncAttributeMaxDynamicSharedMemorySize, LDS_BYTES) != hipSuccess) {
            fprintf(stderr, "kernel_launch: hipFuncSetAttribute failed\n"); grid = -1; return;
        }
        hipOccupancyMaxActiveBlocksPerMultiprocessor(&per_cu, (const void*)fwd_megakernel, NTHREADS, LDS_BYTES);
        if (per_cu < 1) { fprintf(stderr, "kernel_launch: occupancy query says %d blocks per CU\n", per_cu); per_cu = 1; }
        (void)hipGetLastError();
        grid = cus;
    }
    if (grid < 0) return;
    Params p{};
    for (int i = 0; i < 27; ++i) p.in[i] = (const float*)d_in[i];
    p.out = (float*)d_out; p.ws = (unsigned char*)d_ws;
    (void)hipMemsetAsync((unsigned char*)d_ws + OFF_BAR, 0, XCD_BAR_WORDS * 4, stream);
    void* args[] = {&p};
    hipError_t e = hipLaunchCooperativeKernel((const void*)fwd_megakernel, dim3(grid), dim3(NTHREADS), args, LDS_BYTES, stream);
    if (e != hipSuccess) fprintf(stderr, "cooperative launch failed: %s (grid %d)\n", hipGetErrorString(e), grid);
}
```

```cpp
#include <hip/hip_runtime.h>
#include <hip/hip_cooperative_groups.h>
#include <hip/hip_fp16.h>
#include <cstdio>
#include <cstdint>
namespace cg = cooperative_groups;

typedef unsigned short bf16_t;
typedef short bf16x8 __attribute__((ext_vector_type(8)));
typedef float f32x4 __attribute__((ext_vector_type(4)));

constexpr int M_TOK = 32768, DM = 1024, SEQ_T = 8192;
constexpr int NTHREADS = 512;
constexpr int LDS_STAGE = 131072;
constexpr int LDS_BYTES = LDS_STAGE + 16;
constexpr int RW_COLS = 4224;
#ifndef REP_GEMM
#define REP_GEMM 1
#endif
#ifndef REP_RSCAN
#define REP_RSCAN 1
#endif
#ifndef REP_HSCAN
#define REP_HSCAN 1
#endif
#ifndef REP_MISC
#define REP_MISC 1
#endif

constexpr size_t MiB = 1048576;
constexpr size_t OFF_WT_RWKV_IN = 0;
constexpr size_t OFF_WT_RWKV_OUT = OFF_WT_RWKV_IN + (size_t)RW_COLS * 1024 * 2;
constexpr size_t OFF_WT_HGRN_IN = OFF_WT_RWKV_OUT + 2 * MiB;
constexpr size_t OFF_WT_HGRN_OUT = OFF_WT_HGRN_IN + 8 * MiB;
constexpr size_t OFF_WT_CONV_IN = OFF_WT_HGRN_OUT + 2 * MiB;
constexpr size_t OFF_WT_CONV_OUT = OFF_WT_CONV_IN + 8 * MiB;
constexpr size_t OFF_WT_GMLP_IN = OFF_WT_CONV_OUT + 2 * MiB;
constexpr size_t OFF_WT_GMLP_OUT = OFF_WT_GMLP_IN + 6 * MiB;
constexpr size_t OFF_WT_W2 = OFF_WT_GMLP_OUT + 2 * MiB;
constexpr size_t OFF_WT_A2 = OFF_WT_W2 + 131072;
constexpr size_t OFF_WS_GMLP = OFF_WT_A2 + 131072;
constexpr size_t OFF_LB = OFF_WS_GMLP + 262144;
constexpr size_t OFF_BAR = OFF_LB + 4096;
constexpr size_t OFF_P = 39 * MiB;
constexpr size_t OFF_X = OFF_P + 264 * MiB;
constexpr size_t OFF_Y = OFF_X + 128 * MiB;
constexpr size_t OFF_LIN = OFF_Y + 64 * MiB;
constexpr size_t WS_END = OFF_LIN + 8 * MiB;
static_assert(OFF_BAR + 16384 <= OFF_P, "small region overflow");

struct Params {
    const float* in[27];
    float* out;
    unsigned char* ws;
};

__device__ __forceinline__ int otid() { int t = (int)threadIdx.x; asm volatile("" : "+v"(t)); return t; }
__device__ __forceinline__ bf16_t f2bf(float f) { unsigned u = __float_as_uint(f); u += 0x7FFFu + ((u >> 16) & 1u); return (bf16_t)(u >> 16); }
__device__ __forceinline__ float bf2f(unsigned h) { return __uint_as_float(h << 16); }
typedef __bf16 hwbf16x2 __attribute__((ext_vector_type(2)));
typedef float f32x2c __attribute__((ext_vector_type(2)));
__device__ __forceinline__ unsigned pack2bf(float a, float b) { const f32x2c v = {a, b}; const hwbf16x2 r = __builtin_convertvector(v, hwbf16x2); return __builtin_bit_cast(unsigned, r); }
__device__ __forceinline__ float bflo(unsigned u) { return __uint_as_float(u << 16); }
__device__ __forceinline__ float bfhi(unsigned u) { return __uint_as_float(u & 0xFFFF0000u); }
__device__ __forceinline__ float h2f(unsigned short h) { return __half2float(__ushort_as_half(h)); }
__device__ __forceinline__ unsigned short f2h(float f) { return __half_as_ushort(__float2half(f)); }
__device__ __forceinline__ float sigmoidf_(float x) { return __builtin_amdgcn_rcpf(1.0f + __expf(-x)); }
__device__ __forceinline__ float siluf_(float x) { return x * __builtin_amdgcn_rcpf(1.0f + __expf(-x)); }

__device__ __forceinline__ float wave_sum(float v) {
#pragma unroll
    for (int o = 1; o < 64; o <<= 1) v += __shfl_xor(v, o);
    return v;
}
template <int CTRL>
__device__ __forceinline__ float dpp_mov(float x) {
    return __int_as_float(__builtin_amdgcn_update_dpp(0, __float_as_int(x), CTRL, 0xF, 0xF, true));
}
__device__ __forceinline__ float sum16(float x) {
    x += dpp_mov<0xB1>(x);
    x += dpp_mov<0x4E>(x);
    x += dpp_mov<0x141>(x);
    x += dpp_mov<0x140>(x);
    return x;
}

__device__ __forceinline__ int conv_perm(int n) { const int blk = n >> 10, ch = n & 1023, chin = ch & 63; return (ch >> 6) * 256 + (blk >> 1) * 128 + (chin >> 4) * 32 + (blk & 1) * 16 + (chin & 15); }

__device__ __forceinline__ void transpose_convert(const float* __restrict__ W, int K, int N, bf16_t* __restrict__ WT, bool perm, float* tile) {
    const int tid = otid();
    const int nnb = N / 64, items = (K / 64) * nnb;
    for (int it = blockIdx.x; it < items; it += gridDim.x) {
        const int kb = it / nnb, nb = it % nnb, k0 = kb * 64, n0 = nb * 64;
#pragma unroll
        for (int i = 0; i < 2; ++i) {
            const int idx = tid + i * 512, kk = idx >> 4, n4 = (idx & 15) * 4;
            const f32x4 v = *(const f32x4*)(W + (size_t)(k0 + kk) * N + n0 + n4);
            float* d = tile + kk * 65 + n4;
            d[0] = v.x; d[1] = v.y; d[2] = v.z; d[3] = v.w;
        }
        __syncthreads();
        {
            const int n = tid >> 3, k8 = (tid & 7) * 8;
            const float* s = tile + k8 * 65 + n;
            uint4 o;
            o.x = pack2bf(s[0 * 65], s[1 * 65]); o.y = pack2bf(s[2 * 65], s[3 * 65]);
            o.z = pack2bf(s[4 * 65], s[5 * 65]); o.w = pack2bf(s[6 * 65], s[7 * 65]);
            const int ncol = n0 + n, nrow = perm ? conv_perm(ncol) : ncol;
            *(uint4*)(WT + (size_t)nrow * K + k0 + k8) = o;
        }
        __syncthreads();
    }
}

__device__ __forceinline__ void phase_weights(const Params& p, char* smem) {
    float* tile = (float*)smem;
    unsigned char* ws = p.ws;
    transpose_convert(p.in[3], 1024, RW_COLS, (bf16_t*)(ws + OFF_WT_RWKV_IN), false, tile);
    transpose_convert(p.in[14], 1024, 1024, (bf16_t*)(ws + OFF_WT_RWKV_OUT), false, tile);
    transpose_convert(p.in[16], 1024, 4096, (bf16_t*)(ws + OFF_WT_HGRN_IN), false, tile);
    transpose_convert(p.in[18], 1024, 1024, (bf16_t*)(ws + OFF_WT_HGRN_OUT), false, tile);
    transpose_convert(p.in[19], 1024, 4096, (bf16_t*)(ws + OFF_WT_CONV_IN), true, tile);
    transpose_convert(p.in[21], 1024, 1024, (bf16_t*)(ws + OFF_WT_CONV_OUT), false, tile);
    transpose_convert(p.in[22], 1024, 3072, (bf16_t*)(ws + OFF_WT_GMLP_IN), false, tile);
    transpose_convert(p.in[26], 1024, 1024, (bf16_t*)(ws + OFF_WT_GMLP_OUT), false, tile);
    transpose_convert(p.in[6], 64, 1024, (bf16_t*)(ws + OFF_WT_W2), false, tile);
    transpose_convert(p.in[8], 64, 1024, (bf16_t*)(ws + OFF_WT_A2), false, tile);
    const int gtid = blockIdx.x * NTHREADS + otid(), gsz = gridDim.x * NTHREADS;
    {
        const float* w = p.in[24]; bf16_t* o = (bf16_t*)(ws + OFF_WS_GMLP);
        for (int i = gtid; i < 8 * 128 * 128; i += gsz) { const int t = (i >> 7) & 127, s = i & 127; o[i] = (s <= t) ? f2bf(w[i]) : (bf16_t)0; }
    }
    {
        const float* l = p.in[15]; float* lb = (float*)(ws + OFF_LB);
        for (int c = gtid; c < 1024; c += gsz) {
            const float l0 = l[c], l1 = l[1024 + c], l2 = l[2048 + c], l3 = l[3072 + c];
            const float m = fmaxf(fmaxf(l0, l1), fmaxf(l2, l3));
            const float e0 = expf(l0 - m), e1 = expf(l1 - m), e2 = expf(l2 - m), e3 = expf(l3 - m);
            lb[c] = e1 / (e0 + e1 + e2 + e3);
        }
    }
}

template <bool OUT_BF16>
__device__ __forceinline__ void rmsnorm_phase(const float* in, const float* __restrict__ g, void* outp) {
    const int lane = otid() & 63, wid = otid() >> 6;
    const int gw = blockIdx.x * 8 + wid, ngw = gridDim.x * 8;
    f32x4 gv[4];
#pragma unroll
    for (int j = 0; j < 4; ++j) gv[j] = *(const f32x4*)(g + lane * 4 + j * 256);
    for (int row = gw; row < M_TOK; row += ngw) {
        const float* xr = in + (size_t)row * 1024 + lane * 4;
        f32x4 v[4]; float ss = 0.f;
#pragma unroll
        for (int j = 0; j < 4; ++j) { v[j] = *(const f32x4*)(xr + j * 256); ss += v[j].x * v[j].x + v[j].y * v[j].y + v[j].z * v[j].z + v[j].w * v[j].w; }
        ss = wave_sum(ss);
        const float rs = rsqrtf(ss * (1.0f / 1024.0f) + 1e-6f);
#pragma unroll
        for (int j = 0; j < 4; ++j) {
            const f32x4 o = v[j] * rs * gv[j];
            if (OUT_BF16) {
                uint2 pk; pk.x = pack2bf(o.x, o.y); pk.y = pack2bf(o.z, o.w);
                *(uint2*)((bf16_t*)outp + (size_t)row * 1024 + lane * 4 + j * 256) = pk;
            } else {
                *(f32x4*)((float*)outp + (size_t)row * 1024 + lane * 4 + j * 256) = o;
            }
        }
    }
}

constexpr int G_BM = 256, G_BN = 128, G_BK = 64, G_LS = 72;
constexpr int G_ASTAGE = G_BM * G_LS, G_BSTAGE = G_BN * G_LS;

template <class Epi>
__device__ __forceinline__ void gemm_phase(const bf16_t* A, int lda, const bf16_t* Bt, int ldb, int N, int K, const Epi epi, char* smem) {
    const int tid = otid(), lane = tid & 63, wid = tid >> 6, wr = wid >> 1, wc = wid & 1, fr = lane & 15, fq = lane >> 4;
    bf16_t* As = (bf16_t*)smem;
    bf16_t* Bs = As + 2 * G_ASTAGE;
    const int nTn = N / G_BN, nT = (M_TOK / G_BM) * nTn, nk = K / G_BK;
    const int lrow = tid >> 3, lc = (tid & 7) * 8;
    for (int tile = blockIdx.x; tile < nT; tile += gridDim.x) {
        const int tm = tile / nTn, tn = tile % nTn;
        const bf16_t* Ag = A + (size_t)(tm * G_BM + lrow) * lda + lc;
        const bf16_t* Bg = Bt + (size_t)(tn * G_BN + lrow) * ldb + lc;
        f32x4 acc[4][4];
#pragma unroll
        for (int i = 0; i < 4; ++i)
#pragma unroll
            for (int j = 0; j < 4; ++j) acc[i][j] = (f32x4){0.f, 0.f, 0.f, 0.f};
        uint4 ra[4], rb[2];
#pragma unroll
        for (int i = 0; i < 4; ++i) ra[i] = *(const uint4*)(Ag + (size_t)i * 64 * lda);
#pragma unroll
        for (int i = 0; i < 2; ++i) rb[i] = *(const uint4*)(Bg + (size_t)i * 64 * ldb);
#pragma unroll
        for (int i = 0; i < 4; ++i) *(uint4*)(As + (lrow + i * 64) * G_LS + lc) = ra[i];
#pragma unroll
        for (int i = 0; i < 2; ++i) *(uint4*)(Bs + (lrow + i * 64) * G_LS + lc) = rb[i];
        __syncthreads();
        for (int kt = 0; kt < nk; ++kt) {
            const int buf = kt & 1;
            const bool more = (kt + 1 < nk);
            if (more) {
#pragma unroll
                for (int i = 0; i < 4; ++i) ra[i] = *(const uint4*)(Ag + (size_t)i * 64 * lda + (kt + 1) * G_BK);
#pragma unroll
                for (int i = 0; i < 2; ++i) rb[i] = *(const uint4*)(Bg + (size_t)i * 64 * ldb + (kt + 1) * G_BK);
            }
            const bf16_t* as = As + buf * G_ASTAGE + (wr * 64 + fr) * G_LS + fq * 8;
            const bf16_t* bs = Bs + buf * G_BSTAGE + (wc * 64 + fr) * G_LS + fq * 8;
#pragma unroll
            for (int ks = 0; ks < 2; ++ks) {
                bf16x8 af[4], bfr[4];
#pragma unroll
                for (int i = 0; i < 4; ++i) { af[i] = *(const bf16x8*)(as + i * 16 * G_LS + ks * 32); bfr[i] = *(const bf16x8*)(bs + i * 16 * G_LS + ks * 32); }
#pragma unroll
                for (int mi = 0; mi < 4; ++mi)
#pragma unroll
                    for (int ni = 0; ni < 4; ++ni) acc[mi][ni] = __builtin_amdgcn_mfma_f32_16x16x32_bf16(bfr[ni], af[mi], acc[mi][ni], 0, 0, 0);
            }
            if (more) {
                bf16_t* ad = As + (buf ^ 1) * G_ASTAGE; bf16_t* bd = Bs + (buf ^ 1) * G_BSTAGE;
#pragma unroll
                for (int i = 0; i < 4; ++i) *(uint4*)(ad + (lrow + i * 64) * G_LS + lc) = ra[i];
#pragma unroll
                for (int i = 0; i < 2; ++i) *(uint4*)(bd + (lrow + i * 64) * G_LS + lc) = rb[i];
            }
            __syncthreads();
        }
        epi(acc, tm * G_BM + wr * 64, tn * G_BN + wc * 64, fr, fq);
    }
}

struct EpiStoreBf16 {
    bf16_t* C; int ldc;
    __device__ __forceinline__ void operator()(f32x4 (&acc)[4][4], int row0, int col0, int fr, int fq) const {
#pragma unroll
        for (int mi = 0; mi < 4; ++mi)
#pragma unroll
            for (int ni = 0; ni < 4; ++ni) {
                const f32x4 a = acc[mi][ni]; uint2 pk; pk.x = pack2bf(a.x, a.y); pk.y = pack2bf(a.z, a.w);
                *(uint2*)(C + (size_t)(row0 + mi * 16 + fr) * ldc + col0 + ni * 16 + fq * 4) = pk;
            }
    }
};
struct EpiHgrn {
    bf16_t* C; const float* lb;
    __device__ __forceinline__ void operator()(f32x4 (&acc)[4][4], int row0, int col0, int fr, int fq) const {
        const int blk = col0 >> 10;
#pragma unroll
        for (int mi = 0; mi < 4; ++mi)
#pragma unroll
            for (int ni = 0; ni < 4; ++ni) {
                f32x4 a = acc[mi][ni]; const int col = col0 + ni * 16 + fq * 4; uint2 pk;
                if (blk == 1) {
                    const f32x4 l = *(const f32x4*)(lb + (col - 1024));
                    a.x = (1.f - l.x) * sigmoidf_(-a.x); a.y = (1.f - l.y) * sigmoidf_(-a.y); a.z = (1.f - l.z) * sigmoidf_(-a.z); a.w = (1.f - l.w) * sigmoidf_(-a.w);
                    pk.x = (unsigned)f2h(a.x) | ((unsigned)f2h(a.y) << 16); pk.y = (unsigned)f2h(a.z) | ((unsigned)f2h(a.w) << 16);
                } else {
                    if (blk == 3) { a.x = siluf_(a.x); a.y = siluf_(a.y); a.z = siluf_(a.z); a.w = siluf_(a.w); }
                    pk.x = pack2bf(a.x, a.y); pk.y = pack2bf(a.z, a.w);
                }
                *(uint2*)(C + (size_t)(row0 + mi * 16 + fr) * 4096 + col) = pk;
            }
    }
};
struct EpiConv {
    bf16_t* Yc; bf16_t* U;
    __device__ __forceinline__ void operator()(f32x4 (&acc)[4][4], int row0, int col0, int fr, int fq) const {
        const int ch = (col0 >> 6) * 16 + fq * 4;
#pragma unroll
        for (int mi = 0; mi < 4; ++mi) {
            const f32x4 b = acc[mi][0], c = acc[mi][1], z = acc[mi][2], g = acc[mi][3];
            const size_t o = (size_t)(row0 + mi * 16 + fr) * 1024 + ch;
            uint2 py, pu;
            py.x = pack2bf(c.x * z.x, c.y * z.y); py.y = pack2bf(c.z * z.z, c.w * z.w);
            pu.x = pack2bf(b.x * siluf_(g.x), b.y * siluf_(g.y)); pu.y = pack2bf(b.z * siluf_(g.z), b.w * siluf_(g.w));
            *(uint2*)(Yc + o) = py; *(uint2*)(U + o) = pu;
        }
    }
};
struct EpiGmlp {
    bf16_t* C;
    __device__ __forceinline__ void operator()(f32x4 (&acc)[4][4], int row0, int col0, int fr, int fq) const {
        const int blk = col0 >> 10;
#pragma unroll
        for (int mi = 0; mi < 4; ++mi)
#pragma unroll
            for (int ni = 0; ni < 4; ++ni) {
                f32x4 a = acc[mi][ni];
                if (blk == 2) { a.x = siluf_(a.x); a.y = siluf_(a.y); a.z = siluf_(a.z); a.w = siluf_(a.w); }
                uint2 pk; pk.x = pack2bf(a.x, a.y); pk.y = pack2bf(a.z, a.w);
                *(uint2*)(C + (size_t)(row0 + mi * 16 + fr) * 3072 + col0 + ni * 16 + fq * 4) = pk;
            }
    }
};
struct EpiResid {
    const float* R; float* O;
    __device__ __forceinline__ void operator()(f32x4 (&acc)[4][4], int row0, int col0, int fr, int fq) const {
#pragma unroll
        for (int mi = 0; mi < 4; ++mi)
#pragma unroll
            for (int ni = 0; ni < 4; ++ni) {
                const size_t o = (size_t)(row0 + mi * 16 + fr) * 1024 + col0 + ni * 16 + fq * 4;
                const f32x4 r = *(const f32x4*)(R + o);
                *(f32x4*)(O + o) = r + acc[mi][ni];
            }
    }
};
__device__ __forceinline__ float rwkv_decay(float v) {
    return __expf(-0.60653065971263342f * sigmoidf_(v));
}
struct EpiLoraW {
    const float* w0; float* Wd;
    __device__ __forceinline__ void operator()(f32x4 (&acc)[4][4], int row0, int col0, int fr, int fq) const {
#pragma unroll
        for (int mi = 0; mi < 4; ++mi)
#pragma unroll
            for (int ni = 0; ni < 4; ++ni) {
                const int col = col0 + ni * 16 + fq * 4;
                const f32x4 b = *(const f32x4*)(w0 + col); const f32x4 a = acc[mi][ni] + b;
                f32x4 o; o.x = rwkv_decay(a.x); o.y = rwkv_decay(a.y); o.z = rwkv_decay(a.z); o.w = rwkv_decay(a.w);
                *(f32x4*)(Wd + (size_t)(row0 + mi * 16 + fr) * 1024 + col) = o;
            }
    }
};
struct EpiLoraA {
    const float* a0; unsigned short* Ai;
    __device__ __forceinline__ void operator()(f32x4 (&acc)[4][4], int row0, int col0, int fr, int fq) const {
#pragma unroll
        for (int mi = 0; mi < 4; ++mi)
#pragma unroll
            for (int ni = 0; ni < 4; ++ni) {
                const int col = col0 + ni * 16 + fq * 4;
                const f32x4 b = *(const f32x4*)(a0 + col); const f32x4 a = acc[mi][ni] + b;
                uint2 pk;
                pk.x = (unsigned)f2h(sigmoidf_(a.x)) | ((unsigned)f2h(sigmoidf_(a.y)) << 16);
                pk.y = (unsigned)f2h(sigmoidf_(a.z)) | ((unsigned)f2h(sigmoidf_(a.w)) << 16);
                *(uint2*)(Ai + (size_t)(row0 + mi * 16 + fr) * 1024 + col) = pk;
            }
    }
};


namespace pg8 {
#define PG8_LAS __attribute__((address_space(3)))
constexpr int BM = 256, BK = 64, HALF = 128, HTB = HALF * BK * 2, NXCD = 8, WGM = 8;
__device__ __forceinline__ int lds_byte(int r, int c) { const int st = (r >> 4) * 2 + (c >> 5), rr = r & 15, cc = c & 31, ob = rr * 64 + cc * 2; return st * 1024 + (ob ^ (((ob >> 9) & 1) << 5)); }
__device__ __forceinline__ void stage_rc(int b, int& R, int& C) { const int st = b / 1024, sb = b % 1024, swz = sb ^ (((sb >> 9) & 1) << 5); R = (st >> 1) * 16 + swz / 64; C = (st & 1) * 32 + (swz % 64) / 2; }
struct Unit { int pm, pn; };
struct Gemm { const bf16_t* A; const bf16_t* Bt; int M, N, K; };
struct StaticOrder {
    int nM, nN, nwg, G, c;
    __device__ void init(int M, int N, int G_, int c_) { nM = M / BM; nN = N / BM; nwg = nM * nN; G = G_; c = c_; }
    __device__ bool next(int i, Unit& u) const {
        const long L = (long)i * G + c; if (L >= nwg) return false;
        int wgid = (int)L; { const int q = nwg / NXCD, r = nwg % NXCD, xcd = wgid % NXCD, off = wgid / NXCD; wgid = (xcd < r ? xcd * (q + 1) : r * (q + 1) + (xcd - r) * q) + off; }
        const int nig = WGM * nN, gid = wgid / nig, fm = gid * WGM, gsz = (nM - fm) < WGM ? (nM - fm) : WGM;
        u.pm = fm + ((wgid % nig) % gsz); u.pn = (wgid % nig) / gsz; return true;
    }
};
template <class Epi>
__device__ __forceinline__ void gemm_phase(PG8_LAS unsigned char* lds, const Gemm g, const StaticOrder& S, const Epi& E) {
    const int tid = otid(), wid = __builtin_amdgcn_readfirstlane(tid >> 6), lane = tid & 63, wr = wid >> 2, wc = wid & 3, fr = lane & 15, fq = lane >> 4;
    const int K = g.K, nt = K / BK;
    unsigned voffA[2], voffB[2];
#pragma unroll
    for (int i = 0; i < 2; ++i) { int R, C; stage_rc(tid * 16 + i * 8192, R, C); voffA[i] = (unsigned)(R * K + C) * 2u; voffB[i] = (unsigned)(R * K + C) * 2u; }
    const size_t kstep = (size_t)(BK * 2);
    const size_t hstep = (size_t)HALF * K * 2;
    const size_t tstep = 2 * hstep;
    const unsigned ldsw = (unsigned)wid * 1024u;
    const int aoff = lds_byte(wr * 64 + fr, fq * 8), boff = lds_byte(wc * 32 + fr, fq * 8);
#define PG8_SA(b, h) (((b) * 2 + (h)) * HTB)
#define PG8_SB(b, h) ((4 + (b) * 2 + (h)) * HTB)
#define PG8_STAGE(bufoff, gbase, voff) do { _Pragma("unroll") for (int _i = 0; _i < 2; ++_i) \
        __builtin_amdgcn_global_load_lds((const unsigned*)((const char*)(gbase) + (voff)[_i]), (PG8_LAS unsigned*)(lds + (bufoff) + ldsw + _i * 8192), 16, 0, 0); } while (0)
#define PG8_LDA(dst, b, h) do { _Pragma("unroll") for (int m = 0; m < 4; ++m) _Pragma("unroll") for (int k = 0; k < 2; ++k) dst[m][k] = *(const PG8_LAS bf16x8*)(lds + PG8_SA(b, h) + aoff + m * 2048 + k * 1024); } while (0)
#define PG8_LDB(dst, b, h) do { _Pragma("unroll") for (int n = 0; n < 2; ++n) _Pragma("unroll") for (int k = 0; k < 2; ++k) dst[n][k] = *(const PG8_LAS bf16x8*)(lds + PG8_SB(b, h) + boff + n * 2048 + k * 1024); } while (0)
#define PG8_MMA(ai, bj, At, Bt) do { __builtin_amdgcn_s_setprio(1); _Pragma("unroll") for (int m = 0; m < 4; ++m) _Pragma("unroll") for (int n = 0; n < 2; ++n) _Pragma("unroll") for (int k = 0; k < 2; ++k) \
        acc[ai][bj][m][n] = __builtin_amdgcn_mfma_f32_16x16x32_bf16(Bt[n][k], At[m][k], acc[ai][bj][m][n], 0, 0, 0); __builtin_amdgcn_s_setprio(0); } while (0)
#define PG8_WAIT_V(n) asm volatile("s_waitcnt vmcnt(" #n ")" ::: "memory")
#define PG8_WAIT_L(n) asm volatile("s_waitcnt lgkmcnt(" #n ")" ::: "memory")
#define PG8_BAR __builtin_amdgcn_s_barrier()
#define PG8_SCHED __builtin_amdgcn_sched_barrier(0)
    Unit cur, nxt; int ui = 0;
    if (!S.next(0, cur)) return;
    f32x4 acc[2][2][4][2];
#pragma unroll
    for (int a = 0; a < 2; ++a)
#pragma unroll
        for (int b = 0; b < 2; ++b)
#pragma unroll
            for (int m = 0; m < 4; ++m)
#pragma unroll
                for (int n = 0; n < 2; ++n) acc[a][b][m][n] = (f32x4){0.f, 0.f, 0.f, 0.f};
    bf16x8 At[4][2], B0[2][2], B1[2][2];
    const char* cA = (const char*)g.A + (size_t)cur.pm * tstep; const char* cB = (const char*)g.Bt + (size_t)cur.pn * tstep;
    PG8_STAGE(PG8_SB(0, 0), cB, voffB); PG8_STAGE(PG8_SA(0, 0), cA, voffA); PG8_STAGE(PG8_SB(0, 1), cB + hstep, voffB); PG8_STAGE(PG8_SA(0, 1), cA + hstep, voffA);
    if (wr == 1) PG8_BAR;
    PG8_WAIT_V(4); PG8_BAR;
    PG8_STAGE(PG8_SB(1, 0), cB + kstep, voffB); PG8_STAGE(PG8_SA(1, 0), cA + kstep, voffA); PG8_STAGE(PG8_SB(1, 1), cB + hstep + kstep, voffB);
    PG8_WAIT_V(6); PG8_BAR;
    for (;;) {
        const bool has_next = S.next(ui + 1, nxt);
        const char* nA = has_next ? (const char*)g.A + (size_t)nxt.pm * tstep : cA; const char* nB = has_next ? (const char*)g.Bt + (size_t)nxt.pn * tstep : cB;
        for (int t = 0; t < nt; t += 2) {
            const bool last = (t == nt - 2);
            const char* a1 = cA + (size_t)(t + 1) * kstep;
            const char* a2 = last ? nA : cA + (size_t)(t + 2) * kstep; const char* b2 = last ? nB : cB + (size_t)(t + 2) * kstep;
            const char* a3 = a2 + kstep; const char* b3 = b2 + kstep;
            PG8_LDB(B0, 0, 0); PG8_SCHED; PG8_LDA(At, 0, 0); PG8_STAGE(PG8_SA(1, 1), a1 + hstep, voffA);
            PG8_WAIT_L(8); PG8_BAR; PG8_WAIT_L(0); PG8_MMA(0, 0, At, B0); PG8_BAR; PG8_SCHED;
            PG8_LDB(B1, 0, 1); PG8_STAGE(PG8_SB(0, 0), b2, voffB);
            PG8_BAR; PG8_WAIT_L(0); PG8_MMA(0, 1, At, B1); PG8_BAR;
            PG8_LDA(At, 0, 1); PG8_STAGE(PG8_SA(0, 0), a2, voffA);
            PG8_BAR; PG8_WAIT_L(0); PG8_MMA(1, 0, At, B0); PG8_BAR; PG8_SCHED;
            PG8_STAGE(PG8_SB(0, 1), b2 + hstep, voffB);
            PG8_WAIT_V(6); PG8_BAR; PG8_MMA(1, 1, At, B1); PG8_BAR;
            PG8_LDB(B0, 1, 0); PG8_SCHED; PG8_LDA(At, 1, 0); PG8_STAGE(PG8_SA(0, 1), a2 + hstep, voffA);
            PG8_WAIT_L(8); PG8_BAR; PG8_WAIT_L(0); PG8_MMA(0, 0, At, B0); PG8_BAR; PG8_SCHED;
            PG8_LDB(B1, 1, 1); PG8_STAGE(PG8_SB(1, 0), b3, voffB);
            PG8_BAR; PG8_WAIT_L(0); PG8_MMA(0, 1, At, B1); PG8_BAR;
            PG8_LDA(At, 1, 1); PG8_STAGE(PG8_SA(1, 0), a3, voffA);
            PG8_BAR; PG8_WAIT_L(0); PG8_MMA(1, 0, At, B0); PG8_BAR; PG8_SCHED;
            PG8_STAGE(PG8_SB(1, 1), b3 + hstep, voffB);
            PG8_WAIT_V(6); PG8_BAR; PG8_MMA(1, 1, At, B1); PG8_BAR;
        }
        E(acc, cur, wr, wc, fr, fq);
        if (!has_next) break;
#pragma unroll
        for (int a = 0; a < 2; ++a)
#pragma unroll
            for (int b = 0; b < 2; ++b)
#pragma unroll
                for (int m = 0; m < 4; ++m)
#pragma unroll
                    for (int n = 0; n < 2; ++n) acc[a][b][m][n] = (f32x4){0.f, 0.f, 0.f, 0.f};
        cur = nxt; cA = nA; cB = nB; ++ui;
    }
    PG8_WAIT_V(0);
    if (wr == 0) PG8_BAR;
    PG8_BAR;
#undef PG8_SA
#undef PG8_SB
#undef PG8_STAGE
#undef PG8_LDA
#undef PG8_LDB
#undef PG8_MMA
#undef PG8_WAIT_V
#undef PG8_WAIT_L
#undef PG8_BAR
#undef PG8_SCHED
}
#define PG8_FOREACH(body) \
    _Pragma("unroll") for (int ai = 0; ai < 2; ++ai) _Pragma("unroll") for (int m = 0; m < 4; ++m) { const int row = u.pm * 256 + ai * 128 + wr * 64 + m * 16 + fr; \
    _Pragma("unroll") for (int bj = 0; bj < 2; ++bj) _Pragma("unroll") for (int n = 0; n < 2; ++n) { const int col = u.pn * 256 + bj * 128 + wc * 32 + n * 16 + fq * 4; f32x4 a = acc[ai][bj][m][n]; body } }
struct EStoreBf16 {
    bf16_t* C; int ldc; int ncols;
    __device__ __forceinline__ void operator()(const f32x4 (&acc)[2][2][4][2], const Unit& u, int wr, int wc, int fr, int fq) const {
        const int nbj = (u.pn * 256 + 256 <= ncols) ? 2 : 1;
#pragma unroll
        for (int ai = 0; ai < 2; ++ai)
#pragma unroll
            for (int m = 0; m < 4; ++m) { const int row = u.pm * 256 + ai * 128 + wr * 64 + m * 16 + fr;
                for (int bj = 0; bj < nbj; ++bj)
#pragma unroll
                    for (int n = 0; n < 2; ++n) { const int col = u.pn * 256 + bj * 128 + wc * 32 + n * 16 + fq * 4; const f32x4 a = acc[ai][bj][m][n];
                        uint2 pk; pk.x = pack2bf(a.x, a.y); pk.y = pack2bf(a.z, a.w); *(uint2*)(C + (size_t)row * ldc + col) = pk; } }
    }
};
struct EHgrn {
    bf16_t* C; const float* lb;
    __device__ __forceinline__ void operator()(const f32x4 (&acc)[2][2][4][2], const Unit& u, int wr, int wc, int fr, int fq) const {
        const int blk = (u.pn * 256) >> 10;
        PG8_FOREACH( uint2 pk;
            if (blk == 1) { const f32x4 l = *(const f32x4*)(lb + (col - 1024));
                a.x = (1.f - l.x) * sigmoidf_(-a.x); a.y = (1.f - l.y) * sigmoidf_(-a.y); a.z = (1.f - l.z) * sigmoidf_(-a.z); a.w = (1.f - l.w) * sigmoidf_(-a.w);
                pk.x = (unsigned)f2h(a.x) | ((unsigned)f2h(a.y) << 16); pk.y = (unsigned)f2h(a.z) | ((unsigned)f2h(a.w) << 16);
            } else { if (blk == 3) { a.x = siluf_(a.x); a.y = siluf_(a.y); a.z = siluf_(a.z); a.w = siluf_(a.w); }
                pk.x = pack2bf(a.x, a.y); pk.y = pack2bf(a.z, a.w); }
            *(uint2*)(C + (size_t)row * 4096 + col) = pk; )
    }
};
struct EGmlp {
    bf16_t* C;
    __device__ __forceinline__ void operator()(const f32x4 (&acc)[2][2][4][2], const Unit& u, int wr, int wc, int fr, int fq) const {
        const int blk = (u.pn * 256) >> 10;
        PG8_FOREACH( if (blk == 2) { a.x = siluf_(a.x); a.y = siluf_(a.y); a.z = siluf_(a.z); a.w = siluf_(a.w); }
            uint2 pk; pk.x = pack2bf(a.x, a.y); pk.y = pack2bf(a.z, a.w); *(uint2*)(C + (size_t)row * 3072 + col) = pk; )
    }
};
struct EResid {
    const float* R; float* O;
    __device__ __forceinline__ void operator()(const f32x4 (&acc)[2][2][4][2], const Unit& u, int wr, int wc, int fr, int fq) const {
        PG8_FOREACH( const size_t o = (size_t)row * 1024 + col; const f32x4 r = *(const f32x4*)(R + o); *(f32x4*)(O + o) = r + a; )
    }
};
struct EConv {
    bf16_t* Yc; bf16_t* U;
    __device__ __forceinline__ void operator()(const f32x4 (&acc)[2][2][4][2], const Unit& u, int wr, int wc, int fr, int fq) const {
        const int ch = u.pn * 64 + wc * 16 + fq * 4;
#pragma unroll
        for (int ai = 0; ai < 2; ++ai)
#pragma unroll
            for (int m = 0; m < 4; ++m) {
                const int row = u.pm * 256 + ai * 128 + wr * 64 + m * 16 + fr;
                const f32x4 b = acc[ai][0][m][0], c = acc[ai][0][m][1], z = acc[ai][1][m][0], g = acc[ai][1][m][1];
                const size_t o = (size_t)row * 1024 + ch;
                uint2 py, pu;
                py.x = pack2bf(c.x * z.x, c.y * z.y); py.y = pack2bf(c.z * z.z, c.w * z.w);
                pu.x = pack2bf(b.x * siluf_(g.x), b.y * siluf_(g.y)); pu.y = pack2bf(b.z * siluf_(g.z), b.w * siluf_(g.w));
                *(uint2*)(Yc + o) = py; *(uint2*)(U + o) = pu;
            }
    }
};
template <class Epi>
__device__ __forceinline__ void run(char* smem, const bf16_t* A, const bf16_t* Bt, int N, const Epi& E) {
    StaticOrder S; S.init(M_TOK, N, (int)gridDim.x, (int)blockIdx.x);
    gemm_phase((PG8_LAS unsigned char*)smem, Gemm{A, Bt, M_TOK, N, 1024}, S, E);
    __syncthreads();
}
}

__device__ __forceinline__ void rwkv_lin_phase(const bf16_t* P, const float* __restrict__ mu, bf16_t* Lin) {
    const int gtid = blockIdx.x * NTHREADS + otid(), gsz = gridDim.x * NTHREADS;
    for (int idx = gtid; idx < M_TOK * 64; idx += gsz) {
        const int tok = idx >> 6, cp = (idx & 63) * 2, col = 3072 + cp;
        const unsigned pc = *(const unsigned*)(P + (size_t)tok * RW_COLS + col);
        unsigned pp = 0u;
        if ((tok & (SEQ_T - 1)) != 0) pp = *(const unsigned*)(P + (size_t)(tok - 1) * RW_COLS + col);
        const float m0 = mu[col], m1 = mu[col + 1];
        float x0 = bflo(pc) + (bflo(pp) - bflo(pc)) * m0;
        float x1 = bfhi(pc) + (bfhi(pp) - bfhi(pc)) * m1;
        if (cp < 64) { x0 = tanhf(x0); x1 = tanhf(x1); }
        *(unsigned*)(Lin + (size_t)tok * 128 + cp) = pack2bf(x0, x1);
    }
}

constexpr int RW_TC = 32;
typedef float f32x2 __attribute__((ext_vector_type(2)));
struct RwRaw { uint2 cr, ck, cv, pr, pk, pv, a; f32x4 w; };
__device__ __forceinline__ RwRaw rw_load_raw(const bf16_t* P, const float* Wd, const unsigned short* Ai, size_t tokbase, int t, int hcol) {
    RwRaw r;
    const size_t tok = tokbase + t;
    const bf16_t* pr = P + tok * RW_COLS + hcol;
    r.cr = *(const uint2*)(pr); r.ck = *(const uint2*)(pr + 1024); r.cv = *(const uint2*)(pr + 2048);
    { const bf16_t* pp = (t > 0) ? pr - RW_COLS : pr; r.pr = *(const uint2*)(pp); r.pk = *(const uint2*)(pp + 1024); r.pv = *(const uint2*)(pp + 2048);
      const unsigned msk = (t > 0) ? 0xFFFFFFFFu : 0u; r.pr.x &= msk; r.pr.y &= msk; r.pk.x &= msk; r.pk.y &= msk; r.pv.x &= msk; r.pv.y &= msk; }
    r.w = *(const f32x4*)(Wd + tok * 1024 + hcol);
    r.a = *(const uint2*)(Ai + tok * 1024 + hcol);
    return r;
}
__device__ __forceinline__ void rw_process(const RwRaw& x, const f32x4 mur, const f32x4 muk, const f32x4 muv, const f32x4 kkc, const f32x4 kac, float* d) {
    f32x4 rc = {bflo(x.cr.x), bfhi(x.cr.x), bflo(x.cr.y), bfhi(x.cr.y)}, rp = {bflo(x.pr.x), bfhi(x.pr.x), bflo(x.pr.y), bfhi(x.pr.y)};
    f32x4 kc = {bflo(x.ck.x), bfhi(x.ck.x), bflo(x.ck.y), bfhi(x.ck.y)}, kp = {bflo(x.pk.x), bfhi(x.pk.x), bflo(x.pk.y), bfhi(x.pk.y)};
    f32x4 vc = {bflo(x.cv.x), bfhi(x.cv.x), bflo(x.cv.y), bfhi(x.cv.y)}, vp = {bflo(x.pv.x), bfhi(x.pv.x), bflo(x.pv.y), bfhi(x.pv.y)};
    const f32x4 a = {h2f((unsigned short)(x.a.x & 0xFFFFu)), h2f((unsigned short)(x.a.x >> 16)), h2f((unsigned short)(x.a.y & 0xFFFFu)), h2f((unsigned short)(x.a.y >> 16))};
    const f32x4 r1 = rc + (rp - rc) * mur, k1 = kc + (kp - kc) * muk, v1 = vc + (vp - vc) * muv;
    const f32x4 kkv = k1 * kkc;
    float n2 = kkv.x * kkv.x + kkv.y * kkv.y + kkv.z * kkv.z + kkv.w * kkv.w;
    n2 = sum16(n2);
    const float inv = rsqrtf(fmaxf(n2, 1e-24f));
    const f32x4 kk = kkv * inv;
    const f32x4 k2 = k1 * (1.f + (a - 1.f) * kac);
    *(f32x4*)(d) = r1; *(f32x4*)(d + 64) = x.w; *(f32x4*)(d + 128) = k2; *(f32x4*)(d + 192) = v1; *(f32x4*)(d + 256) = -kk; *(f32x4*)(d + 320) = kk * a;
}
__device__ __forceinline__ void rwkv_scan_phase(const Params& p, char* smem) {
    float* buf = (float*)smem;
    const bf16_t* P = (const bf16_t*)(p.ws + OFF_P);
    const float* Wd = (const float*)(p.ws + OFF_X);
    const unsigned short* Ai = (const unsigned short*)(p.ws + OFF_Y);
    float* Y = p.out;
    const float* mu = p.in[4]; const float* k_k = p.in[9]; const float* k_a = p.in[10];
    const int tid = otid(), lane = tid & 63, wid = __builtin_amdgcn_readfirstlane(tid >> 6);
    constexpr int NCH = SEQ_T / RW_TC;
    const int sub = lane >> 4, q = lane & 15;
    for (int unit = blockIdx.x; unit < 256; unit += gridDim.x) {
        const int bh = unit >> 2, rg = unit & 3, b = bh >> 4, h = bh & 15;
        const size_t tokbase = (size_t)b * SEQ_T;
        __syncthreads();
        if (wid >= 4) {
            const int hcol = h * 64 + q * 4, lw = wid - 4;
            const f32x4 mur = *(const f32x4*)(mu + hcol), muk = *(const f32x4*)(mu + 1024 + hcol), muv = *(const f32x4*)(mu + 2048 + hcol);
            const f32x4 kkc = *(const f32x4*)(k_k + hcol), kac = *(const f32x4*)(k_a + hcol);
            const int tl0 = lw * 4 + sub, tl1 = 16 + lw * 4 + sub;
            RwRaw x0 = rw_load_raw(P, Wd, Ai, tokbase, tl0, hcol), x1 = rw_load_raw(P, Wd, Ai, tokbase, tl1, hcol);
            for (int c = -1; c < NCH; ++c) {
                if (c + 1 < NCH) {
                    const int cn = c + 1; float* db = buf + (cn & 1) * (RW_TC * 384) + q * 4;
                    rw_process(x0, mur, muk, muv, kkc, kac, db + tl0 * 384);
                    rw_process(x1, mur, muk, muv, kkc, kac, db + tl1 * 384);
                    { const int cl = (cn + 1 < NCH) ? cn + 1 : cn; x0 = rw_load_raw(P, Wd, Ai, tokbase, cl * RW_TC + tl0, hcol); x1 = rw_load_raw(P, Wd, Ai, tokbase, cl * RW_TC + tl1, hcol); }
                }
                __syncthreads();
            }
        } else {
            f32x2 Sa = {0.f, 0.f}, Sb = {0.f, 0.f};
            const int rowl = wid * 4 + sub;
            float* ybase = Y + tokbase * 1024 + h * 64 + rg * 16 + rowl;
            __syncthreads();
            for (int c = 0; c < NCH; ++c) {
                const float* cb = buf + (c & 1) * (RW_TC * 384) + q * 4;
                const float* vb = buf + (c & 1) * (RW_TC * 384) + 192 + rg * 16 + rowl;
                f32x4 r4 = *(const f32x4*)(cb), w4 = *(const f32x4*)(cb + 64), k4 = *(const f32x4*)(cb + 128), a4 = *(const f32x4*)(cb + 256), b4 = *(const f32x4*)(cb + 320);
                float vv = vb[0];
                float ykeep = 0.f;
#pragma unroll
                for (int tl = 0; tl < RW_TC; ++tl) {
                    f32x4 nr = r4, nw = w4, nk = k4, na = a4, nb = b4; float nv = vv;
                    if (tl + 1 < RW_TC) {
                        const float* s = cb + (tl + 1) * 384;
                        nr = *(const f32x4*)(s); nw = *(const f32x4*)(s + 64); nk = *(const f32x4*)(s + 128); na = *(const f32x4*)(s + 256); nb = *(const f32x4*)(s + 320);
                        nv = vb[(tl + 1) * 384];
                    }
                    __builtin_amdgcn_sched_barrier(0);
                    f32x2 pa = Sa * (f32x2){a4.x, a4.y};
                    pa = __builtin_elementwise_fma(Sb, (f32x2){a4.z, a4.w}, pa);
                    const float sa = sum16(pa.x + pa.y);
                    const f32x2 ta = __builtin_elementwise_fma((f32x2){k4.x, k4.y}, (f32x2){vv, vv}, (f32x2){b4.x, b4.y} * sa);
                    const f32x2 tb = __builtin_elementwise_fma((f32x2){k4.z, k4.w}, (f32x2){vv, vv}, (f32x2){b4.z, b4.w} * sa);
                    Sa = __builtin_elementwise_fma(Sa, (f32x2){w4.x, w4.y}, ta);
                    Sb = __builtin_elementwise_fma(Sb, (f32x2){w4.z, w4.w}, tb);
                    f32x2 py = Sa * (f32x2){r4.x, r4.y};
                    py = __builtin_elementwise_fma(Sb, (f32x2){r4.z, r4.w}, py);
                    const float y = sum16(py.x + py.y);
                    ykeep = (q == (tl & 15)) ? y : ykeep;
                    if ((tl & 15) == 15) ybase[(size_t)(c * RW_TC + (tl - 15) + q) * 1024] = ykeep;
                    __builtin_amdgcn_sched_barrier(0);
                    r4 = nr; w4 = nw; k4 = nk; a4 = na; b4 = nb; vv = nv;
                }
                __syncthreads();
            }
        }
    }
}

constexpr int RC = 16, RNCH = SEQ_T / RC;
constexpr int RS_AT = 0, RS_RT = 2048, RS_BKT = 4096, RS_AKP = 8192, RS_BRP = 9216, RS_TP = 10240, RS_VT = 11264, RS_WC = 11776, RS_SLOT = 12032;
constexpr int RS_SCR = 8 * RS_SLOT, RS_ST = RS_SCR + 7 * 4096;
static_assert(RS_ST + 16 * 72 * 2 + 128 <= LDS_STAGE, "rwkv chunk LDS overflow");
__device__ __forceinline__ float wave_sum64(float x) {
    x = sum16(x);
    unsigned xi = __float_as_uint(x);
    const auto r = __builtin_amdgcn_permlane16_swap(xi, xi, false, false);
    x = __uint_as_float(r[0]) + __uint_as_float(r[1]);
    xi = __float_as_uint(x);
    const auto r2 = __builtin_amdgcn_permlane32_swap(xi, xi, false, false);
    return __uint_as_float(r2[0]) + __uint_as_float(r2[1]);
}
__device__ __forceinline__ bf16x8 mk_frag(unsigned a, unsigned b, unsigned c, unsigned d) { const uint4 u = make_uint4(a, b, c, d); return __builtin_bit_cast(bf16x8, u); }
template <int L>
__device__ __forceinline__ float rw_nfetch(int g, float dep) {
    int r;
    asm volatile("v_readlane_b32 %0, %1, %2\n\ts_nop 0" : "=s"(r) : "v"(g), "n"(L), "v"(dep));
    return __int_as_float(r);
}
struct RwStg {
    float W, pr, pk, pv;
    float bt[16], kt[16];
    unsigned short nr[4], nk[4], nv[4], na[4]; float nw[4];
    unsigned short ppr, ppk, ppv;
    int gx, gy, gz, gw;
};
__device__ __forceinline__ void rwkv_chunk_phase(const Params& p, char* smem) {
    const bf16_t* P = (const bf16_t*)(p.ws + OFF_P);
    const float* Wd = (const float*)(p.ws + OFF_X);
    const unsigned short* Ai = (const unsigned short*)(p.ws + OFF_Y);
    float* Y = p.out;
    const float* mu = p.in[4]; const float* k_k = p.in[9]; const float* k_a = p.in[10];
    const int tid = otid(), lane = tid & 63, wid = __builtin_amdgcn_readfirstlane(tid >> 6), fr = lane & 15, fq = lane >> 4;
    for (int unit = blockIdx.x; unit < 256; unit += gridDim.x) {
        const int bh = unit >> 2, rg = unit & 3, b = bh >> 4, h = bh & 15;
        const size_t tokbase = (size_t)b * SEQ_T;
        __syncthreads();
        f32x4 accS[4];
#pragma unroll
        for (int i = 0; i < 4; ++i) accS[i] = (f32x4){0.f, 0.f, 0.f, 0.f};
        RwStg st; st.W = 1.f; st.pr = 0.f; st.pk = 0.f; st.pv = 0.f;
        const int col = h * 64 + lane;
        const float mur = mu[col], muk = mu[1024 + col], muv = mu[2048 + col], kkc = k_k[col], kac = k_a[col];
        const int sw = wid - 1;
        bf16_t* BTs = (bf16_t*)(smem + RS_SCR + (sw < 0 ? 0 : sw) * 4096);
        bf16_t* KTs = BTs + 1024;
        const bf16_t* Pl = P + tokbase * RW_COLS + col; const float* Wl = Wd + tokbase * 1024 + col; const unsigned short* Al = Ai + tokbase * 1024 + col;
#define RW_LD(S, TOK) do { const unsigned tr_ = (unsigned)__builtin_amdgcn_readfirstlane((int)((TOK) - tokbase)); const bf16_t* pr_ = Pl + tr_ * (unsigned)RW_COLS; st.nr[S] = pr_[0]; st.nk[S] = pr_[1024]; st.nv[S] = pr_[2048]; \
            st.nw[S] = Wl[tr_ * 1024u]; st.na[S] = Al[tr_ * 1024u]; } while (0)
#define RW_LDPREV(CH) do { const int ch_ = (CH); const unsigned tr_ = (unsigned)__builtin_amdgcn_readfirstlane(ch_ > 0 ? ch_ * RC - 1 : 0); const bf16_t* pp_ = Pl + tr_ * (unsigned)RW_COLS; \
            st.ppr = pp_[0]; st.ppk = pp_[1024]; st.ppv = pp_[2048]; } while (0)
        if (wid == 0) {
            for (int i = lane; i < 16 * 72 / 2; i += 64) *(unsigned*)(smem + RS_ST + i * 4) = 0u;
        } else {
            const int c0 = (sw < RNCH) ? sw : RNCH - 1;
            RW_LD(0, tokbase + (size_t)c0 * RC + 0); RW_LD(1, tokbase + (size_t)c0 * RC + 1); RW_LD(2, tokbase + (size_t)c0 * RC + 2); RW_LD(3, tokbase + (size_t)c0 * RC + 3); RW_LDPREV(c0);
        }
        __syncthreads();
        if (wid == 0) {
            for (int per = 0; per < RNCH + 7; ++per) {
                const int c = per - 7;
                if (c >= 0) {
                    const char* sl = smem + (c & 7) * RS_SLOT;
                    const bf16_t* STr = (const bf16_t*)(smem + RS_ST) + fr * 72 + fq * 8;
                    const bf16x8 st0 = *(const bf16x8*)(STr), st1 = *(const bf16x8*)(STr + 32);
                    const bf16_t* ATr = (const bf16_t*)(sl + RS_AT) + fr * 64 + fq * 8;
                    const bf16x8 a0 = *(const bf16x8*)(ATr), a1 = *(const bf16x8*)(ATr + 32);
                    const bf16_t* RTr = (const bf16_t*)(sl + RS_RT) + fr * 64 + fq * 8;
                    const bf16x8 r0 = *(const bf16x8*)(RTr), r1 = *(const bf16x8*)(RTr + 32);
                    const bf16x8 akp = *(const bf16x8*)((const bf16_t*)(sl + RS_AKP) + fr * 32 + fq * 8);
                    const bf16x8 brp = *(const bf16x8*)((const bf16_t*)(sl + RS_BRP) + fr * 32 + fq * 8);
                    const bf16x8 tpf = *(const bf16x8*)((const bf16_t*)(sl + RS_TP) + fr * 32 + fq * 8);
                    const uint2 vt = *(const uint2*)((const bf16_t*)(sl + RS_VT) + fr * 16 + fq * 4);
                    bf16x8 bk[4]; f32x4 wc4[4];
#pragma unroll
                    for (int kt = 0; kt < 4; ++kt) { bk[kt] = *(const bf16x8*)((const bf16_t*)(sl + RS_BKT) + (kt * 16 + fr) * 32 + fq * 8); wc4[kt] = *(const f32x4*)((const float*)(sl + RS_WC) + kt * 16 + fq * 4); }
                    f32x4 u = {0.f, 0.f, 0.f, 0.f};
                    u = __builtin_amdgcn_mfma_f32_16x16x32_bf16(a0, st0, u, 0, 0, 0);
                    u = __builtin_amdgcn_mfma_f32_16x16x32_bf16(a1, st1, u, 0, 0, 0);
                    u = __builtin_amdgcn_mfma_f32_16x16x32_bf16(akp, mk_frag(vt.x, vt.y, 0u, 0u), u, 0, 0, 0);
                    f32x4 sv = {0.f, 0.f, 0.f, 0.f};
                    sv = __builtin_amdgcn_mfma_f32_16x16x32_bf16(tpf, mk_frag(pack2bf(u.x, u.y), pack2bf(u.z, u.w), 0u, 0u), sv, 0, 0, 0);
                    const bf16x8 f3 = mk_frag(pack2bf(sv.x, sv.y), pack2bf(sv.z, sv.w), vt.x, vt.y);
                    f32x4 yv = {0.f, 0.f, 0.f, 0.f};
                    yv = __builtin_amdgcn_mfma_f32_16x16x32_bf16(st0, r0, yv, 0, 0, 0);
                    yv = __builtin_amdgcn_mfma_f32_16x16x32_bf16(st1, r1, yv, 0, 0, 0);
                    yv = __builtin_amdgcn_mfma_f32_16x16x32_bf16(f3, brp, yv, 0, 0, 0);
                    *(f32x4*)(Y + (tokbase + (size_t)c * RC + fr) * 1024 + h * 64 + rg * 16 + fq * 4) = yv;
#pragma unroll
                    for (int kt = 0; kt < 4; ++kt) {
                        accS[kt] = accS[kt] * wc4[kt];
                        accS[kt] = __builtin_amdgcn_mfma_f32_16x16x32_bf16(bk[kt], f3, accS[kt], 0, 0, 0);
                        uint2 pk; pk.x = pack2bf(accS[kt].x, accS[kt].y); pk.y = pack2bf(accS[kt].z, accS[kt].w);
                        *(uint2*)((bf16_t*)(smem + RS_ST) + fr * 72 + kt * 16 + fq * 4) = pk;
                    }
                }
                __syncthreads();
            }
        } else {
            for (int per = 0; per < RNCH + 7; ++per) {
                const int q = per - sw;
                const int c = (q >= 0) ? 7 * (q / 7) + sw : RNCH;
                if (c < RNCH) {
                    const int part = q % 7;
                    char* sl = smem + (c & 7) * RS_SLOT;
                    bf16_t* ATw = (bf16_t*)(sl + RS_AT); bf16_t* RTw = (bf16_t*)(sl + RS_RT);
                    const size_t tok0 = tokbase + (size_t)c * RC;
                    unsigned short cr[4], ck[4], cv[4], ca[4]; float cw[4];
#pragma unroll
                    for (int i = 0; i < 4; ++i) { cr[i] = st.nr[i]; ck[i] = st.nk[i]; cv[i] = st.nv[i]; ca[i] = st.na[i]; cw[i] = st.nw[i]; }
#define RW_TS(J, S) do { const float r0_ = bf2f(cr[S]), k0_ = bf2f(ck[S]), v0_ = bf2f(cv[S]); const float w_ = cw[S], a_ = h2f(ca[S]); \
                        const float r1_ = r0_ + (st.pr - r0_) * mur, k1_ = k0_ + (st.pk - k0_) * muk, v1_ = v0_ + (st.pv - v0_) * muv; st.pr = r0_; st.pk = k0_; st.pv = v0_; \
                        const float kkv_ = k1_ * kkc; const float n2_ = wave_sum64(kkv_ * kkv_); const float kk_ = kkv_ * rsqrtf(fmaxf(n2_, 1e-24f)); \
                        const float k2_ = k1_ * (1.f + (a_ - 1.f) * kac); \
                        const float at_ = -kk_ * st.W; st.W *= w_; const float rt_ = r1_ * st.W; const float iw_ = __builtin_amdgcn_rcpf(st.W); \
                        const float bt_ = kk_ * a_ * iw_, kt_ = k2_ * iw_; st.bt[J] = bt_; st.kt[J] = kt_; \
                        ATw[(J) * 64 + lane] = f2bf(at_); RTw[(J) * 64 + lane] = f2bf(rt_); BTs[(J) * 64 + lane] = f2bf(bt_); KTs[(J) * 64 + lane] = f2bf(kt_); \
                        *((fq == rg) ? ((bf16_t*)(sl + RS_VT) + fr * 16 + (J)) : ((bf16_t*)(smem + RS_ST + 2304) + lane)) = f2bf(v1_); } while (0)
                    switch (part) {
                    case 0: {
                        RW_LD(0, tok0 + 4); RW_LD(1, tok0 + 5); RW_LD(2, tok0 + 6); RW_LD(3, tok0 + 7);
                        st.W = 1.f;
                        if (c > 0) { st.pr = bf2f(st.ppr); st.pk = bf2f(st.ppk); st.pv = bf2f(st.ppv); } else { st.pr = 0.f; st.pk = 0.f; st.pv = 0.f; }
                        RW_TS(0, 0); RW_TS(1, 1); RW_TS(2, 2); RW_TS(3, 3);
                    } break;
                    case 1: { RW_LD(0, tok0 + 8); RW_LD(1, tok0 + 9); RW_LD(2, tok0 + 10); RW_LD(3, tok0 + 11); RW_TS(4, 0); RW_TS(5, 1); RW_TS(6, 2); RW_TS(7, 3); } break;
                    case 2: { RW_LD(0, tok0 + 12); RW_LD(1, tok0 + 13); RW_LD(2, tok0 + 14); RW_LD(3, tok0 + 15); RW_TS(8, 0); RW_TS(9, 1); RW_TS(10, 2); RW_TS(11, 3); } break;
                    case 3: {
                        RW_TS(12, 0); RW_TS(13, 1); RW_TS(14, 2); RW_TS(15, 3);
                        const float WC = st.W;
                        ((float*)(sl + RS_WC))[lane] = WC;
                        bf16_t* BKw = (bf16_t*)(sl + RS_BKT) + lane * 32;
#define RW_BKG(G) do { uint4 o; \
                            o.x = pack2bf(st.bt[4 * (G) + 0] * WC, st.bt[4 * (G) + 1] * WC); o.y = pack2bf(st.bt[4 * (G) + 2] * WC, st.bt[4 * (G) + 3] * WC); \
                            o.z = pack2bf(st.kt[4 * (G) + 0] * WC, st.kt[4 * (G) + 1] * WC); o.w = pack2bf(st.kt[4 * (G) + 2] * WC, st.kt[4 * (G) + 3] * WC); \
                            *(uint4*)(BKw + (G) * 8) = o; } while (0)
                        RW_BKG(0); RW_BKG(1); RW_BKG(2); RW_BKG(3);
#undef RW_BKG
                    } break;
                    case 4: {
                        const bf16_t* ATr = ATw + fr * 64 + fq * 8; const bf16_t* RTr = RTw + fr * 64 + fq * 8; const bf16_t* BTr = BTs + fr * 64 + fq * 8; const bf16_t* KTr = KTs + fr * 64 + fq * 8;
                        const bf16x8 a0 = *(const bf16x8*)(ATr), a1 = *(const bf16x8*)(ATr + 32), r0 = *(const bf16x8*)(RTr), r1 = *(const bf16x8*)(RTr + 32);
                        const bf16x8 b0 = *(const bf16x8*)(BTr), b1 = *(const bf16x8*)(BTr + 32), k0 = *(const bf16x8*)(KTr), k1 = *(const bf16x8*)(KTr + 32);
                        f32x4 gab = {0.f, 0.f, 0.f, 0.f}, gak = gab, grb = gab, grk = gab;
                        gab = __builtin_amdgcn_mfma_f32_16x16x32_bf16(b0, a0, gab, 0, 0, 0); gab = __builtin_amdgcn_mfma_f32_16x16x32_bf16(b1, a1, gab, 0, 0, 0);
                        gak = __builtin_amdgcn_mfma_f32_16x16x32_bf16(k0, a0, gak, 0, 0, 0); gak = __builtin_amdgcn_mfma_f32_16x16x32_bf16(k1, a1, gak, 0, 0, 0);
                        grb = __builtin_amdgcn_mfma_f32_16x16x32_bf16(b0, r0, grb, 0, 0, 0); grb = __builtin_amdgcn_mfma_f32_16x16x32_bf16(b1, r1, grb, 0, 0, 0);
                        grk = __builtin_amdgcn_mfma_f32_16x16x32_bf16(k0, r0, grk, 0, 0, 0); grk = __builtin_amdgcn_mfma_f32_16x16x32_bf16(k1, r1, grk, 0, 0, 0);
                        const int j0 = fq * 4;
                        gab.x = (j0 + 0 < fr) ? gab.x : 0.f; gab.y = (j0 + 1 < fr) ? gab.y : 0.f; gab.z = (j0 + 2 < fr) ? gab.z : 0.f; gab.w = (j0 + 3 < fr) ? gab.w : 0.f;
                        gak.x = (j0 + 0 < fr) ? gak.x : 0.f; gak.y = (j0 + 1 < fr) ? gak.y : 0.f; gak.z = (j0 + 2 < fr) ? gak.z : 0.f; gak.w = (j0 + 3 < fr) ? gak.w : 0.f;
                        grb.x = (j0 + 0 <= fr) ? grb.x : 0.f; grb.y = (j0 + 1 <= fr) ? grb.y : 0.f; grb.z = (j0 + 2 <= fr) ? grb.z : 0.f; grb.w = (j0 + 3 <= fr) ? grb.w : 0.f;
                        grk.x = (j0 + 0 <= fr) ? grk.x : 0.f; grk.y = (j0 + 1 <= fr) ? grk.y : 0.f; grk.z = (j0 + 2 <= fr) ? grk.z : 0.f; grk.w = (j0 + 3 <= fr) ? grk.w : 0.f;
                        *(uint4*)((bf16_t*)(sl + RS_AKP) + fr * 32 + fq * 8) = make_uint4(pack2bf(gak.x, gak.y), pack2bf(gak.z, gak.w), 0u, 0u);
                        *(uint4*)((bf16_t*)(sl + RS_BRP) + fr * 32 + fq * 8) = make_uint4(pack2bf(grb.x, grb.y), pack2bf(grb.z, grb.w), pack2bf(grk.x, grk.y), pack2bf(grk.z, grk.w));
                        st.gx = __float_as_int(gab.x); st.gy = __float_as_int(gab.y); st.gz = __float_as_int(gab.z); st.gw = __float_as_int(gab.w);
                    } break;
#define RW_GSEL(J) ((((J) & 3) == 0) ? st.gx : ((((J) & 3) == 1) ? st.gy : ((((J) & 3) == 2) ? st.gz : st.gw)))
#define RW_TJ(T, J) do { if ((J) < (T)) acc = fmaf(rw_nfetch<(T) + 16 * ((J) >> 2)>(RW_GSEL(J), acc), Tr[(J)], acc); } while (0)
#define RW_TROW(T) do { float acc = ((T) == fr) ? 1.f : 0.f; RW_TJ(T, 0); RW_TJ(T, 1); RW_TJ(T, 2); RW_TJ(T, 3); RW_TJ(T, 4); RW_TJ(T, 5); RW_TJ(T, 6); RW_TJ(T, 7); \
                        RW_TJ(T, 8); RW_TJ(T, 9); RW_TJ(T, 10); RW_TJ(T, 11); RW_TJ(T, 12); RW_TJ(T, 13); RW_TJ(T, 14); RW_TJ(T, 15); Tr[(T)] = acc; } while (0)
                    case 5: {
                        float Tr[16];
                        RW_TROW(0); RW_TROW(1); RW_TROW(2); RW_TROW(3); RW_TROW(4); RW_TROW(5); RW_TROW(6); RW_TROW(7); RW_TROW(8); RW_TROW(9); RW_TROW(10);
                        float* TS_ = (float*)BTs + lane;
#define RW_TSV(T) TS_[(T) * 64] = Tr[(T)]
                        RW_TSV(0); RW_TSV(1); RW_TSV(2); RW_TSV(3); RW_TSV(4); RW_TSV(5); RW_TSV(6); RW_TSV(7); RW_TSV(8); RW_TSV(9); RW_TSV(10);
#undef RW_TSV
                    } break;
                    default: {
                        { const int cn = (c + 7 < RNCH) ? c + 7 : c; const size_t tn = tokbase + (size_t)cn * RC; RW_LD(0, tn + 0); RW_LD(1, tn + 1); RW_LD(2, tn + 2); RW_LD(3, tn + 3); RW_LDPREV(cn); }
                        float Tr[16];
                        const float* TS_ = (const float*)BTs + lane;
#define RW_TLD(T) Tr[(T)] = TS_[(T) * 64]
                        RW_TLD(0); RW_TLD(1); RW_TLD(2); RW_TLD(3); RW_TLD(4); RW_TLD(5); RW_TLD(6); RW_TLD(7); RW_TLD(8); RW_TLD(9); RW_TLD(10);
#undef RW_TLD
                        RW_TROW(11); RW_TROW(12); RW_TROW(13); RW_TROW(14); RW_TROW(15);
                        if (fq < 2) {
                            bf16_t* TPw = (bf16_t*)(sl + RS_TP) + (fr >> 2) * 8 + (fr & 3) + fq * 4;
#define RW_TPW(T) TPw[(T) * 32] = (fq == 0) ? f2bf(Tr[(T)]) : (bf16_t)0
                            RW_TPW(0); RW_TPW(1); RW_TPW(2); RW_TPW(3); RW_TPW(4); RW_TPW(5); RW_TPW(6); RW_TPW(7); RW_TPW(8); RW_TPW(9); RW_TPW(10); RW_TPW(11); RW_TPW(12); RW_TPW(13); RW_TPW(14); RW_TPW(15);
#undef RW_TPW
                        }
                    } break;
#undef RW_TROW
#undef RW_TJ
#undef RW_GSEL
                    }
#undef RW_TS
                }
                __syncthreads();
            }
        }
#undef RW_LD
#undef RW_LDPREV
    }
}

__device__ __forceinline__ float half_sum32(float v);
__device__ __forceinline__ void rwkv_elem_phase(const Params& p) {
    bf16_t* P = (bf16_t*)(p.ws + OFF_P);
    float* Wd = (float*)(p.ws + OFF_X);
    unsigned short* Ai = (unsigned short*)(p.ws + OFF_Y);
    bf16_t* KT2 = (bf16_t*)p.out + (size_t)M_TOK * 1024;
    float* BON = (float*)(p.ws + OFF_LIN);
    const float* mu = p.in[4]; const float* k_k = p.in[9]; const float* k_a = p.in[10]; const float* r_k = p.in[11];
    const int tid = otid(), lane = tid & 63, wid = __builtin_amdgcn_readfirstlane(tid >> 6);
    const int gw = blockIdx.x * 8 + wid, ngw = gridDim.x * 8;
    for (int u = gw; u < 64 * RNCH; u += ngw) {
        const int bh = u >> 9, c = u & (RNCH - 1), b = bh >> 4, h = bh & 15, col = h * 64 + lane;
        const size_t tok0 = (size_t)b * SEQ_T + (size_t)c * RC;
        const float mur = mu[col], muk = mu[1024 + col], kkc = k_k[col], kac = k_a[col], rkc = r_k[col];
        unsigned short rr[16], rk[16], ra[16]; float rw[16];
        const bf16_t* pr = P + tok0 * RW_COLS + col;
        const bf16_t* pp = (c > 0) ? pr - RW_COLS : pr;
        const unsigned short p0r = pp[0], p0k = pp[1024];
#pragma unroll
        for (int j = 0; j < 16; ++j) { rr[j] = pr[(size_t)j * RW_COLS]; rk[j] = pr[(size_t)j * RW_COLS + 1024]; rw[j] = Wd[(tok0 + j) * 1024 + col]; ra[j] = Ai[(tok0 + j) * 1024 + col]; }
        asm volatile("s_waitcnt vmcnt(0)" ::: "memory");
        float W = 1.f, prv = (c > 0) ? bf2f(p0r) : 0.f, pkv = (c > 0) ? bf2f(p0k) : 0.f;
#pragma unroll
        for (int j = 0; j < 16; ++j) {
            const float r0 = bf2f(rr[j]), k0 = bf2f(rk[j]), w = rw[j], a = h2f(ra[j]);
            const float r1 = r0 + (prv - r0) * mur, k1 = k0 + (pkv - k0) * muk; prv = r0; pkv = k0;
            const float kkv = k1 * kkc; const float n2 = wave_sum64(kkv * kkv); const float kk = kkv * rsqrtf(fmaxf(n2, 1e-24f));
            const float k2 = k1 * (1.f + (a - 1.f) * kac);
            const float bon = wave_sum64(r1 * k2 * rkc);
            const float at = -kk * W; W *= w; const float rt = r1 * W; const float iw = __builtin_amdgcn_rcpf(W);
            const float bt = kk * a * iw, kt = k2 * iw;
            bf16_t* ar = (bf16_t*)(Wd + (tok0 + j) * 1024 + h * 64);
            ar[lane] = f2bf(at); ar[64 + lane] = f2bf(rt);
            Ai[(tok0 + j) * 1024 + col] = f2bf(bt);
            KT2[(tok0 + j) * 1024 + col] = f2bf(kt);
            if (lane == 0) BON[(tok0 + j) * 16 + h] = bon;
        }
        ((float*)(P + (tok0 + h) * RW_COLS + 3072))[lane] = W;
    }
}
#ifndef XLAS
#define XLAS __attribute__((address_space(3)))
#endif
struct RwStg2 { int gx, gy, gz, gw; };
__device__ __forceinline__ void rwkv_chunk2_phase(const Params& p, char* smem) {
    const bf16_t* P = (const bf16_t*)(p.ws + OFF_P);
    const char* WdB = (const char*)(p.ws + OFF_X);
    const bf16_t* BT2 = (const bf16_t*)(p.ws + OFF_Y);
    const bf16_t* KT2 = (const bf16_t*)p.out + (size_t)M_TOK * 1024;
    bf16_t* Yb = (bf16_t*)p.out;
    const float* mu = p.in[4];
    const int tid = otid(), lane = tid & 63, wid = __builtin_amdgcn_readfirstlane(tid >> 6), fr = lane & 15, fq = lane >> 4;
    for (int unit = blockIdx.x; unit < 256; unit += gridDim.x) {
        const int xcd_ = unit & 7, idx_ = unit >> 3;
        const int bh = xcd_ * 8 + (idx_ >> 2), rg = idx_ & 3, b = bh >> 4, h = bh & 15;
        const size_t tokbase = (size_t)b * SEQ_T;
        __syncthreads();
        f32x4 accS[4];
#pragma unroll
        for (int i = 0; i < 4; ++i) accS[i] = (f32x4){0.f, 0.f, 0.f, 0.f};
        RwStg2 st; st.gx = 0; st.gy = 0; st.gz = 0; st.gw = 0;
        const int sw = wid - 1;
        const int scr_off = RS_SCR + (sw < 0 ? 0 : sw) * 4096;
        bf16_t* BTs = (bf16_t*)(smem + scr_off);
        bf16_t* KTs = BTs + 1024;
        const float muv = mu[2048 + h * 64 + rg * 16 + fr];
        if (wid == 0) {
            for (int i = lane; i < 16 * 72 / 2; i += 64) *(unsigned*)(smem + RS_ST + i * 4) = 0u;
        }
        __syncthreads();
        if (wid == 0) {
            __builtin_amdgcn_s_setprio(2);
            bf16x8 pa0 = {}, pa1 = {}, pr0 = {}, pr1 = {}, pakp = {}, pbrp = {}; uint2 pvt = make_uint2(0u, 0u); bf16x8 pbk[4] = {}; f32x4 pwc[4] = {};
            for (int per = 0; per < RNCH + 7; ++per) {
                const int c = per - 7;
                if (c >= 0) {
                    const char* sl = smem + (c & 7) * RS_SLOT;
                    const bf16_t* STr = (const bf16_t*)(smem + RS_ST) + fr * 72 + fq * 8;
                    const bf16x8 st0 = *(const bf16x8*)(STr), st1 = *(const bf16x8*)(STr + 32);
                    const bf16x8 tpf = *(const bf16x8*)((const bf16_t*)(sl + RS_TP) + fr * 32 + fq * 8);
                    const bf16x8 a0 = pa0, a1 = pa1, r0 = pr0, r1 = pr1, akp = pakp, brp = pbrp; const uint2 vt = pvt;
                    f32x4 u = {0.f, 0.f, 0.f, 0.f};
                    u = __builtin_amdgcn_mfma_f32_16x16x32_bf16(a0, st0, u, 0, 0, 0);
                    u = __builtin_amdgcn_mfma_f32_16x16x32_bf16(a1, st1, u, 0, 0, 0);
                    u = __builtin_amdgcn_mfma_f32_16x16x32_bf16(akp, mk_frag(vt.x, vt.y, 0u, 0u), u, 0, 0, 0);
                    f32x4 sv = {0.f, 0.f, 0.f, 0.f};
                    sv = __builtin_amdgcn_mfma_f32_16x16x32_bf16(tpf, mk_frag(pack2bf(u.x, u.y), pack2bf(u.z, u.w), 0u, 0u), sv, 0, 0, 0);
                    const bf16x8 f3 = mk_frag(pack2bf(sv.x, sv.y), pack2bf(sv.z, sv.w), vt.x, vt.y);
                    f32x4 yv = {0.f, 0.f, 0.f, 0.f};
                    yv = __builtin_amdgcn_mfma_f32_16x16x32_bf16(st0, r0, yv, 0, 0, 0);
                    yv = __builtin_amdgcn_mfma_f32_16x16x32_bf16(st1, r1, yv, 0, 0, 0);
                    yv = __builtin_amdgcn_mfma_f32_16x16x32_bf16(f3, brp, yv, 0, 0, 0);
                    { uint2 py; py.x = pack2bf(yv.x, yv.y); py.y = pack2bf(yv.z, yv.w); *(uint2*)(Yb + (tokbase + (size_t)c * RC + fr) * 1024 + h * 64 + rg * 16 + fq * 4) = py; }
#pragma unroll
                    for (int kt = 0; kt < 4; ++kt) {
                        accS[kt] = accS[kt] * pwc[kt];
                        accS[kt] = __builtin_amdgcn_mfma_f32_16x16x32_bf16(pbk[kt], f3, accS[kt], 0, 0, 0);
                        uint2 pk; pk.x = pack2bf(accS[kt].x, accS[kt].y); pk.y = pack2bf(accS[kt].z, accS[kt].w);
                        *(uint2*)((bf16_t*)(smem + RS_ST) + fr * 72 + kt * 16 + fq * 4) = pk;
                    }
                }
                if (c + 1 >= 0 && c + 1 < RNCH) {
                    const char* sn = smem + ((c + 1) & 7) * RS_SLOT;
                    const bf16_t* ATr = (const bf16_t*)(sn + RS_AT) + fr * 128;
                    pa0 = *(const bf16x8*)(ATr + ((fq) ^ fr) * 8); pa1 = *(const bf16x8*)(ATr + ((4 + fq) ^ fr) * 8);
                    pr0 = *(const bf16x8*)(ATr + ((8 + fq) ^ fr) * 8); pr1 = *(const bf16x8*)(ATr + ((12 + fq) ^ fr) * 8);
                    pakp = *(const bf16x8*)((const bf16_t*)(sn + RS_AKP) + fr * 32 + fq * 8);
                    pbrp = *(const bf16x8*)((const bf16_t*)(sn + RS_BRP) + fr * 32 + fq * 8);
                    pvt = *(const uint2*)((const bf16_t*)(sn + RS_VT) + fr * 16 + fq * 4);
#pragma unroll
                    for (int kt = 0; kt < 4; ++kt) { pbk[kt] = *(const bf16x8*)((const bf16_t*)(sn + RS_BKT) + (kt * 16 + fr) * 32 + fq * 8); pwc[kt] = *(const f32x4*)((const float*)(sn + RS_WC) + kt * 16 + fq * 4); }
                }
                asm volatile("s_waitcnt lgkmcnt(0)" ::: "memory"); __builtin_amdgcn_s_barrier(); asm volatile("" ::: "memory");
            }
            __builtin_amdgcn_s_setprio(0);
        } else {
            for (int per = 0; per < RNCH + 7; ++per) {
                const int q = per - sw;
                const int c = (q >= 0) ? 7 * (q / 7) + sw : RNCH;
                if (c < RNCH) {
                    const int part = q % 7;
                    const int sl_off = (c & 7) * RS_SLOT;
                    char* sl = smem + sl_off;
                    bf16_t* ATw = (bf16_t*)(sl + RS_AT);
                    switch (part) {
                    case 0: {
                        const size_t t0 = tokbase + (size_t)c * RC;
#pragma unroll
                        for (int i = 0; i < 4; ++i)
                            __builtin_amdgcn_global_load_lds((const unsigned*)(WdB + ((t0 + i * 4 + fq) * 1024 + h * 64) * 4 + (fr ^ (i * 4 + fq)) * 16), (XLAS unsigned*)(smem + sl_off + RS_AT + i * 1024), 16, 0, 0);
#pragma unroll
                        for (int i = 0; i < 2; ++i) {
                            const size_t o = (t0 + i * 8 + (lane >> 3)) * 1024 + h * 64 + (lane & 7) * 8;
                            __builtin_amdgcn_global_load_lds((const unsigned*)(BT2 + o), (XLAS unsigned*)(smem + scr_off + i * 1024), 16, 0, 0);
                            __builtin_amdgcn_global_load_lds((const unsigned*)(KT2 + o), (XLAS unsigned*)(smem + scr_off + 2048 + i * 1024), 16, 0, 0);
                        }
                        __builtin_amdgcn_global_load_lds((const unsigned*)((const float*)(P + (t0 + h) * RW_COLS + 3072) + lane), (XLAS unsigned*)(smem + sl_off + RS_WC), 4, 0, 0);
#pragma unroll
                        for (int i = 0; i < 3; ++i) {
                            const int idx = i * 64 + lane; int row = idx >> 3; row = row > 16 ? 16 : row; const int dwq = idx & 7;
                            int tt = c * RC - 1 + row; tt = tt < 0 ? 0 : tt;
                            __builtin_amdgcn_global_load_lds((const unsigned*)(P + (tokbase + tt) * RW_COLS + 2048 + h * 64 + rg * 16 + dwq * 2), (XLAS unsigned*)(smem + sl_off + RS_TP + i * 256), 4, 0, 0);
                        }
                    } break;
                    case 1: break;
                    case 2: {
                        asm volatile("s_waitcnt vmcnt(0)" ::: "memory");
                    } break;
                    case 3: {
                        { const unsigned short* vr = (const unsigned short*)(sl + RS_TP) + (fq * 4) * 16 + fr;
                          const float pv = (c == 0 && fq == 0) ? 0.f : bf2f(vr[0]);
                          const float v0 = bf2f(vr[16]), v1 = bf2f(vr[32]), v2 = bf2f(vr[48]), v3 = bf2f(vr[64]);
                          uint2 o; o.x = pack2bf(v0 + (pv - v0) * muv, v1 + (v0 - v1) * muv); o.y = pack2bf(v2 + (v1 - v2) * muv, v3 + (v2 - v3) * muv);
                          *(uint2*)((bf16_t*)(sl + RS_VT) + fr * 16 + fq * 4) = o; }
                        const float WC = ((const float*)(sl + RS_WC))[lane];
                        bf16_t* BKw = (bf16_t*)(sl + RS_BKT) + lane * 32;
#define RW_BKG(G) do { uint4 o; \
                            o.x = pack2bf(bf2f(BTs[(4 * (G) + 0) * 64 + lane]) * WC, bf2f(BTs[(4 * (G) + 1) * 64 + lane]) * WC); o.y = pack2bf(bf2f(BTs[(4 * (G) + 2) * 64 + lane]) * WC, bf2f(BTs[(4 * (G) + 3) * 64 + lane]) * WC); \
                            o.z = pack2bf(bf2f(KTs[(4 * (G) + 0) * 64 + lane]) * WC, bf2f(KTs[(4 * (G) + 1) * 64 + lane]) * WC); o.w = pack2bf(bf2f(KTs[(4 * (G) + 2) * 64 + lane]) * WC, bf2f(KTs[(4 * (G) + 3) * 64 + lane]) * WC); \
                            *(uint4*)(BKw + (G) * 8) = o; } while (0)
                        RW_BKG(0); RW_BKG(1); RW_BKG(2); RW_BKG(3);
#undef RW_BKG
                    } break;
                    case 4: {
                        const bf16_t* ATr = ATw + fr * 128; const bf16_t* BTr = BTs + fr * 64 + fq * 8; const bf16_t* KTr = KTs + fr * 64 + fq * 8;
                        const bf16x8 a0 = *(const bf16x8*)(ATr + ((fq) ^ fr) * 8), a1 = *(const bf16x8*)(ATr + ((4 + fq) ^ fr) * 8), r0 = *(const bf16x8*)(ATr + ((8 + fq) ^ fr) * 8), r1 = *(const bf16x8*)(ATr + ((12 + fq) ^ fr) * 8);
                        const bf16x8 b0 = *(const bf16x8*)(BTr), b1 = *(const bf16x8*)(BTr + 32), k0 = *(const bf16x8*)(KTr), k1 = *(const bf16x8*)(KTr + 32);
                        f32x4 gab = {0.f, 0.f, 0.f, 0.f}, gak = gab, grb = gab, grk = gab;
                        gab = __builtin_amdgcn_mfma_f32_16x16x32_bf16(b0, a0, gab, 0, 0, 0); gab = __builtin_amdgcn_mfma_f32_16x16x32_bf16(b1, a1, gab, 0, 0, 0);
                        gak = __builtin_amdgcn_mfma_f32_16x16x32_bf16(k0, a0, gak, 0, 0, 0); gak = __builtin_amdgcn_mfma_f32_16x16x32_bf16(k1, a1, gak, 0, 0, 0);
                        grb = __builtin_amdgcn_mfma_f32_16x16x32_bf16(b0, r0, grb, 0, 0, 0); grb = __builtin_amdgcn_mfma_f32_16x16x32_bf16(b1, r1, grb, 0, 0, 0);
                        grk = __builtin_amdgcn_mfma_f32_16x16x32_bf16(k0, r0, grk, 0, 0, 0); grk = __builtin_amdgcn_mfma_f32_16x16x32_bf16(k1, r1, grk, 0, 0, 0);
                        const int j0 = fq * 4;
                        gab.x = (j0 + 0 < fr) ? gab.x : 0.f; gab.y = (j0 + 1 < fr) ? gab.y : 0.f; gab.z = (j0 + 2 < fr) ? gab.z : 0.f; gab.w = (j0 + 3 < fr) ? gab.w : 0.f;
                        gak.x = (j0 + 0 < fr) ? gak.x : 0.f; gak.y = (j0 + 1 < fr) ? gak.y : 0.f; gak.z = (j0 + 2 < fr) ? gak.z : 0.f; gak.w = (j0 + 3 < fr) ? gak.w : 0.f;
                        grb.x = (j0 + 0 <= fr) ? grb.x : 0.f; grb.y = (j0 + 1 <= fr) ? grb.y : 0.f; grb.z = (j0 + 2 <= fr) ? grb.z : 0.f; grb.w = (j0 + 3 <= fr) ? grb.w : 0.f;
                        grk.x = (j0 + 0 <= fr) ? grk.x : 0.f; grk.y = (j0 + 1 <= fr) ? grk.y : 0.f; grk.z = (j0 + 2 <= fr) ? grk.z : 0.f; grk.w = (j0 + 3 <= fr) ? grk.w : 0.f;
                        *(uint4*)((bf16_t*)(sl + RS_AKP) + fr * 32 + fq * 8) = make_uint4(pack2bf(gak.x, gak.y), pack2bf(gak.z, gak.w), 0u, 0u);
                        *(uint4*)((bf16_t*)(sl + RS_BRP) + fr * 32 + fq * 8) = make_uint4(pack2bf(grb.x, grb.y), pack2bf(grb.z, grb.w), pack2bf(grk.x, grk.y), pack2bf(grk.z, grk.w));
                        st.gx = __float_as_int(gab.x); st.gy = __float_as_int(gab.y); st.gz = __float_as_int(gab.z); st.gw = __float_as_int(gab.w);
                    } break;
#define RW_GSEL(J) ((((J) & 3) == 0) ? st.gx : ((((J) & 3) == 1) ? st.gy : ((((J) & 3) == 2) ? st.gz : st.gw)))
#define RW_TJ(T, J) do { if ((J) < (T)) { const float n_ = rw_nfetch<(T) + 16 * ((J) >> 2)>(RW_GSEL(J), rowdep); if ((J) & 1) acc1 = fmaf(n_, Tr[(J)], acc1); else acc0 = fmaf(n_, Tr[(J)], acc0); } } while (0)
#define RW_TROW(T) do { float acc0 = ((T) == fr) ? 1.f : 0.f, acc1 = 0.f; RW_TJ(T, 0); RW_TJ(T, 1); RW_TJ(T, 2); RW_TJ(T, 3); RW_TJ(T, 4); RW_TJ(T, 5); RW_TJ(T, 6); RW_TJ(T, 7); \
                        RW_TJ(T, 8); RW_TJ(T, 9); RW_TJ(T, 10); RW_TJ(T, 11); RW_TJ(T, 12); RW_TJ(T, 13); RW_TJ(T, 14); RW_TJ(T, 15); Tr[(T)] = acc0 + acc1; rowdep = Tr[(T)]; } while (0)
                    case 5: {
                        float Tr[16]; float rowdep = 0.f;
                        RW_TROW(0); RW_TROW(1); RW_TROW(2); RW_TROW(3); RW_TROW(4); RW_TROW(5); RW_TROW(6); RW_TROW(7); RW_TROW(8); RW_TROW(9); RW_TROW(10);
                        float* TS_ = (float*)BTs + lane;
#define RW_TSV(T) TS_[(T) * 64] = Tr[(T)]
                        RW_TSV(0); RW_TSV(1); RW_TSV(2); RW_TSV(3); RW_TSV(4); RW_TSV(5); RW_TSV(6); RW_TSV(7); RW_TSV(8); RW_TSV(9); RW_TSV(10);
#undef RW_TSV
                    } break;
                    default: {
                        float Tr[16]; float rowdep = 0.f;
                        const float* TS_ = (const float*)BTs + lane;
#define RW_TLD(T) Tr[(T)] = TS_[(T) * 64]
                        RW_TLD(0); RW_TLD(1); RW_TLD(2); RW_TLD(3); RW_TLD(4); RW_TLD(5); RW_TLD(6); RW_TLD(7); RW_TLD(8); RW_TLD(9); RW_TLD(10);
#undef RW_TLD
                        RW_TROW(11); RW_TROW(12); RW_TROW(13); RW_TROW(14); RW_TROW(15);
                        if (fq < 2) {
                            bf16_t* TPw = (bf16_t*)(sl + RS_TP) + (fr >> 2) * 8 + (fr & 3) + fq * 4;
#define RW_TPW(T) TPw[(T) * 32] = (fq == 0) ? f2bf(Tr[(T)]) : (bf16_t)0
                            RW_TPW(0); RW_TPW(1); RW_TPW(2); RW_TPW(3); RW_TPW(4); RW_TPW(5); RW_TPW(6); RW_TPW(7); RW_TPW(8); RW_TPW(9); RW_TPW(10); RW_TPW(11); RW_TPW(12); RW_TPW(13); RW_TPW(14); RW_TPW(15);
#undef RW_TPW
                        }
                    } break;
#undef RW_TROW
#undef RW_TJ
#undef RW_GSEL
                    }
                }
                asm volatile("s_waitcnt lgkmcnt(0)" ::: "memory"); __builtin_amdgcn_s_barrier(); asm volatile("" ::: "memory");
            }
        }
    }
}
__device__ __forceinline__ void rwkv_post2_phase(const Params& p) {
    const bf16_t* P = (const bf16_t*)(p.ws + OFF_P);
    const bf16_t* Yb = (const bf16_t*)p.out;
    const float* BON = (const float*)(p.ws + OFF_LIN);
    bf16_t* Z = (bf16_t*)(p.ws + OFF_X);
    const float* mu = p.in[4];
    const int ch = otid() * 2;
    const float mv0 = mu[2048 + ch], mv1 = mu[2049 + ch], mg0 = mu[3200 + ch], mg1 = mu[3201 + ch];
    const float gg0 = p.in[12][ch], gg1 = p.in[12][ch + 1], gb0 = p.in[13][ch], gb1 = p.in[13][ch + 1];
    for (int tok = blockIdx.x; tok < M_TOK; tok += gridDim.x) {
        const bf16_t* pr = P + (size_t)tok * RW_COLS + ch;
        const unsigned uv = *(const unsigned*)(pr + 2048), ug = *(const unsigned*)(pr + 3200);
        unsigned pv_ = 0u, pg_ = 0u;
        if ((tok & (SEQ_T - 1)) != 0) { const bf16_t* pp = pr - RW_COLS; pv_ = *(const unsigned*)(pp + 2048); pg_ = *(const unsigned*)(pp + 3200); }
        const unsigned yu = *(const unsigned*)(Yb + (size_t)tok * 1024 + ch);
        const float y0 = bflo(yu), y1 = bfhi(yu);
        const float sb = BON[(size_t)tok * 16 + (ch >> 6)];
        const float v0 = bflo(uv) + (bflo(pv_) - bflo(uv)) * mv0, v1 = bfhi(uv) + (bfhi(pv_) - bfhi(uv)) * mv1;
        const float g0 = bflo(ug) + (bflo(pg_) - bflo(ug)) * mg0, g1 = bfhi(ug) + (bfhi(pg_) - bfhi(ug)) * mg1;
        const float mean = half_sum32(y0 + y1) * (1.f / 64.f);
        const float d0 = y0 - mean, d1 = y1 - mean;
        const float var = half_sum32(d0 * d0 + d1 * d1) * (1.f / 64.f);
        const float rstd = rsqrtf(var + 64e-5f);
        const float o0 = (d0 * rstd * gg0 + gb0 + sb * v0) * siluf_(g0);
        const float o1 = (d1 * rstd * gg1 + gb1 + sb * v1) * siluf_(g1);
        *(unsigned*)(Z + (size_t)tok * 1024 + ch) = pack2bf(o0, o1);
    }
}

__device__ __forceinline__ float half_sum32(float v) {
#pragma unroll
    for (int o = 1; o < 32; o <<= 1) v += __shfl_xor(v, o);
    return v;
}
__device__ __forceinline__ void rwkv_post_phase(const Params& p) {
    const bf16_t* P = (const bf16_t*)(p.ws + OFF_P);
    const unsigned short* Ai = (const unsigned short*)(p.ws + OFF_Y);
    const float* Y = p.out;
    bf16_t* Z = (bf16_t*)(p.ws + OFF_X);
    const float* mu = p.in[4];
    const int ch = otid() * 2;
    const float mr0 = mu[ch], mr1 = mu[ch + 1], mk0 = mu[1024 + ch], mk1 = mu[1025 + ch], mv0 = mu[2048 + ch], mv1 = mu[2049 + ch], mg0 = mu[3200 + ch], mg1 = mu[3201 + ch];
    const float ka0 = p.in[10][ch], ka1 = p.in[10][ch + 1], rk0 = p.in[11][ch], rk1 = p.in[11][ch + 1];
    const float gg0 = p.in[12][ch], gg1 = p.in[12][ch + 1], gb0 = p.in[13][ch], gb1 = p.in[13][ch + 1];
    for (int tok = blockIdx.x; tok < M_TOK; tok += gridDim.x) {
        const bf16_t* pr = P + (size_t)tok * RW_COLS + ch;
        const unsigned ur = *(const unsigned*)(pr), uk = *(const unsigned*)(pr + 1024), uv = *(const unsigned*)(pr + 2048), ug = *(const unsigned*)(pr + 3200);
        unsigned pr_ = 0u, pk_ = 0u, pv_ = 0u, pg_ = 0u;
        if ((tok & (SEQ_T - 1)) != 0) { const bf16_t* pp = pr - RW_COLS; pr_ = *(const unsigned*)(pp); pk_ = *(const unsigned*)(pp + 1024); pv_ = *(const unsigned*)(pp + 2048); pg_ = *(const unsigned*)(pp + 3200); }
        const unsigned ua = *(const unsigned*)(Ai + (size_t)tok * 1024 + ch);
        const float a0 = h2f((unsigned short)(ua & 0xFFFFu)), a1 = h2f((unsigned short)(ua >> 16));
        const float2 y2 = *(const float2*)(Y + (size_t)tok * 1024 + ch);
        const float r0 = bflo(ur) + (bflo(pr_) - bflo(ur)) * mr0, r1 = bfhi(ur) + (bfhi(pr_) - bfhi(ur)) * mr1;
        float k0 = bflo(uk) + (bflo(pk_) - bflo(uk)) * mk0, k1 = bfhi(uk) + (bfhi(pk_) - bfhi(uk)) * mk1;
        const float v0 = bflo(uv) + (bflo(pv_) - bflo(uv)) * mv0, v1 = bfhi(uv) + (bfhi(pv_) - bfhi(uv)) * mv1;
        const float g0 = bflo(ug) + (bflo(pg_) - bflo(ug)) * mg0, g1 = bfhi(ug) + (bfhi(pg_) - bfhi(ug)) * mg1;
        k0 = k0 * (1.f + (a0 - 1.f) * ka0); k1 = k1 * (1.f + (a1 - 1.f) * ka1);
        const float mean = half_sum32(y2.x + y2.y) * (1.f / 64.f);
        const float d0 = y2.x - mean, d1 = y2.y - mean;
        const float var = half_sum32(d0 * d0 + d1 * d1) * (1.f / 64.f);
        const float rstd = rsqrtf(var + 64e-5f);
        const float sb = half_sum32(r0 * k0 * rk0 + r1 * k1 * rk1);
        const float o0 = (d0 * rstd * gg0 + gb0 + sb * v0) * siluf_(g0);
        const float o1 = (d1 * rstd * gg1 + gb1 + sb * v1) * siluf_(g1);
        *(unsigned*)(Z + (size_t)tok * 1024 + ch) = pack2bf(o0, o1);
    }
}

constexpr int HG_TC = 32, HG_STRIDE = 272;
struct HgRaw { uint4 q, k, v; };
__device__ __forceinline__ HgRaw hg_load_raw(const bf16_t* P, size_t tok, int h, int vg, int q) {
    HgRaw r;
    const bf16_t* pr = P + tok * 4096 + h * 128 + 8 * q;
    r.q = *(const uint4*)(pr); r.k = *(const uint4*)(pr + 1024);
    r.v = *(const uint4*)(P + tok * 4096 + 2048 + h * 128 + vg * 16 + 8 * (q & 1));
    return r;
}
__device__ __forceinline__ void hg_process(const HgRaw& x, float* d, int q) {
    *(f32x4*)(d + 8 * q) = (f32x4){bflo(x.q.x), bfhi(x.q.x), bflo(x.q.y), bfhi(x.q.y)};
    *(f32x4*)(d + 8 * q + 4) = (f32x4){bflo(x.q.z), bfhi(x.q.z), bflo(x.q.w), bfhi(x.q.w)};
    *(f32x4*)(d + 128 + 8 * q) = (f32x4){h2f((unsigned short)(x.k.x & 0xFFFFu)), h2f((unsigned short)(x.k.x >> 16)), h2f((unsigned short)(x.k.y & 0xFFFFu)), h2f((unsigned short)(x.k.y >> 16))};
    *(f32x4*)(d + 128 + 8 * q + 4) = (f32x4){h2f((unsigned short)(x.k.z & 0xFFFFu)), h2f((unsigned short)(x.k.z >> 16)), h2f((unsigned short)(x.k.w & 0xFFFFu)), h2f((unsigned short)(x.k.w >> 16))};
    if (q < 2) {
        *(f32x4*)(d + 256 + 8 * q) = (f32x4){bflo(x.v.x), bfhi(x.v.x), bflo(x.v.y), bfhi(x.v.y)};
        *(f32x4*)(d + 256 + 8 * q + 4) = (f32x4){bflo(x.v.z), bfhi(x.v.z), bflo(x.v.w), bfhi(x.v.w)};
    }
}
__device__ __forceinline__ void hgrn_scan_phase(const Params& p, char* smem) {
    float* buf = (float*)smem;
    const bf16_t* P = (const bf16_t*)(p.ws + OFF_P);
    float* O = (float*)(p.ws + OFF_X);
    const int tid = otid(), lane = tid & 63, wid = __builtin_amdgcn_readfirstlane(tid >> 6);
    constexpr int NCH = SEQ_T / HG_TC;
    const int sub = lane >> 4, q = lane & 15;
    for (int unit = blockIdx.x; unit < 256; unit += gridDim.x) {
        const int bh = unit >> 3, vg = unit & 7, b = bh >> 3, h = bh & 7;
        const size_t tokbase = (size_t)b * SEQ_T;
        __syncthreads();
        if (wid >= 4) {
            const int lw = wid - 4, tl0 = lw * 4 + sub, tl1 = 16 + lw * 4 + sub;
            HgRaw x0 = hg_load_raw(P, tokbase + tl0, h, vg, q), x1 = hg_load_raw(P, tokbase + tl1, h, vg, q);
            for (int c = -1; c < NCH; ++c) {
                if (c + 1 < NCH) {
                    const int cn = c + 1; float* db = buf + (cn & 1) * (HG_TC * HG_STRIDE);
                    hg_process(x0, db + tl0 * HG_STRIDE, q);
                    hg_process(x1, db + tl1 * HG_STRIDE, q);
                    if (cn + 1 < NCH) { x0 = hg_load_raw(P, tokbase + (cn + 1) * HG_TC + tl0, h, vg, q); x1 = hg_load_raw(P, tokbase + (cn + 1) * HG_TC + tl1, h, vg, q); }
                }
                __syncthreads();
            }
        } else {
            f32x2 S[4];
#pragma unroll
            for (int e = 0; e < 4; ++e) S[e] = (f32x2){0.f, 0.f};
            const int rowl = wid * 4 + sub;
            float* obase = O + tokbase * 1024 + h * 128 + vg * 16 + rowl;
            __syncthreads();
            for (int c = 0; c < NCH; ++c) {
                const float* cb = buf + (c & 1) * (HG_TC * HG_STRIDE) + q * 8;
                const float* vb = buf + (c & 1) * (HG_TC * HG_STRIDE) + 256 + rowl;
                f32x4 q0 = *(const f32x4*)(cb), q1 = *(const f32x4*)(cb + 4), k0 = *(const f32x4*)(cb + 128), k1 = *(const f32x4*)(cb + 132);
                float vv = vb[0];
                float okeep = 0.f;
#pragma unroll
                for (int tl = 0; tl < HG_TC; ++tl) {
                    f32x4 nq0 = q0, nq1 = q1, nk0 = k0, nk1 = k1; float nv = vv;
                    if (tl + 1 < HG_TC) {
                        const float* s = cb + (tl + 1) * HG_STRIDE;
                        nq0 = *(const f32x4*)(s); nq1 = *(const f32x4*)(s + 4); nk0 = *(const f32x4*)(s + 128); nk1 = *(const f32x4*)(s + 132);
                        nv = vb[(tl + 1) * HG_STRIDE];
                    }
                    __builtin_amdgcn_sched_barrier(0);
                    const f32x2 v2 = {vv, vv};
                    S[0] = __builtin_elementwise_fma((f32x2){k0.x, k0.y}, v2 - S[0], S[0]);
                    S[1] = __builtin_elementwise_fma((f32x2){k0.z, k0.w}, v2 - S[1], S[1]);
                    S[2] = __builtin_elementwise_fma((f32x2){k1.x, k1.y}, v2 - S[2], S[2]);
                    S[3] = __builtin_elementwise_fma((f32x2){k1.z, k1.w}, v2 - S[3], S[3]);
                    f32x2 po = S[0] * (f32x2){q0.x, q0.y};
                    f32x2 pp = S[1] * (f32x2){q0.z, q0.w};
                    po = __builtin_elementwise_fma(S[2], (f32x2){q1.x, q1.y}, po);
                    pp = __builtin_elementwise_fma(S[3], (f32x2){q1.z, q1.w}, pp);
                    po = po + pp;
                    const float o = sum16(po.x + po.y);
                    okeep = (q == (tl & 15)) ? o : okeep;
                    if ((tl & 15) == 15) obase[(size_t)(c * HG_TC + (tl - 15) + q) * 1024] = okeep;
                    __builtin_amdgcn_sched_barrier(0);
                    q0 = nq0; q1 = nq1; k0 = nk0; k1 = nk1; vv = nv;
                }
                __syncthreads();
            }
        }
    }
}
constexpr int HCK = 32;
constexpr size_t OFF_ATTG = OFF_X, OFF_DLG = OFF_X + 16 * MiB;
struct HcRaw { unsigned short q[8], k[8]; };
__device__ __forceinline__ void hc_load(HcRaw& r, const bf16_t* P, size_t tok0, int h, int tid) {
    const int k = tid & 127, tg = tid >> 7;
    const bf16_t* pr = P + (tok0 + tg * 8) * 4096 + h * 128 + k;
#pragma unroll
    for (int j = 0; j < 8; ++j) { r.q[j] = pr[(size_t)j * 4096]; r.k[j] = pr[(size_t)j * 4096 + 1024]; }
}
__device__ __forceinline__ void hgrn_prep_phase(const Params& p, char* smem) {
    bf16_t* P = (bf16_t*)(p.ws + OFF_P);
    bf16_t* ATTg = (bf16_t*)(p.ws + OFF_ATTG);
    float* DLg = (float*)(p.ws + OFF_DLG);
    const int tid = otid(), lane = tid & 63, wid = __builtin_amdgcn_readfirstlane(tid >> 6), fr = lane & 15, fq = lane >> 4;
    const int kch = tid & 127, tg = tid >> 7;
    float* TOT = (float*)(smem);
    bf16_t* QM = (bf16_t*)(smem + 4096);
    bf16_t* KM = (bf16_t*)(smem + 4096 + 8704);
    const int G = gridDim.x;
    __syncthreads();
    HcRaw rawA, rawB;
    {   const int u0 = blockIdx.x, u1 = blockIdx.x + G;
        const int u1c = (u1 < 8192) ? u1 : u0;
        hc_load(rawA, P, (size_t)(u0 >> 11) * SEQ_T + (size_t)(u0 & 255) * HCK, (u0 >> 8) & 7, tid);
        hc_load(rawB, P, (size_t)(u1c >> 11) * SEQ_T + (size_t)(u1c & 255) * HCK, (u1c >> 8) & 7, tid); }
#define HP_BODY(RAW, U) do { \
        const int u_ = (U); const int h_ = (u_ >> 8) & 7; const size_t tok0 = (size_t)(u_ >> 11) * SEQ_T + (size_t)(u_ & 255) * HCK; \
        float kf[8], l[8], qf[8]; \
        { float run = 0.f; _Pragma("unroll") for (int j = 0; j < 8; ++j) { kf[j] = h2f(RAW.k[j]); qf[j] = bf2f(RAW.q[j]); run += __logf(1.0f - kf[j]); l[j] = run; } } \
        { const int un = (u_ + 2 * G < 8192) ? u_ + 2 * G : u_; hc_load(RAW, P, (size_t)(un >> 11) * SEQ_T + (size_t)(un & 255) * HCK, (un >> 8) & 7, tid); } \
        TOT[tg * 128 + kch] = l[7]; if (tg == 2) TOT[4 * 128 + kch] = l[0]; \
        __syncthreads(); \
        { const float t0 = TOT[kch], t1 = TOT[128 + kch], t2 = TOT[256 + kch], t3 = TOT[384 + kch], g16 = TOT[512 + kch]; \
          const float off = (tg > 0 ? t0 : 0.f) + (tg > 1 ? t1 : 0.f) + (tg > 2 ? t2 : 0.f); \
          const float m = t0 + t1 + g16, blast = (t0 + t1) + (t2 + t3); \
          const float em = __expf(m), elm = __expf(blast - m); \
          bf16_t* pq = P + (tok0 + tg * 8) * 4096 + h_ * 128 + kch; float ko8[8]; \
          _Pragma("unroll") for (int j = 0; j < 8; ++j) { const int t = tg * 8 + j; const float bb = off + l[j]; \
              const float e1 = __expf(bb - m), e2 = __builtin_amdgcn_rcpf(e1); const float qm = qf[j] * e1, km = kf[j] * e2; \
              QM[t * 136 + kch] = f2bf(qm); KM[t * 136 + kch] = f2bf(km); pq[(size_t)j * 4096] = f2bf(qm * em); ko8[j] = km * elm; } \
          { uint4 kt; kt.x = pack2bf(ko8[0], ko8[1]); kt.y = pack2bf(ko8[2], ko8[3]); kt.z = pack2bf(ko8[4], ko8[5]); kt.w = pack2bf(ko8[6], ko8[7]); \
            const int idx = kch * 64 + tg * 16;   \
            *(uint4*)(P + (tok0 + (idx >> 8)) * 4096 + 1024 + h_ * 128 + ((idx & 255) >> 1)) = kt; } \
          if (tg == 0) DLg[(size_t)u_ * 128 + kch] = __expf(blast); } \
        __syncthreads(); \
        if (wid < 4) { \
            const int mi = wid >> 1, ni = wid & 1; f32x4 at = {0.f, 0.f, 0.f, 0.f}; \
            if (ni <= mi) { const bf16_t* KMr = KM + (ni * 16 + fr) * 136 + fq * 8; const bf16_t* QMr = QM + (mi * 16 + fr) * 136 + fq * 8; \
                _Pragma("unroll") for (int ks = 0; ks < 4; ++ks) at = __builtin_amdgcn_mfma_f32_16x16x32_bf16(*(const bf16x8*)(KMr + ks * 32), *(const bf16x8*)(QMr + ks * 32), at, 0, 0, 0); } \
            const int t = mi * 16 + fr, s0 = ni * 16 + fq * 4; \
            at.x = (s0 + 0 <= t) ? at.x : 0.f; at.y = (s0 + 1 <= t) ? at.y : 0.f; at.z = (s0 + 2 <= t) ? at.z : 0.f; at.w = (s0 + 3 <= t) ? at.w : 0.f; \
            uint2 pk; pk.x = pack2bf(at.x, at.y); pk.y = pack2bf(at.z, at.w); \
            *(uint2*)(ATTg + (size_t)u_ * 1024 + t * 32 + s0) = pk; \
        } \
    } while (0)
    for (int u = blockIdx.x; u < 8192; u += 2 * G) { HP_BODY(rawA, u); if (u + G < 8192) HP_BODY(rawB, u + G); }
#undef HP_BODY
}
constexpr int H2_QI = 0, H2_KOT = 8704, H2_VT = 18944, H2_ATT = 20224, H2_DL = 22784, H2_PAR = 23296, H2_ST = 2 * H2_PAR, H2_STSZ = 4352;
struct H2Raw { uint4 qi, ko, v, att; f32x4 dl; };
__device__ __forceinline__ void h2_load(H2Raw& r, const bf16_t* P, const bf16_t* ATTg, const float* DLg, size_t tok0, int u, int h, int vg, int tid) {
    const int row = tid >> 4, seg = tid & 15;
    const bf16_t* pr = P + (tok0 + row) * 4096 + h * 128 + seg * 8;
    r.qi = *(const uint4*)(pr); r.ko = *(const uint4*)(pr + 1024);
    r.v = *(const uint4*)(P + (tok0 + ((tid & 63) >> 1)) * 4096 + 2048 + h * 128 + vg * 16 + (tid & 1) * 8);
    r.att = *(const uint4*)(ATTg + (size_t)u * 1024 + (tid & 127) * 8);
    r.dl = *(const f32x4*)(DLg + (size_t)u * 128 + (tid & 31) * 4);
}
__device__ __forceinline__ void hgrn_chunk_phase(const Params& p, char* smem) {
    bf16_t* P = (bf16_t*)(p.ws + OFF_P);
    const bf16_t* ATTg = (const bf16_t*)(p.ws + OFF_ATTG);
    const float* DLg = (const float*)(p.ws + OFF_DLG);
    const int tid = otid(), lane = tid & 63, wid = __builtin_amdgcn_readfirstlane(tid >> 6), fr = lane & 15, fq = lane >> 4;
    constexpr int NCH = SEQ_T / HCK;
    for (int unit = blockIdx.x; unit < 256; unit += gridDim.x) {
        const int xcd_ = unit & 7, idx_ = unit >> 3;
        const int bh = xcd_ * 4 + (idx_ >> 3), vg = idx_ & 7, b = bh >> 3, h = bh & 7;
        const size_t tokbase = (size_t)b * SEQ_T;
        __syncthreads();
        for (int i = tid; i < H2_STSZ / 4; i += NTHREADS) *(unsigned*)(smem + H2_ST + i * 4) = 0u;
        f32x4 accS = {0.f, 0.f, 0.f, 0.f};
        H2Raw rawA, rawB;
        h2_load(rawA, P, ATTg, DLg, tokbase, bh * 256, h, vg, tid);
        h2_load(rawB, P, ATTg, DLg, tokbase + HCK, bh * 256 + 1, h, vg, tid);
#define H2_BODY(RAW, C) do { \
        const int c_ = (C); char* pb = smem + (c_ & 1) * H2_PAR; \
        { const int row = tid >> 4, seg = tid & 15; \
          *(uint4*)((bf16_t*)(pb + H2_QI) + row * 136 + seg * 8) = RAW.qi; \
            \
          { uint4 kov; kov.x = RAW.ko.x; kov.y = RAW.ko.y; kov.z = RAW.ko.z; kov.w = RAW.ko.w; *(uint4*)((bf16_t*)(pb + H2_KOT) + (tid >> 2) * 40 + (tid & 3) * 8) = kov; } \
          if (tid < 64) { bf16_t* VT = (bf16_t*)(pb + H2_VT) + ((tid & 1) * 8) * 40 + (tid >> 1); \
              VT[0] = (bf16_t)(RAW.v.x & 0xFFFFu); VT[40] = (bf16_t)(RAW.v.x >> 16); VT[80] = (bf16_t)(RAW.v.y & 0xFFFFu); VT[120] = (bf16_t)(RAW.v.y >> 16); \
              VT[160] = (bf16_t)(RAW.v.z & 0xFFFFu); VT[200] = (bf16_t)(RAW.v.z >> 16); VT[240] = (bf16_t)(RAW.v.w & 0xFFFFu); VT[280] = (bf16_t)(RAW.v.w >> 16); } \
          if (tid < 128) *(uint4*)((bf16_t*)(pb + H2_ATT) + (tid >> 2) * 40 + (tid & 3) * 8) = RAW.att; \
          if (tid < 32) *(f32x4*)((float*)(pb + H2_DL) + tid * 4) = RAW.dl; } \
        { const int cn_ = (c_ + 2 < NCH) ? c_ + 2 : NCH - 1; h2_load(RAW, P, ATTg, DLg, tokbase + (size_t)cn_ * HCK, bh * 256 + cn_, h, vg, tid); } \
        __syncthreads(); \
        if (wid >= 4 && wid < 6) { \
            const int mi = wid - 4; f32x4 acco = {0.f, 0.f, 0.f, 0.f}; \
            const bf16_t* STr = (const bf16_t*)(smem + H2_ST + (c_ & 1) * H2_STSZ) + fr * 136 + fq * 8; const bf16_t* QIr = (const bf16_t*)(pb + H2_QI) + (mi * 16 + fr) * 136 + fq * 8; \
            _Pragma("unroll") for (int ks = 0; ks < 4; ++ks) acco = __builtin_amdgcn_mfma_f32_16x16x32_bf16(*(const bf16x8*)(STr + ks * 32), *(const bf16x8*)(QIr + ks * 32), acco, 0, 0, 0); \
            const bf16x8 va = *(const bf16x8*)((const bf16_t*)(pb + H2_VT) + fr * 40 + fq * 8); \
            const bf16x8 ab = *(const bf16x8*)((const bf16_t*)(pb + H2_ATT) + (mi * 16 + fr) * 40 + fq * 8); \
            acco = __builtin_amdgcn_mfma_f32_16x16x32_bf16(va, ab, acco, 0, 0, 0); \
            uint2 po; po.x = pack2bf(acco.x, acco.y); po.y = pack2bf(acco.z, acco.w); \
            *(uint2*)(P + (tokbase + (size_t)c_ * HCK + mi * 16 + fr) * 4096 + 2048 + h * 128 + vg * 16 + fq * 4) = po; \
        } \
        { const f32x4 dl = *(const f32x4*)((const float*)(pb + H2_DL) + wid * 16 + fq * 4); accS = accS * dl; \
          const bf16x8 ka = *(const bf16x8*)((const bf16_t*)(pb + H2_KOT) + (wid * 16 + fr) * 40 + fq * 8); \
          const bf16x8 vb = *(const bf16x8*)((const bf16_t*)(pb + H2_VT) + fr * 40 + fq * 8); \
          accS = __builtin_amdgcn_mfma_f32_16x16x32_bf16(ka, vb, accS, 0, 0, 0); \
          uint2 pk; pk.x = pack2bf(accS.x, accS.y); pk.y = pack2bf(accS.z, accS.w); \
          *(uint2*)((bf16_t*)(smem + H2_ST + ((c_ + 1) & 1) * H2_STSZ) + fr * 136 + wid * 16 + fq * 4) = pk; } \
    } while (0)
        for (int c = 0; c < NCH; c += 2) { H2_BODY(rawA, c); H2_BODY(rawB, c + 1); }
#undef H2_BODY
    }
}

__device__ __forceinline__ void hgrn_post_phase(const Params& p) {
    const bf16_t* P = (const bf16_t*)(p.ws + OFF_P);
    bf16_t* Z = (bf16_t*)(p.ws + OFF_Y);
    const int ch = otid() * 2;
    const float g0 = p.in[17][ch], g1 = p.in[17][ch + 1];
    for (int tok = blockIdx.x; tok < M_TOK; tok += gridDim.x) {
        const unsigned ou = *(const unsigned*)(P + (size_t)tok * 4096 + 2048 + ch);
        const float2 o2 = make_float2(bflo(ou), bfhi(ou));
        const unsigned sg = *(const unsigned*)(P + (size_t)tok * 4096 + 3072 + ch);
        const float ss = wave_sum(o2.x * o2.x + o2.y * o2.y);
        const float rs = rsqrtf(ss * (1.f / 128.f) + 1e-6f);
        *(unsigned*)(Z + (size_t)tok * 1024 + ch) = pack2bf(o2.x * rs * g0 * bflo(sg), o2.y * rs * g1 * bfhi(sg));
    }
}

__device__ __forceinline__ void conv_post_phase(const Params& p) {
    const bf16_t* Yc = (const bf16_t*)(p.ws + OFF_P);
    const bf16_t* U = Yc + (size_t)M_TOK * 1024;
    bf16_t* Z = (bf16_t*)(p.ws + OFF_X);
    const float* cw = p.in[20];
    const int ch = otid() * 2;
    const float w00 = cw[ch], w01 = cw[ch + 1], w10 = cw[1024 + ch], w11 = cw[1025 + ch], w20 = cw[2048 + ch], w21 = cw[2049 + ch];
    for (int tok = blockIdx.x; tok < M_TOK; tok += gridDim.x) {
        const int t = tok & (SEQ_T - 1);
        const unsigned y0 = *(const unsigned*)(Yc + (size_t)tok * 1024 + ch);
        unsigned y1 = 0u, y2 = 0u;
        if (t >= 1) y1 = *(const unsigned*)(Yc + (size_t)(tok - 1) * 1024 + ch);
        if (t >= 2) y2 = *(const unsigned*)(Yc + (size_t)(tok - 2) * 1024 + ch);
        const unsigned u = *(const unsigned*)(U + (size_t)tok * 1024 + ch);
        const float c0 = w00 * bflo(y2) + w10 * bflo(y1) + w20 * bflo(y0);
        const float c1 = w01 * bfhi(y2) + w11 * bfhi(y1) + w21 * bfhi(y0);
        *(unsigned*)(Z + (size_t)tok * 1024 + ch) = pack2bf(bflo(u) * c0, bfhi(u) * c1);
    }
}

constexpr int SG_LS = 136;
__device__ __forceinline__ void gmlp_spatial_phase(const Params& p, char* smem) {
    float* rsA = (float*)smem;
    bf16_t* Aw = (bf16_t*)(smem + 1024);
    bf16_t* VT = Aw + 128 * SG_LS;
    const bf16_t* P = (const bf16_t*)(p.ws + OFF_P);
    const bf16_t* Wsb = (const bf16_t*)(p.ws + OFF_WS_GMLP);
    bf16_t* Z = (bf16_t*)(p.ws + OFF_X);
    const float* vg = p.in[23]; const float* bs = p.in[25];
    const int tid = otid(), lane = tid & 63, wid = tid >> 6, wr = wid >> 1, wc = wid & 1, fr = lane & 15, fq = lane >> 4;
    for (int unit = blockIdx.x; unit < 256; unit += gridDim.x) {
        const size_t tok0 = (size_t)unit * 128;
        __syncthreads();
        for (int i = 0; i < 16; ++i) {
            const int r = wid * 16 + i;
            const bf16_t* vr = P + (tok0 + r) * 3072 + 1024 + lane * 16;
            const uint4 a = *(const uint4*)(vr), b = *(const uint4*)(vr + 8);
            const unsigned w[8] = {a.x, a.y, a.z, a.w, b.x, b.y, b.z, b.w};
            float ss = 0.f;
#pragma unroll
            for (int e = 0; e < 8; ++e) { const float lo = bflo(w[e]), hi = bfhi(w[e]); ss += lo * lo + hi * hi; }
            ss = wave_sum(ss);
            if (lane == 0) rsA[r] = rsqrtf(ss * (1.f / 1024.f) + 1e-6f);
        }
        __syncthreads();
        for (int g = 0; g < 8; ++g) {
#pragma unroll
            for (int i = 0; i < 4; ++i) {
                const int idx = tid + i * 512, row = idx >> 4, c16 = idx & 15;
                *(uint4*)(Aw + row * SG_LS + c16 * 8) = *(const uint4*)(Wsb + (size_t)g * 16384 + row * 128 + c16 * 8);
            }
            {
                const int s = tid >> 2, cp = tid & 3;
                const float rs = rsA[s];
                const bf16_t* vr = P + (tok0 + s) * 3072 + 1024 + g * 128 + cp * 32;
#pragma unroll
                for (int i = 0; i < 4; ++i) {
                    const uint4 a = *(const uint4*)(vr + i * 8);
                    const unsigned w[4] = {a.x, a.y, a.z, a.w};
#pragma unroll
                    for (int e = 0; e < 4; ++e) {
                        const int c = cp * 32 + i * 8 + e * 2;
                        const float g0 = vg[g * 128 + c], g1 = vg[g * 128 + c + 1];
                        VT[c * SG_LS + s] = f2bf(bflo(w[e]) * rs * g0);
                        VT[(c + 1) * SG_LS + s] = f2bf(bfhi(w[e]) * rs * g1);
                    }
                }
            }
            __syncthreads();
            f32x4 acc[2][4];
#pragma unroll
            for (int i = 0; i < 2; ++i)
#pragma unroll
                for (int j = 0; j < 4; ++j) acc[i][j] = (f32x4){0.f, 0.f, 0.f, 0.f};
#pragma unroll
            for (int ks = 0; ks < 4; ++ks) {
                bf16x8 af[2], bfr[4];
#pragma unroll
                for (int i = 0; i < 2; ++i) af[i] = *(const bf16x8*)(Aw + (wr * 32 + i * 16 + fr) * SG_LS + ks * 32 + fq * 8);
#pragma unroll
                for (int i = 0; i < 4; ++i) bfr[i] = *(const bf16x8*)(VT + (wc * 64 + i * 16 + fr) * SG_LS + ks * 32 + fq * 8);
#pragma unroll
                for (int mi = 0; mi < 2; ++mi)
#pragma unroll
                    for (int ni = 0; ni < 4; ++ni) acc[mi][ni] = __builtin_amdgcn_mfma_f32_16x16x32_bf16(bfr[ni], af[mi], acc[mi][ni], 0, 0, 0);
            }
#pragma unroll
            for (int mi = 0; mi < 2; ++mi) {
                const int t = wr * 32 + mi * 16 + fr;
                const float bias = bs[g * 128 + t];
                const bf16_t* pr = P + (tok0 + t) * 3072;
#pragma unroll
                for (int ni = 0; ni < 4; ++ni) {
                    const int c = g * 128 + wc * 64 + ni * 16 + fq * 4;
                    const uint2 uu = *(const uint2*)(pr + c), sg = *(const uint2*)(pr + 2048 + c);
                    const f32x4 a = acc[mi][ni];
                    uint2 pk;
                    pk.x = pack2bf(bflo(uu.x) * (a.x + bias) * bflo(sg.x), bfhi(uu.x) * (a.y + bias) * bfhi(sg.x));
                    pk.y = pack2bf(bflo(uu.y) * (a.z + bias) * bflo(sg.y), bfhi(uu.y) * (a.w + bias) * bfhi(sg.y));
                    *(uint2*)(Z + (tok0 + t) * 1024 + c) = pk;
                }
            }
            __syncthreads();
        }
    }
}


#define XB_TMO      128
#define XB_XCNT(j)  (256  + 64 * (j))
#define XB_XSUB(j)  (1280 + 64 * (j))
#define XB_XGEN(j)  (2304 + 64 * (j))
#define XB_TOP      3328
#define XB_TOPGEN   3392
#define XCD_BAR_WORDS 3456
#define XB_SPIN_CAP (1u << 20)
#define XLAS __attribute__((address_space(3)))
__device__ __forceinline__ unsigned xb_ld(unsigned* p)              { return __hip_atomic_load(p, __ATOMIC_RELAXED, __HIP_MEMORY_SCOPE_AGENT); }
__device__ __forceinline__ unsigned xb_add(unsigned* p, unsigned v) { return __hip_atomic_fetch_add(p, v, __ATOMIC_RELAXED, __HIP_MEMORY_SCOPE_AGENT); }
__device__ __forceinline__ unsigned xb_xcc_id() { return (unsigned)__builtin_amdgcn_s_getreg((3 << 11) | 20) & 0xFu; }
#define XB_SPIN(cond, bar) do { unsigned _sp = 0; while (cond) { __builtin_amdgcn_s_sleep(1); \
    if ((++_sp & 255u) == 0u) { if (xb_ld(&(bar)[XB_TMO])) break; if (_sp > XB_SPIN_CAP) { atomicAdd(&(bar)[XB_TMO], 1u); break; } } } } while (0)
struct XcdBarrier { unsigned* bar; unsigned x; volatile XLAS unsigned* st; };
__device__ __forceinline__ XcdBarrier xcd_barrier_post(unsigned* bar, volatile XLAS unsigned* st) {
    XcdBarrier b; b.bar = bar; b.x = xb_xcc_id(); b.st = st;
    if (otid() == 0) (void)xb_add(&bar[XB_XCNT(b.x)], 1u);
    return b;
}
__device__ __forceinline__ void xcd_barrier_complete(unsigned* bar, unsigned x, unsigned& nloc, unsigned& nx) {
    const unsigned G = gridDim.x * gridDim.y * gridDim.z;
    unsigned sum, cnt, mine, sp = 0u;
    for (;;) {
        sum = 0u; cnt = 0u; mine = 0u;
#pragma unroll
        for (unsigned j = 0; j < 16; ++j) { const unsigned c = xb_ld(&bar[XB_XCNT(j)]); sum += c; cnt += (c > 0u) ? 1u : 0u; mine = (j == x) ? c : mine; }
        if (sum == G) break;
        __builtin_amdgcn_s_sleep(1);
        if ((++sp & 255u) == 0u) { if (xb_ld(&bar[XB_TMO])) break; if (sp > XB_SPIN_CAP) { atomicAdd(&bar[XB_TMO], 1u); break; } }
    }
    nloc = mine > 0u ? mine : 1u; nx = cnt > 0u ? cnt : 1u;
}
__device__ __forceinline__ void xcd_barrier(const XcdBarrier& b) {
    asm volatile("s_waitcnt vmcnt(0)" ::: "memory");
    __syncthreads();
    if (otid() == 0) {
        unsigned* bar = b.bar;
        __builtin_amdgcn_s_waitcnt(0);
        unsigned nloc = b.st[0], nx = b.st[1];
        if (nloc == 0u) { xcd_barrier_complete(bar, b.x, nloc, nx); b.st[0] = nloc; b.st[1] = nx; }
        const unsigned old = xb_add(&bar[XB_XSUB(b.x)], 1u);
        const unsigned gen = old / nloc;
        if (old + 1u == (gen + 1u) * nloc) {
            __builtin_amdgcn_fence(__ATOMIC_RELEASE, "agent");
            asm volatile("s_waitcnt vmcnt(0)" ::: "memory");
            const unsigned og = xb_add(&bar[XB_TOP], 1u);
            const unsigned tg = og / nx;
            if (og + 1u == (tg + 1u) * nx) xb_add(&bar[XB_TOPGEN], 1u);
            else XB_SPIN(xb_ld(&bar[XB_TOPGEN]) == tg, bar);
            __builtin_amdgcn_fence(__ATOMIC_ACQUIRE, "agent");
            xb_add(&bar[XB_XGEN(b.x)], 1u);
            asm volatile("s_waitcnt vmcnt(0)" ::: "memory");
        } else {
            XB_SPIN(xb_ld(&bar[XB_XGEN(b.x)]) == gen, bar);
            __builtin_amdgcn_fence(__ATOMIC_ACQUIRE, "agent");
            asm volatile("s_waitcnt vmcnt(0)" ::: "memory");
        }
    }
    __syncthreads();
}

__global__ void __launch_bounds__(NTHREADS) fwd_megakernel(Params p) {
    extern __shared__ __attribute__((aligned(16))) char smem[];
    cg::grid_group grid = cg::this_grid();
    unsigned char* ws = p.ws;
    bf16_t* HN = (bf16_t*)(ws + OFF_X);
    bf16_t* Pb = (bf16_t*)(ws + OFF_P);
    bf16_t* Zx = (bf16_t*)(ws + OFF_X);
    bf16_t* Zy = (bf16_t*)(ws + OFF_Y);
    bf16_t* Lin = (bf16_t*)(ws + OFF_LIN);
    const float* ng = p.in[1];
    volatile XLAS unsigned* xst = (volatile XLAS unsigned*)(smem + LDS_STAGE);
    if (threadIdx.x == 0) { xst[0] = 0u; xst[1] = 0u; }
    __syncthreads();
    const XcdBarrier xbar = xcd_barrier_post((unsigned*)(ws + OFF_BAR), xst);

    phase_weights(p, smem);
    rmsnorm_phase<true>(p.in[0], ng, HN);
    grid.sync();
    for (int rep = 0; rep < REP_GEMM; ++rep) {
    pg8::run(smem, HN, (const bf16_t*)(ws + OFF_WT_RWKV_IN), 4352, pg8::EStoreBf16{Pb, RW_COLS, RW_COLS});
    xcd_barrier(xbar); }
    rwkv_lin_phase(Pb, p.in[4], Lin);
    xcd_barrier(xbar);
    gemm_phase(Lin, 128, (const bf16_t*)(ws + OFF_WT_W2), 64, 1024, 64, EpiLoraW{p.in[5], (float*)(ws + OFF_X)}, smem);
    gemm_phase(Lin + 64, 128, (const bf16_t*)(ws + OFF_WT_A2), 64, 1024, 64, EpiLoraA{p.in[7], (unsigned short*)(ws + OFF_Y)}, smem);
    xcd_barrier(xbar);
    for (int rep = 0; rep < REP_RSCAN; ++rep) {
    rwkv_elem_phase(p);
    xcd_barrier(xbar);
    rwkv_chunk2_phase(p, smem);
    xcd_barrier(xbar); }
    for (int rep = 0; rep < REP_MISC; ++rep) {
    rwkv_post2_phase(p);
    xcd_barrier(xbar); }
    pg8::run(smem, Zx, (const bf16_t*)(ws + OFF_WT_RWKV_OUT), 1024, pg8::EResid{p.in[0], p.out});
    xcd_barrier(xbar);
    rmsnorm_phase<true>(p.out, ng + 1024, HN);
    xcd_barrier(xbar);
    for (int rep = 0; rep < REP_GEMM; ++rep) {
    pg8::run(smem, HN, (const bf16_t*)(ws + OFF_WT_HGRN_IN), 4096, pg8::EHgrn{Pb, (const float*)(ws + OFF_LB)});
    xcd_barrier(xbar); }
    for (int rep = 0; rep < REP_HSCAN; ++rep) {
    hgrn_prep_phase(p, smem);
    xcd_barrier(xbar);
    hgrn_chunk_phase(p, smem);
    xcd_barrier(xbar); }
    for (int rep = 0; rep < REP_MISC; ++rep) {
    hgrn_post_phase(p);
    xcd_barrier(xbar); }
    pg8::run(smem, Zy, (const bf16_t*)(ws + OFF_WT_HGRN_OUT), 1024, pg8::EResid{p.out, p.out});
    xcd_barrier(xbar);
    rmsnorm_phase<true>(p.out, ng + 2048, HN);
    xcd_barrier(xbar);
    for (int rep = 0; rep < REP_GEMM; ++rep) {
    pg8::run(smem, HN, (const bf16_t*)(ws + OFF_WT_CONV_IN), 4096, pg8::EConv{Pb, Pb + (size_t)M_TOK * 1024});
    xcd_barrier(xbar); }
    for (int rep = 0; rep < REP_MISC; ++rep) {
    conv_post_phase(p);
    xcd_barrier(xbar); }
    pg8::run(smem, Zx, (const bf16_t*)(ws + OFF_WT_CONV_OUT), 1024, pg8::EResid{p.out, p.out});
    xcd_barrier(xbar);
    rmsnorm_phase<true>(p.out, ng + 3072, HN);
    xcd_barrier(xbar);
    for (int rep = 0; rep < REP_GEMM; ++rep) {
    pg8::run(smem, HN, (const bf16_t*)(ws + OFF_WT_GMLP_IN), 3072, pg8::EGmlp{Pb});
    xcd_barrier(xbar); }
    for (int rep = 0; rep < REP_MISC; ++rep) {
    gmlp_spatial_phase(p, smem);
    xcd_barrier(xbar); }
    pg8::run(smem, Zx, (const bf16_t*)(ws + OFF_WT_GMLP_OUT), 1024, pg8::EResid{p.out, p.out});
    xcd_barrier(xbar);
    rmsnorm_phase<false>(p.out, p.in[2], p.out);
}

extern "C" void kernel_launch(void* const* d_in, const int* in_sizes, int n_in, void* d_out, int out_size, void* d_ws, size_t ws_size, hipStream_t stream) {
    static int grid = 0;
    if (grid == 0) {
        if (n_in != 27 || out_size != M_TOK * DM || ws_size < WS_END) {
            fprintf(stderr, "kernel_launch: unexpected problem (n_in %d, out %d, ws %zu, need %zu)\n", n_in, out_size, ws_size, (size_t)WS_END);
            grid = -1; return;
        }
        int dev = 0, cus = 0, per_cu = 0;
        hipGetDevice(&dev);
        hipDeviceGetAttribute(&cus, hipDeviceAttributeMultiprocessorCount, dev);
        if (hipFuncSetAttribute((const void*)fwd_megakernel, hipFuncAttributeMaxDynamicSharedMemorySize, LDS_BYTES) != hipSuccess) {
            fprintf(stderr, "kernel_launch: hipFuncSetAttribute failed\n"); grid = -1; return;
        }
        hipOccupancyMaxActiveBlocksPerMultiprocessor(&per_cu, (const void*)fwd_megakernel, NTHREADS, LDS_BYTES);
        if (per_cu < 1) { fprintf(stderr, "kernel_launch: occupancy query says %d blocks per CU\n", per_cu); per_cu = 1; }
        (void)hipGetLastError();
        grid = cus;
    }
    if (grid < 0) return;
    Params p{};
    for (int i = 0; i < 27; ++i) p.in[i] = (const float*)d_in[i];
    p.out = (float*)d_out; p.ws = (unsigned char*)d_ws;
    (void)hipMemsetAsync((unsigned char*)d_ws + OFF_BAR, 0, XCD_BAR_WORDS * 4, stream);
    void* args[] = {&p};
    hipError_t e = hipLaunchCooperativeKernel((const void*)fwd_megakernel, dim3(grid), dim3(NTHREADS), args, LDS_BYTES, stream);
    if (e != hipSuccess) fprintf(stderr, "cooperative launch failed: %s (grid %d)\n", hipGetErrorString(e), grid);
}
```

```cpp
#include <hip/hip_runtime.h>
#include <hip/hip_cooperative_groups.h>
#include <hip/hip_fp16.h>
#include <cstdio>
#include <cstdint>
namespace cg = cooperative_groups;

typedef unsigned short bf16_t;
typedef short bf16x8 __attribute__((ext_vector_type(8)));
typedef float f32x4 __attribute__((ext_vector_type(4)));

constexpr int M_TOK = 32768, DM = 1024, SEQ_T = 8192;
constexpr int NTHREADS = 512;
constexpr int LDS_STAGE = 131072;
constexpr int LDS_BYTES = LDS_STAGE + 16;
constexpr int RW_COLS = 4224;
#ifndef REP_GEMM
#define REP_GEMM 1
#endif
#ifndef REP_RSCAN
#define REP_RSCAN 1
#endif
#ifndef REP_HSCAN
#define REP_HSCAN 1
#endif
#ifndef REP_MISC
#define REP_MISC 1
#endif

constexpr size_t MiB = 1048576;
constexpr size_t OFF_WT_RWKV_IN = 0;
constexpr size_t OFF_WT_RWKV_OUT = OFF_WT_RWKV_IN + (size_t)RW_COLS * 1024 * 2;
constexpr size_t OFF_WT_HGRN_IN = OFF_WT_RWKV_OUT + 2 * MiB;
constexpr size_t OFF_WT_HGRN_OUT = OFF_WT_HGRN_IN + 8 * MiB;
constexpr size_t OFF_WT_CONV_IN = OFF_WT_HGRN_OUT + 2 * MiB;
constexpr size_t OFF_WT_CONV_OUT = OFF_WT_CONV_IN + 8 * MiB;
constexpr size_t OFF_WT_GMLP_IN = OFF_WT_CONV_OUT + 2 * MiB;
constexpr size_t OFF_WT_GMLP_OUT = OFF_WT_GMLP_IN + 6 * MiB;
constexpr size_t OFF_WT_W2 = OFF_WT_GMLP_OUT + 2 * MiB;
constexpr size_t OFF_WT_A2 = OFF_WT_W2 + 131072;
constexpr size_t OFF_WS_GMLP = OFF_WT_A2 + 131072;
constexpr size_t OFF_LB = OFF_WS_GMLP + 262144;
constexpr size_t OFF_BAR = OFF_LB + 4096;
constexpr size_t OFF_P = 39 * MiB;
constexpr size_t OFF_X = OFF_P + 264 * MiB;
constexpr size_t OFF_Y = OFF_X + 128 * MiB;
constexpr size_t OFF_LIN = OFF_Y + 64 * MiB;
constexpr size_t WS_END = OFF_LIN + 8 * MiB;
static_assert(OFF_BAR + 16384 <= OFF_P, "small region overflow");

struct Params {
    const float* in[27];
    float* out;
    unsigned char* ws;
};

__device__ __forceinline__ int otid() { int t = (int)threadIdx.x; asm volatile("" : "+v"(t)); return t; }
__device__ __forceinline__ bf16_t f2bf(float f) { unsigned u = __float_as_uint(f); u += 0x7FFFu + ((u >> 16) & 1u); return (bf16_t)(u >> 16); }
__device__ __forceinline__ float bf2f(unsigned h) { return __uint_as_float(h << 16); }
typedef __bf16 hwbf16x2 __attribute__((ext_vector_type(2)));
typedef float f32x2c __attribute__((ext_vector_type(2)));
__device__ __forceinline__ unsigned pack2bf(float a, float b) { const f32x2c v = {a, b}; const hwbf16x2 r = __builtin_convertvector(v, hwbf16x2); return __builtin_bit_cast(unsigned, r); }
__device__ __forceinline__ float bflo(unsigned u) { return __uint_as_float(u << 16); }
__device__ __forceinline__ float bfhi(unsigned u) { return __uint_as_float(u & 0xFFFF0000u); }
__device__ __forceinline__ float h2f(unsigned short h) { return __half2float(__ushort_as_half(h)); }
__device__ __forceinline__ unsigned short f2h(float f) { return __half_as_ushort(__float2half(f)); }
__device__ __forceinline__ float sigmoidf_(float x) { return __builtin_amdgcn_rcpf(1.0f + __expf(-x)); }
__device__ __forceinline__ float siluf_(float x) { return x * __builtin_amdgcn_rcpf(1.0f + __expf(-x)); }

__device__ __forceinline__ float wave_sum(float v) {
#pragma unroll
    for (int o = 1; o < 64; o <<= 1) v += __shfl_xor(v, o);
    return v;
}
template <int CTRL>
__device__ __forceinline__ float dpp_mov(float x) {
    return __int_as_float(__builtin_amdgcn_update_dpp(0, __float_as_int(x), CTRL, 0xF, 0xF, true));
}
__device__ __forceinline__ float sum16(float x) {
    x += dpp_mov<0xB1>(x);
    x += dpp_mov<0x4E>(x);
    x += dpp_mov<0x141>(x);
    x += dpp_mov<0x140>(x);
    return x;
}

__device__ __forceinline__ int conv_perm(int n) { const int blk = n >> 10, ch = n & 1023, chin = ch & 63; return (ch >> 6) * 256 + (blk >> 1) * 128 + (chin >> 4) * 32 + (blk & 1) * 16 + (chin & 15); }

__device__ __forceinline__ void transpose_convert(const float* __restrict__ W, int K, int N, bf16_t* __restrict__ WT, bool perm, float* tile) {
    const int tid = otid();
    const int nnb = N / 64, items = (K / 64) * nnb;
    for (int it = blockIdx.x; it < items; it += gridDim.x) {
        const int kb = it / nnb, nb = it % nnb, k0 = kb * 64, n0 = nb * 64;
#pragma unroll
        for (int i = 0; i < 2; ++i) {
            const int idx = tid + i * 512, kk = idx >> 4, n4 = (idx & 15) * 4;
            const f32x4 v = *(const f32x4*)(W + (size_t)(k0 + kk) * N + n0 + n4);
            float* d = tile + kk * 65 + n4;
            d[0] = v.x; d[1] = v.y; d[2] = v.z; d[3] = v.w;
        }
        __syncthreads();
        {
            const int n = tid >> 3, k8 = (tid & 7) * 8;
            const float* s = tile + k8 * 65 + n;
            uint4 o;
            o.x = pack2bf(s[0 * 65], s[1 * 65]); o.y = pack2bf(s[2 * 65], s[3 * 65]);
            o.z = pack2bf(s[4 * 65], s[5 * 65]); o.w = pack2bf(s[6 * 65], s[7 * 65]);
            const int ncol = n0 + n, nrow = perm ? conv_perm(ncol) : ncol;
            *(uint4*)(WT + (size_t)nrow * K + k0 + k8) = o;
        }
        __syncthreads();
    }
}

__device__ __forceinline__ void phase_weights(const Params& p, char* smem) {
    float* tile = (float*)smem;
    unsigned char* ws = p.ws;
    transpose_convert(p.in[3], 1024, RW_COLS, (bf16_t*)(ws + OFF_WT_RWKV_IN), false, tile);
    transpose_convert(p.in[14], 1024, 1024, (bf16_t*)(ws + OFF_WT_RWKV_OUT), false, tile);
    transpose_convert(p.in[16], 1024, 4096, (bf16_t*)(ws + OFF_WT_HGRN_IN), false, tile);
    transpose_convert(p.in[18], 1024, 1024, (bf16_t*)(ws + OFF_WT_HGRN_OUT), false, tile);
    transpose_convert(p.in[19], 1024, 4096, (bf16_t*)(ws + OFF_WT_CONV_IN), true, tile);
    transpose_convert(p.in[21], 1024, 1024, (bf16_t*)(ws + OFF_WT_CONV_OUT), false, tile);
    transpose_convert(p.in[22], 1024, 3072, (bf16_t*)(ws + OFF_WT_GMLP_IN), false, tile);
    transpose_convert(p.in[26], 1024, 1024, (bf16_t*)(ws + OFF_WT_GMLP_OUT), false, tile);
    transpose_convert(p.in[6], 64, 1024, (bf16_t*)(ws + OFF_WT_W2), false, tile);
    transpose_convert(p.in[8], 64, 1024, (bf16_t*)(ws + OFF_WT_A2), false, tile);
    const int gtid = blockIdx.x * NTHREADS + otid(), gsz = gridDim.x * NTHREADS;
    {
        const float* w = p.in[24]; bf16_t* o = (bf16_t*)(ws + OFF_WS_GMLP);
        for (int i = gtid; i < 8 * 128 * 128; i += gsz) { const int t = (i >> 7) & 127, s = i & 127; o[i] = (s <= t) ? f2bf(w[i]) : (bf16_t)0; }
    }
    {
        const float* l = p.in[15]; float* lb = (float*)(ws + OFF_LB);
        for (int c = gtid; c < 1024; c += gsz) {
            const float l0 = l[c], l1 = l[1024 + c], l2 = l[2048 + c], l3 = l[3072 + c];
            const float m = fmaxf(fmaxf(l0, l1), fmaxf(l2, l3));
            const float e0 = expf(l0 - m), e1 = expf(l1 - m), e2 = expf(l2 - m), e3 = expf(l3 - m);
            lb[c] = e1 / (e0 + e1 + e2 + e3);
        }
    }
}

template <bool OUT_BF16>
__device__ __forceinline__ void rmsnorm_phase(const float* in, const float* __restrict__ g, void* outp) {
    const int lane = otid() & 63, wid = otid() >> 6;
    const int gw = blockIdx.x * 8 + wid, ngw = gridDim.x * 8;
    f32x4 gv[4];
#pragma unroll
    for (int j = 0; j < 4; ++j) gv[j] = *(const f32x4*)(g + lane * 4 + j * 256);
    for (int row = gw; row < M_TOK; row += ngw) {
        const float* xr = in + (size_t)row * 1024 + lane * 4;
        f32x4 v[4]; float ss = 0.f;
#pragma unroll
        for (int j = 0; j < 4; ++j) { v[j] = *(const f32x4*)(xr + j * 256); ss += v[j].x * v[j].x + v[j].y * v[j].y + v[j].z * v[j].z + v[j].w * v[j].w; }
        ss = wave_sum(ss);
        const float rs = rsqrtf(ss * (1.0f / 1024.0f) + 1e-6f);
#pragma unroll
        for (int j = 0; j < 4; ++j) {
            const f32x4 o = v[j] * rs * gv[j];
            if (OUT_BF16) {
                uint2 pk; pk.x = pack2bf(o.x, o.y); pk.y = pack2bf(o.z, o.w);
                *(uint2*)((bf16_t*)outp + (size_t)row * 1024 + lane * 4 + j * 256) = pk;
            } else {
                *(f32x4*)((float*)outp + (size_t)row * 1024 + lane * 4 + j * 256) = o;
            }
        }
    }
}

constexpr int G_BM = 256, G_BN = 128, G_BK = 64, G_LS = 72;
constexpr int G_ASTAGE = G_BM * G_LS, G_BSTAGE = G_BN * G_LS;

template <class Epi>
__device__ __forceinline__ void gemm_phase(const bf16_t* A, int lda, const bf16_t* Bt, int ldb, int N, int K, const Epi epi, char* smem) {
    const int tid = otid(), lane = tid & 63, wid = tid >> 6, wr = wid >> 1, wc = wid & 1, fr = lane & 15, fq = lane >> 4;
    bf16_t* As = (bf16_t*)smem;
    bf16_t* Bs = As + 2 * G_ASTAGE;
    const int nTn = N / G_BN, nT = (M_TOK / G_BM) * nTn, nk = K / G_BK;
    const int lrow = tid >> 3, lc = (tid & 7) * 8;
    for (int tile = blockIdx.x; tile < nT; tile += gridDim.x) {
        const int tm = tile / nTn, tn = tile % nTn;
        const bf16_t* Ag = A + (size_t)(tm * G_BM + lrow) * lda + lc;
        const bf16_t* Bg = Bt + (size_t)(tn * G_BN + lrow) * ldb + lc;
        f32x4 acc[4][4];
#pragma unroll
        for (int i = 0; i < 4; ++i)
#pragma unroll
            for (int j = 0; j < 4; ++j) acc[i][j] = (f32x4){0.f, 0.f, 0.f, 0.f};
        uint4 ra[4], rb[2];
#pragma unroll
        for (int i = 0; i < 4; ++i) ra[i] = *(const uint4*)(Ag + (size_t)i * 64 * lda);
#pragma unroll
        for (int i = 0; i < 2; ++i) rb[i] = *(const uint4*)(Bg + (size_t)i * 64 * ldb);
#pragma unroll
        for (int i = 0; i < 4; ++i) *(uint4*)(As + (lrow + i * 64) * G_LS + lc) = ra[i];
#pragma unroll
        for (int i = 0; i < 2; ++i) *(uint4*)(Bs + (lrow + i * 64) * G_LS + lc) = rb[i];
        __syncthreads();
        for (int kt = 0; kt < nk; ++kt) {
            const int buf = kt & 1;
            const bool more = (kt + 1 < nk);
            if (more) {
#pragma unroll
                for (int i = 0; i < 4; ++i) ra[i] = *(const uint4*)(Ag + (size_t)i * 64 * lda + (kt + 1) * G_BK);
#pragma unroll
                for (int i = 0; i < 2; ++i) rb[i] = *(const uint4*)(Bg + (size_t)i * 64 * ldb + (kt + 1) * G_BK);
            }
            const bf16_t* as = As + buf * G_ASTAGE + (wr * 64 + fr) * G_LS + fq * 8;
            const bf16_t* bs = Bs + buf * G_BSTAGE + (wc * 64 + fr) * G_LS + fq * 8;
#pragma unroll
            for (int ks = 0; ks < 2; ++ks) {
                bf16x8 af[4], bfr[4];
#pragma unroll
                for (int i = 0; i < 4; ++i) { af[i] = *(const bf16x8*)(as + i * 16 * G_LS + ks * 32); bfr[i] = *(const bf16x8*)(bs + i * 16 * G_LS + ks * 32); }
#pragma unroll
                for (int mi = 0; mi < 4; ++mi)
#pragma unroll
                    for (int ni = 0; ni < 4; ++ni) acc[mi][ni] = __builtin_amdgcn_mfma_f32_16x16x32_bf16(bfr[ni], af[mi], acc[mi][ni], 0, 0, 0);
            }
            if (more) {
                bf16_t* ad = As + (buf ^ 1) * G_ASTAGE; bf16_t* bd = Bs + (buf ^ 1) * G_BSTAGE;
#pragma unroll
                for (int i = 0; i < 4; ++i) *(uint4*)(ad + (lrow + i * 64) * G_LS + lc) = ra[i];
#pragma unroll
                for (int i = 0; i < 2; ++i) *(uint4*)(bd + (lrow + i * 64) * G_LS + lc) = rb[i];
            }
            __syncthreads();
        }
        epi(acc, tm * G_BM + wr * 64, tn * G_BN + wc * 64, fr, fq);
    }
}

struct EpiStoreBf16 {
    bf16_t* C; int ldc;
    __device__ __forceinline__ void operator()(f32x4 (&acc)[4][4], int row0, int col0, int fr, int fq) const {
#pragma unroll
        for (int mi = 0; mi < 4; ++mi)
#pragma unroll
            for (int ni = 0; ni < 4; ++ni) {
                const f32x4 a = acc[mi][ni]; uint2 pk; pk.x = pack2bf(a.x, a.y); pk.y = pack2bf(a.z, a.w);
                *(uint2*)(C + (size_t)(row0 + mi * 16 + fr) * ldc + col0 + ni * 16 + fq * 4) = pk;
            }
    }
};
struct EpiHgrn {
    bf16_t* C; const float* lb;
    __device__ __forceinline__ void operator()(f32x4 (&acc)[4][4], int row0, int col0, int fr, int fq) const {
        const int blk = col0 >> 10;
#pragma unroll
        for (int mi = 0; mi < 4; ++mi)
#pragma unroll
            for (int ni = 0; ni < 4; ++ni) {
                f32x4 a = acc[mi][ni]; const int col = col0 + ni * 16 + fq * 4; uint2 pk;
                if (blk == 1) {
                    const f32x4 l = *(const f32x4*)(lb + (col - 1024));
                    a.x = (1.f - l.x) * sigmoidf_(-a.x); a.y = (1.f - l.y) * sigmoidf_(-a.y); a.z = (1.f - l.z) * sigmoidf_(-a.z); a.w = (1.f - l.w) * sigmoidf_(-a.w);
                    pk.x = (unsigned)f2h(a.x) | ((unsigned)f2h(a.y) << 16); pk.y = (unsigned)f2h(a.z) | ((unsigned)f2h(a.w) << 16);
                } else {
                    if (blk == 3) { a.x = siluf_(a.x); a.y = siluf_(a.y); a.z = siluf_(a.z); a.w = siluf_(a.w); }
                    pk.x = pack2bf(a.x, a.y); pk.y = pack2bf(a.z, a.w);
                }
                *(uint2*)(C + (size_t)(row0 + mi * 16 + fr) * 4096 + col) = pk;
            }
    }
};
struct EpiConv {
    bf16_t* Yc; bf16_t* U;
    __device__ __forceinline__ void operator()(f32x4 (&acc)[4][4], int row0, int col0, int fr, int fq) const {
        const int ch = (col0 >> 6) * 16 + fq * 4;
#pragma unroll
        for (int mi = 0; mi < 4; ++mi) {
            const f32x4 b = acc[mi][0], c = acc[mi][1], z = acc[mi][2], g = acc[mi][3];
            const size_t o = (size_t)(row0 + mi * 16 + fr) * 1024 + ch;
            uint2 py, pu;
            py.x = pack2bf(c.x * z.x, c.y * z.y); py.y = pack2bf(c.z * z.z, c.w * z.w);
            pu.x = pack2bf(b.x * siluf_(g.x), b.y * siluf_(g.y)); pu.y = pack2bf(b.z * siluf_(g.z), b.w * siluf_(g.w));
            *(uint2*)(Yc + o) = py; *(uint2*)(U + o) = pu;
        }
    }
};
struct EpiGmlp {
    bf16_t* C;
    __device__ __forceinline__ void operator()(f32x4 (&acc)[4][4], int row0, int col0, int fr, int fq) const {
        const int blk = col0 >> 10;
#pragma unroll
        for (int mi = 0; mi < 4; ++mi)
#pragma unroll
            for (int ni = 0; ni < 4; ++ni) {
                f32x4 a = acc[mi][ni];
                if (blk == 2) { a.x = siluf_(a.x); a.y = siluf_(a.y); a.z = siluf_(a.z); a.w = siluf_(a.w); }
                uint2 pk; pk.x = pack2bf(a.x, a.y); pk.y = pack2bf(a.z, a.w);
                *(uint2*)(C + (size_t)(row0 + mi * 16 + fr) * 3072 + col0 + ni * 16 + fq * 4) = pk;
            }
    }
};
struct EpiResid {
    const float* R; float* O;
    __device__ __forceinline__ void operator()(f32x4 (&acc)[4][4], int row0, int col0, int fr, int fq) const {
#pragma unroll
        for (int mi = 0; mi < 4; ++mi)
#pragma unroll
            for (int ni = 0; ni < 4; ++ni) {
                const size_t o = (size_t)(row0 + mi * 16 + fr) * 1024 + col0 + ni * 16 + fq * 4;
                const f32x4 r = *(const f32x4*)(R + o);
                *(f32x4*)(O + o) = r + acc[mi][ni];
            }
    }
};
__device__ __forceinline__ float rwkv_decay(float v) {
    return __expf(-0.60653065971263342f * sigmoidf_(v));
}
struct EpiLoraW {
    const float* w0; float* Wd;
    __device__ __forceinline__ void operator()(f32x4 (&acc)[4][4], int row0, int col0, int fr, int fq) const {
#pragma unroll
        for (int mi = 0; mi < 4; ++mi)
#pragma unroll
            for (int ni = 0; ni < 4; ++ni) {
                const int col = col0 + ni * 16 + fq * 4;
                const f32x4 b = *(const f32x4*)(w0 + col); const f32x4 a = acc[mi][ni] + b;
                f32x4 o; o.x = rwkv_decay(a.x); o.y = rwkv_decay(a.y); o.z = rwkv_decay(a.z); o.w = rwkv_decay(a.w);
                *(f32x4*)(Wd + (size_t)(row0 + mi * 16 + fr) * 1024 + col) = o;
            }
    }
};
struct EpiLoraA {
    const float* a0; unsigned short* Ai;
    __device__ __forceinline__ void operator()(f32x4 (&acc)[4][4], int row0, int col0, int fr, int fq) const {
#pragma unroll
        for (int mi = 0; mi < 4; ++mi)
#pragma unroll
            for (int ni = 0; ni < 4; ++ni) {
                const int col = col0 + ni * 16 + fq * 4;
                const f32x4 b = *(const f32x4*)(a0 + col); const f32x4 a = acc[mi][ni] + b;
                uint2 pk;
                pk.x = (unsigned)f2h(sigmoidf_(a.x)) | ((unsigned)f2h(sigmoidf_(a.y)) << 16);
                pk.y = (unsigned)f2h(sigmoidf_(a.z)) | ((unsigned)f2h(sigmoidf_(a.w)) << 16);
                *(uint2*)(Ai + (size_t)(row0 + mi * 16 + fr) * 1024 + col) = pk;
            }
    }
};


namespace pg8 {
#define PG8_LAS __attribute__((address_space(3)))
constexpr int BM = 256, BK = 64, HALF = 128, HTB = HALF * BK * 2, NXCD = 8, WGM = 8;
__device__ __forceinline__ int lds_byte(int r, int c) { const int st = (r >> 4) * 2 + (c >> 5), rr = r & 15, cc = c & 31, ob = rr * 64 + cc * 2; return st * 1024 + (ob ^ (((ob >> 9) & 1) << 5)); }
__device__ __forceinline__ void stage_rc(int b, int& R, int& C) { const int st = b / 1024, sb = b % 1024, swz = sb ^ (((sb >> 9) & 1) << 5); R = (st >> 1) * 16 + swz / 64; C = (st & 1) * 32 + (swz % 64) / 2; }
struct Unit { int pm, pn; };
struct Gemm { const bf16_t* A; const bf16_t* Bt; int M, N, K; };
struct StaticOrder {
    int nM, nN, nwg, G, c;
    __device__ void init(int M, int N, int G_, int c_) { nM = M / BM; nN = N / BM; nwg = nM * nN; G = G_; c = c_; }
    __device__ bool next(int i, Unit& u) const {
        const long L = (long)i * G + c; if (L >= nwg) return false;
        int wgid = (int)L; { const int q = nwg / NXCD, r = nwg % NXCD, xcd = wgid % NXCD, off = wgid / NXCD; wgid = (xcd < r ? xcd * (q + 1) : r * (q + 1) + (xcd - r) * q) + off; }
        const int nig = WGM * nN, gid = wgid / nig, fm = gid * WGM, gsz = (nM - fm) < WGM ? (nM - fm) : WGM;
        u.pm = fm + ((wgid % nig) % gsz); u.pn = (wgid % nig) / gsz; return true;
    }
};
template <class Epi>
__device__ __forceinline__ void gemm_phase(PG8_LAS unsigned char* lds, const Gemm g, const StaticOrder& S, const Epi& E) {
    const int tid = otid(), wid = __builtin_amdgcn_readfirstlane(tid >> 6), lane = tid & 63, wr = wid >> 2, wc = wid & 3, fr = lane & 15, fq = lane >> 4;
    const int K = g.K, nt = K / BK;
    unsigned voffA[2], voffB[2];
#pragma unroll
    for (int i = 0; i < 2; ++i) { int R, C; stage_rc(tid * 16 + i * 8192, R, C); voffA[i] = (unsigned)(R * K + C) * 2u; voffB[i] = (unsigned)(R * K + C) * 2u; }
    const size_t kstep = (size_t)(BK * 2);
    const size_t hstep = (size_t)HALF * K * 2;
    const size_t tstep = 2 * hstep;
    const unsigned ldsw = (unsigned)wid * 1024u;
    const int aoff = lds_byte(wr * 64 + fr, fq * 8), boff = lds_byte(wc * 32 + fr, fq * 8);
#define PG8_SA(b, h) (((b) * 2 + (h)) * HTB)
#define PG8_SB(b, h) ((4 + (b) * 2 + (h)) * HTB)
#define PG8_STAGE(bufoff, gbase, voff) do { _Pragma("unroll") for (int _i = 0; _i < 2; ++_i) \
        __builtin_amdgcn_global_load_lds((const unsigned*)((const char*)(gbase) + (voff)[_i]), (PG8_LAS unsigned*)(lds + (bufoff) + ldsw + _i * 8192), 16, 0, 0); } while (0)
#define PG8_LDA(dst, b, h) do { _Pragma("unroll") for (int m = 0; m < 4; ++m) _Pragma("unroll") for (int k = 0; k < 2; ++k) dst[m][k] = *(const PG8_LAS bf16x8*)(lds + PG8_SA(b, h) + aoff + m * 2048 + k * 1024); } while (0)
#define PG8_LDB(dst, b, h) do { _Pragma("unroll") for (int n = 0; n < 2; ++n) _Pragma("unroll") for (int k = 0; k < 2; ++k) dst[n][k] = *(const PG8_LAS bf16x8*)(lds + PG8_SB(b, h) + boff + n * 2048 + k * 1024); } while (0)
#define PG8_MMA(ai, bj, At, Bt) do { __builtin_amdgcn_s_setprio(1); _Pragma("unroll") for (int m = 0; m < 4; ++m) _Pragma("unroll") for (int n = 0; n < 2; ++n) _Pragma("unroll") for (int k = 0; k < 2; ++k) \
        acc[ai][bj][m][n] = __builtin_amdgcn_mfma_f32_16x16x32_bf16(Bt[n][k], At[m][k], acc[ai][bj][m][n], 0, 0, 0); __builtin_amdgcn_s_setprio(0); } while (0)
#define PG8_WAIT_V(n) asm volatile("s_waitcnt vmcnt(" #n ")" ::: "memory")
#define PG8_WAIT_L(n) asm volatile("s_waitcnt lgkmcnt(" #n ")" ::: "memory")
#define PG8_BAR __builtin_amdgcn_s_barrier()
#define PG8_SCHED __builtin_amdgcn_sched_barrier(0)
    Unit cur, nxt; int ui = 0;
    if (!S.next(0, cur)) return;
    f32x4 acc[2][2][4][2];
#pragma unroll
    for (int a = 0; a < 2; ++a)
#pragma unroll
        for (int b = 0; b < 2; ++b)
#pragma unroll
            for (int m = 0; m < 4; ++m)
#pragma unroll
                for (int n = 0; n < 2; ++n) acc[a][b][m][n] = (f32x4){0.f, 0.f, 0.f, 0.f};
    bf16x8 At[4][2], B0[2][2], B1[2][2];
    const char* cA = (const char*)g.A + (size_t)cur.pm * tstep; const char* cB = (const char*)g.Bt + (size_t)cur.pn * tstep;
    PG8_STAGE(PG8_SB(0, 0), cB, voffB); PG8_STAGE(PG8_SA(0, 0), cA, voffA); PG8_STAGE(PG8_SB(0, 1), cB + hstep, voffB); PG8_STAGE(PG8_SA(0, 1), cA + hstep, voffA);
    if (wr == 1) PG8_BAR;
    PG8_WAIT_V(4); PG8_BAR;
    PG8_STAGE(PG8_SB(1, 0), cB + kstep, voffB); PG8_STAGE(PG8_SA(1, 0), cA + kstep, voffA); PG8_STAGE(PG8_SB(1, 1), cB + hstep + kstep, voffB);
    PG8_WAIT_V(6); PG8_BAR;
    for (;;) {
        const bool has_next = S.next(ui + 1, nxt);
        const char* nA = has_next ? (const char*)g.A + (size_t)nxt.pm * tstep : cA; const char* nB = has_next ? (const char*)g.Bt + (size_t)nxt.pn * tstep : cB;
        for (int t = 0; t < nt; t += 2) {
            const bool last = (t == nt - 2);
            const char* a1 = cA + (size_t)(t + 1) * kstep;
            const char* a2 = last ? nA : cA + (size_t)(t + 2) * kstep; const char* b2 = last ? nB : cB + (size_t)(t + 2) * kstep;
            const char* a3 = a2 + kstep; const char* b3 = b2 + kstep;
            PG8_LDB(B0, 0, 0); PG8_SCHED; PG8_LDA(At, 0, 0); PG8_STAGE(PG8_SA(1, 1), a1 + hstep, voffA);
            PG8_WAIT_L(8); PG8_BAR; PG8_WAIT_L(0); PG8_MMA(0, 0, At, B0); PG8_BAR; PG8_SCHED;
            PG8_LDB(B1, 0, 1); PG8_STAGE(PG8_SB(0, 0), b2, voffB);
            PG8_BAR; PG8_WAIT_L(0); PG8_MMA(0, 1, At, B1); PG8_BAR;
            PG8_LDA(At, 0, 1); PG8_STAGE(PG8_SA(0, 0), a2, voffA);
            PG8_BAR; PG8_WAIT_L(0); PG8_MMA(1, 0, At, B0); PG8_BAR; PG8_SCHED;
            PG8_STAGE(PG8_SB(0, 1), b2 + hstep, voffB);
            PG8_WAIT_V(6); PG8_BAR; PG8_MMA(1, 1, At, B1); PG8_BAR;
            PG8_LDB(B0, 1, 0); PG8_SCHED; PG8_LDA(At, 1, 0); PG8_STAGE(PG8_SA(0, 1), a2 + hstep, voffA);
            PG8_WAIT_L(8); PG8_BAR; PG8_WAIT_L(0); PG8_MMA(0, 0, At, B0); PG8_BAR; PG8_SCHED;
            PG8_LDB(B1, 1, 1); PG8_STAGE(PG8_SB(1, 0), b3, voffB);
            PG8_BAR; PG8_WAIT_L(0); PG8_MMA(0, 1, At, B1); PG8_BAR;
            PG8_LDA(At, 1, 1); PG8_STAGE(PG8_SA(1, 0), a3, voffA);
            PG8_BAR; PG8_WAIT_L(0); PG8_MMA(1, 0, At, B0); PG8_BAR; PG8_SCHED;
            PG8_STAGE(PG8_SB(1, 1), b3 + hstep, voffB);
            PG8_WAIT_V(6); PG8_BAR; PG8_MMA(1, 1, At, B1); PG8_BAR;
        }
        E(acc, cur, wr, wc, fr, fq);
        if (!has_next) break;
#pragma unroll
        for (int a = 0; a < 2; ++a)
#pragma unroll
            for (int b = 0; b < 2; ++b)
#pragma unroll
                for (int m = 0; m < 4; ++m)
#pragma unroll
                    for (int n = 0; n < 2; ++n) acc[a][b][m][n] = (f32x4){0.f, 0.f, 0.f, 0.f};
        cur = nxt; cA = nA; cB = nB; ++ui;
    }
    PG8_WAIT_V(0);
    if (wr == 0) PG8_BAR;
    PG8_BAR;
#undef PG8_SA
#undef PG8_SB
#undef PG8_STAGE
#undef PG8_LDA
#undef PG8_LDB
#undef PG8_MMA
#undef PG8_WAIT_V
#undef PG8_WAIT_L
#undef PG8_BAR
#undef PG8_SCHED
}
#define PG8_FOREACH(body) \
    _Pragma("unroll") for (int ai = 0; ai < 2; ++ai) _Pragma("unroll") for (int m = 0; m < 4; ++m) { const int row = u.pm * 256 + ai * 128 + wr * 64 + m * 16 + fr; \
    _Pragma("unroll") for (int bj = 0; bj < 2; ++bj) _Pragma("unroll") for (int n = 0; n < 2; ++n) { const int col = u.pn * 256 + bj * 128 + wc * 32 + n * 16 + fq * 4; f32x4 a = acc[ai][bj][m][n]; body } }
struct EStoreBf16 {
    bf16_t* C; int ldc; int ncols;
    __device__ __forceinline__ void operator()(const f32x4 (&acc)[2][2][4][2], const Unit& u, int wr, int wc, int fr, int fq) const {
        const int nbj = (u.pn * 256 + 256 <= ncols) ? 2 : 1;
#pragma unroll
        for (int ai = 0; ai < 2; ++ai)
#pragma unroll
            for (int m = 0; m < 4; ++m) { const int row = u.pm * 256 + ai * 128 + wr * 64 + m * 16 + fr;
                for (int bj = 0; bj < nbj; ++bj)
#pragma unroll
                    for (int n = 0; n < 2; ++n) { const int col = u.pn * 256 + bj * 128 + wc * 32 + n * 16 + fq * 4; const f32x4 a = acc[ai][bj][m][n];
                        uint2 pk; pk.x = pack2bf(a.x, a.y); pk.y = pack2bf(a.z, a.w); *(uint2*)(C + (size_t)row * ldc + col) = pk; } }
    }
};
struct EHgrn {
    bf16_t* C; const float* lb;
    __device__ __forceinline__ void operator()(const f32x4 (&acc)[2][2][4][2], const Unit& u, int wr, int wc, int fr, int fq) const {
        const int blk = (u.pn * 256) >> 10;
        PG8_FOREACH( uint2 pk;
            if (blk == 1) { const f32x4 l = *(const f32x4*)(lb + (col - 1024));
                a.x = (1.f - l.x) * sigmoidf_(-a.x); a.y = (1.f - l.y) * sigmoidf_(-a.y); a.z = (1.f - l.z) * sigmoidf_(-a.z); a.w = (1.f - l.w) * sigmoidf_(-a.w);
                pk.x = (unsigned)f2h(a.x) | ((unsigned)f2h(a.y) << 16); pk.y = (unsigned)f2h(a.z) | ((unsigned)f2h(a.w) << 16);
            } else { if (blk == 3) { a.x = siluf_(a.x); a.y = siluf_(a.y); a.z = siluf_(a.z); a.w = siluf_(a.w); }
                pk.x = pack2bf(a.x, a.y); pk.y = pack2bf(a.z, a.w); }
            *(uint2*)(C + (size_t)row * 4096 + col) = pk; )
    }
};
struct EGmlp {
    bf16_t* C;
    __device__ __forceinline__ void operator()(const f32x4 (&acc)[2][2][4][2], const Unit& u, int wr, int wc, int fr, int fq) const {
        const int blk = (u.pn * 256) >> 10;
        PG8_FOREACH( if (blk == 2) { a.x = siluf_(a.x); a.y = siluf_(a.y); a.z = siluf_(a.z); a.w = siluf_(a.w); }
            uint2 pk; pk.x = pack2bf(a.x, a.y); pk.y = pack2bf(a.z, a.w); *(uint2*)(C + (size_t)row * 3072 + col) = pk; )
    }
};
struct EResid {
    const float* R; float* O;
    __device__ __forceinline__ void operator()(const f32x4 (&acc)[2][2][4][2], const Unit& u, int wr, int wc, int fr, int fq) const {
        PG8_FOREACH( const size_t o = (size_t)row * 1024 + col; const f32x4 r = *(const f32x4*)(R + o); *(f32x4*)(O + o) = r + a; )
    }
};
struct EConv {
    bf16_t* Yc; bf16_t* U;
    __device__ __forceinline__ void operator()(const f32x4 (&acc)[2][2][4][2], const Unit& u, int wr, int wc, int fr, int fq) const {
        const int ch = u.pn * 64 + wc * 16 + fq * 4;
#pragma unroll
        for (int ai = 0; ai < 2; ++ai)
#pragma unroll
            for (int m = 0; m < 4; ++m) {
                const int row = u.pm * 256 + ai * 128 + wr * 64 + m * 16 + fr;
                const f32x4 b = acc[ai][0][m][0], c = acc[ai][0][m][1], z = acc[ai][1][m][0], g = acc[ai][1][m][1];
                const size_t o = (size_t)row * 1024 + ch;
                uint2 py, pu;
                py.x = pack2bf(c.x * z.x, c.y * z.y); py.y = pack2bf(c.z * z.z, c.w * z.w);
                pu.x = pack2bf(b.x * siluf_(g.x), b.y * siluf_(g.y)); pu.y = pack2bf(b.z * siluf_(g.z), b.w * siluf_(g.w));
                *(uint2*)(Yc + o) = py; *(uint2*)(U + o) = pu;
            }
    }
};
template <class Epi>
__device__ __forceinline__ void run(char* smem, const bf16_t* A, const bf16_t* Bt, int N, const Epi& E) {
    StaticOrder S; S.init(M_TOK, N, (int)gridDim.x, (int)blockIdx.x);
    gemm_phase((PG8_LAS unsigned char*)smem, Gemm{A, Bt, M_TOK, N, 1024}, S, E);
    __syncthreads();
}
}

__device__ __forceinline__ void rwkv_lin_phase(const bf16_t* P, const float* __restrict__ mu, bf16_t* Lin) {
    const int gtid = blockIdx.x * NTHREADS + otid(), gsz = gridDim.x * NTHREADS;
    for (int idx = gtid; idx < M_TOK * 64; idx += gsz) {
        const int tok = idx >> 6, cp = (idx & 63) * 2, col = 3072 + cp;
        const unsigned pc = *(const unsigned*)(P + (size_t)tok * RW_COLS + col);
        unsigned pp = 0u;
        if ((tok & (SEQ_T - 1)) != 0) pp = *(const unsigned*)(P + (size_t)(tok - 1) * RW_COLS + col);
        const float m0 = mu[col], m1 = mu[col + 1];
        float x0 = bflo(pc) + (bflo(pp) - bflo(pc)) * m0;
        float x1 = bfhi(pc) + (bfhi(pp) - bfhi(pc)) * m1;
        if (cp < 64) { x0 = tanhf(x0); x1 = tanhf(x1); }
        *(unsigned*)(Lin + (size_t)tok * 128 + cp) = pack2bf(x0, x1);
    }
}

constexpr int RW_TC = 32;
typedef float f32x2 __attribute__((ext_vector_type(2)));
struct RwRaw { uint2 cr, ck, cv, pr, pk, pv, a; f32x4 w; };
__device__ __forceinline__ RwRaw rw_load_raw(const bf16_t* P, const float* Wd, const unsigned short* Ai, size_t tokbase, int t, int hcol) {
    RwRaw r;
    const size_t tok = tokbase + t;
    const bf16_t* pr = P + tok * RW_COLS + hcol;
    r.cr = *(const uint2*)(pr); r.ck = *(const uint2*)(pr + 1024); r.cv = *(const uint2*)(pr + 2048);
    { const bf16_t* pp = (t > 0) ? pr - RW_COLS : pr; r.pr = *(const uint2*)(pp); r.pk = *(const uint2*)(pp + 1024); r.pv = *(const uint2*)(pp + 2048);
      const unsigned msk = (t > 0) ? 0xFFFFFFFFu : 0u; r.pr.x &= msk; r.pr.y &= msk; r.pk.x &= msk; r.pk.y &= msk; r.pv.x &= msk; r.pv.y &= msk; }
    r.w = *(const f32x4*)(Wd + tok * 1024 + hcol);
    r.a = *(const uint2*)(Ai + tok * 1024 + hcol);
    return r;
}
__device__ __forceinline__ void rw_process(const RwRaw& x, const f32x4 mur, const f32x4 muk, const f32x4 muv, const f32x4 kkc, const f32x4 kac, float* d) {
    f32x4 rc = {bflo(x.cr.x), bfhi(x.cr.x), bflo(x.cr.y), bfhi(x.cr.y)}, rp = {bflo(x.pr.x), bfhi(x.pr.x), bflo(x.pr.y), bfhi(x.pr.y)};
    f32x4 kc = {bflo(x.ck.x), bfhi(x.ck.x), bflo(x.ck.y), bfhi(x.ck.y)}, kp = {bflo(x.pk.x), bfhi(x.pk.x), bflo(x.pk.y), bfhi(x.pk.y)};
    f32x4 vc = {bflo(x.cv.x), bfhi(x.cv.x), bflo(x.cv.y), bfhi(x.cv.y)}, vp = {bflo(x.pv.x), bfhi(x.pv.x), bflo(x.pv.y), bfhi(x.pv.y)};
    const f32x4 a = {h2f((unsigned short)(x.a.x & 0xFFFFu)), h2f((unsigned short)(x.a.x >> 16)), h2f((unsigned short)(x.a.y & 0xFFFFu)), h2f((unsigned short)(x.a.y >> 16))};
    const f32x4 r1 = rc + (rp - rc) * mur, k1 = kc + (kp - kc) * muk, v1 = vc + (vp - vc) * muv;
    const f32x4 kkv = k1 * kkc;
    float n2 = kkv.x * kkv.x + kkv.y * kkv.y + kkv.z * kkv.z + kkv.w * kkv.w;
    n2 = sum16(n2);
    const float inv = rsqrtf(fmaxf(n2, 1e-24f));
    const f32x4 kk = kkv * inv;
    const f32x4 k2 = k1 * (1.f + (a - 1.f) * kac);
    *(f32x4*)(d) = r1; *(f32x4*)(d + 64) = x.w; *(f32x4*)(d + 128) = k2; *(f32x4*)(d + 192) = v1; *(f32x4*)(d + 256) = -kk; *(f32x4*)(d + 320) = kk * a;
}
__device__ __forceinline__ void rwkv_scan_phase(const Params& p, char* smem) {
    float* buf = (float*)smem;
    const bf16_t* P = (const bf16_t*)(p.ws + OFF_P);
    const float* Wd = (const float*)(p.ws + OFF_X);
    const unsigned short* Ai = (const unsigned short*)(p.ws + OFF_Y);
    float* Y = p.out;
    const float* mu = p.in[4]; const float* k_k = p.in[9]; const float* k_a = p.in[10];
    const int tid = otid(), lane = tid & 63, wid = __builtin_amdgcn_readfirstlane(tid >> 6);
    constexpr int NCH = SEQ_T / RW_TC;
    const int sub = lane >> 4, q = lane & 15;
    for (int unit = blockIdx.x; unit < 256; unit += gridDim.x) {
        const int bh = unit >> 2, rg = unit & 3, b = bh >> 4, h = bh & 15;
        const size_t tokbase = (size_t)b * SEQ_T;
        __syncthreads();
        if (wid >= 4) {
            const int hcol = h * 64 + q * 4, lw = wid - 4;
            const f32x4 mur = *(const f32x4*)(mu + hcol), muk = *(const f32x4*)(mu + 1024 + hcol), muv = *(const f32x4*)(mu + 2048 + hcol);
            const f32x4 kkc = *(const f32x4*)(k_k + hcol), kac = *(const f32x4*)(k_a + hcol);
            const int tl0 = lw * 4 + sub, tl1 = 16 + lw * 4 + sub;
            RwRaw x0 = rw_load_raw(P, Wd, Ai, tokbase, tl0, hcol), x1 = rw_load_raw(P, Wd, Ai, tokbase, tl1, hcol);
            for (int c = -1; c < NCH; ++c) {
                if (c + 1 < NCH) {
                    const int cn = c + 1; float* db = buf + (cn & 1) * (RW_TC * 384) + q * 4;
                    rw_process(x0, mur, muk, muv, kkc, kac, db + tl0 * 384);
                    rw_process(x1, mur, muk, muv, kkc, kac, db + tl1 * 384);
                    { const int cl = (cn + 1 < NCH) ? cn + 1 : cn; x0 = rw_load_raw(P, Wd, Ai, tokbase, cl * RW_TC + tl0, hcol); x1 = rw_load_raw(P, Wd, Ai, tokbase, cl * RW_TC + tl1, hcol); }
                }
                __syncthreads();
            }
        } else {
            f32x2 Sa = {0.f, 0.f}, Sb = {0.f, 0.f};
            const int rowl = wid * 4 + sub;
            float* ybase = Y + tokbase * 1024 + h * 64 + rg * 16 + rowl;
            __syncthreads();
            for (int c = 0; c < NCH; ++c) {
                const float* cb = buf + (c & 1) * (RW_TC * 384) + q * 4;
                const float* vb = buf + (c & 1) * (RW_TC * 384) + 192 + rg * 16 + rowl;
                f32x4 r4 = *(const f32x4*)(cb), w4 = *(const f32x4*)(cb + 64), k4 = *(const f32x4*)(cb + 128), a4 = *(const f32x4*)(cb + 256), b4 = *(const f32x4*)(cb + 320);
                float vv = vb[0];
                float ykeep = 0.f;
#pragma unroll
                for (int tl = 0; tl < RW_TC; ++tl) {
                    f32x4 nr = r4, nw = w4, nk = k4, na = a4, nb = b4; float nv = vv;
                    if (tl + 1 < RW_TC) {
                        const float* s = cb + (tl + 1) * 384;
                        nr = *(const f32x4*)(s); nw = *(const f32x4*)(s + 64); nk = *(const f32x4*)(s + 128); na = *(const f32x4*)(s + 256); nb = *(const f32x4*)(s + 320);
                        nv = vb[(tl + 1) * 384];
                    }
                    __builtin_amdgcn_sched_barrier(0);
                    f32x2 pa = Sa * (f32x2){a4.x, a4.y};
                    pa = __builtin_elementwise_fma(Sb, (f32x2){a4.z, a4.w}, pa);
                    const float sa = sum16(pa.x + pa.y);
                    const f32x2 ta = __builtin_elementwise_fma((f32x2){k4.x, k4.y}, (f32x2){vv, vv}, (f32x2){b4.x, b4.y} * sa);
                    const f32x2 tb = __builtin_elementwise_fma((f32x2){k4.z, k4.w}, (f32x2){vv, vv}, (f32x2){b4.z, b4.w} * sa);
                    Sa = __builtin_elementwise_fma(Sa, (f32x2){w4.x, w4.y}, ta);
                    Sb = __builtin_elementwise_fma(Sb, (f32x2){w4.z, w4.w}, tb);
                    f32x2 py = Sa * (f32x2){r4.x, r4.y};
                    py = __builtin_elementwise_fma(Sb, (f32x2){r4.z, r4.w}, py);
                    const float y = sum16(py.x + py.y);
                    ykeep = (q == (tl & 15)) ? y : ykeep;
                    if ((tl & 15) == 15) ybase[(size_t)(c * RW_TC + (tl - 15) + q) * 1024] = ykeep;
                    __builtin_amdgcn_sched_barrier(0);
                    r4 = nr; w4 = nw; k4 = nk; a4 = na; b4 = nb; vv = nv;
                }
                __syncthreads();
            }
        }
    }
}

constexpr int RC = 16, RNCH = SEQ_T / RC;
constexpr int RS_AT = 0, RS_RT = 2048, RS_BKT = 4096, RS_AKP = 8192, RS_BRP = 9216, RS_TP = 10240, RS_VT = 11264, RS_WC = 11776, RS_SLOT = 12032;
constexpr int RS_SCR = 8 * RS_SLOT, RS_ST = RS_SCR + 7 * 4096;
static_assert(RS_ST + 16 * 72 * 2 + 128 <= LDS_STAGE, "rwkv chunk LDS overflow");
__device__ __forceinline__ float wave_sum64(float x) {
    x = sum16(x);
    unsigned xi = __float_as_uint(x);
    const auto r = __builtin_amdgcn_permlane16_swap(xi, xi, false, false);
    x = __uint_as_float(r[0]) + __uint_as_float(r[1]);
    xi = __float_as_uint(x);
    const auto r2 = __builtin_amdgcn_permlane32_swap(xi, xi, false, false);
    return __uint_as_float(r2[0]) + __uint_as_float(r2[1]);
}
__device__ __forceinline__ bf16x8 mk_frag(unsigned a, unsigned b, unsigned c, unsigned d) { const uint4 u = make_uint4(a, b, c, d); return __builtin_bit_cast(bf16x8, u); }
template <int L0, int L1>
__device__ __forceinline__ void rw_pair(float& acc0, float& acc1, int g0, int g1, float tr0, float tr1) {
    int t0, t1;
    asm volatile("v_readlane_b32 %2, %4, %8\n\tv_readlane_b32 %3, %5, %9\n\tv_fmac_f32 %0, %2, %6\n\tv_fmac_f32 %1, %3, %7"
                 : "+v"(acc0), "+v"(acc1), "=&s"(t0), "=&s"(t1) : "v"(g0), "v"(g1), "v"(tr0), "v"(tr1), "n"(L0), "n"(L1));
}
template <int L>
__device__ __forceinline__ float rw_nfetch(int g, float dep) {
    int r;
    asm volatile("v_readlane_b32 %0, %1, %2\n\ts_nop 0" : "=s"(r) : "v"(g), "n"(L), "v"(dep));
    return __int_as_float(r);
}
struct RwStg {
    float W, pr, pk, pv;
    float bt[16], kt[16];
    unsigned short nr[4], nk[4], nv[4], na[4]; float nw[4];
    unsigned short ppr, ppk, ppv;
    int gx, gy, gz, gw;
};
__device__ __forceinline__ void rwkv_chunk_phase(const Params& p, char* smem) {
    const bf16_t* P = (const bf16_t*)(p.ws + OFF_P);
    const float* Wd = (const float*)(p.ws + OFF_X);
    const unsigned short* Ai = (const unsigned short*)(p.ws + OFF_Y);
    float* Y = p.out;
    const float* mu = p.in[4]; const float* k_k = p.in[9]; const float* k_a = p.in[10];
    const int tid = otid(), lane = tid & 63, wid = __builtin_amdgcn_readfirstlane(tid >> 6), fr = lane & 15, fq = lane >> 4;
    for (int unit = blockIdx.x; unit < 256; unit += gridDim.x) {
        const int bh = unit >> 2, rg = unit & 3, b = bh >> 4, h = bh & 15;
        const size_t tokbase = (size_t)b * SEQ_T;
        __syncthreads();
        f32x4 accS[4];
#pragma unroll
        for (int i = 0; i < 4; ++i) accS[i] = (f32x4){0.f, 0.f, 0.f, 0.f};
        RwStg st; st.W = 1.f; st.pr = 0.f; st.pk = 0.f; st.pv = 0.f;
        const int col = h * 64 + lane;
        const float mur = mu[col], muk = mu[1024 + col], muv = mu[2048 + col], kkc = k_k[col], kac = k_a[col];
        const int sw = wid - 1;
        bf16_t* BTs = (bf16_t*)(smem + RS_SCR + (sw < 0 ? 0 : sw) * 4096);
        bf16_t* KTs = BTs + 1024;
        const bf16_t* Pl = P + tokbase * RW_COLS + col; const float* Wl = Wd + tokbase * 1024 + col; const unsigned short* Al = Ai + tokbase * 1024 + col;
#define RW_LD(S, TOK) do { const unsigned tr_ = (unsigned)__builtin_amdgcn_readfirstlane((int)((TOK) - tokbase)); const bf16_t* pr_ = Pl + tr_ * (unsigned)RW_COLS; st.nr[S] = pr_[0]; st.nk[S] = pr_[1024]; st.nv[S] = pr_[2048]; \
            st.nw[S] = Wl[tr_ * 1024u]; st.na[S] = Al[tr_ * 1024u]; } while (0)
#define RW_LDPREV(CH) do { const int ch_ = (CH); const unsigned tr_ = (unsigned)__builtin_amdgcn_readfirstlane(ch_ > 0 ? ch_ * RC - 1 : 0); const bf16_t* pp_ = Pl + tr_ * (unsigned)RW_COLS; \
            st.ppr = pp_[0]; st.ppk = pp_[1024]; st.ppv = pp_[2048]; } while (0)
        if (wid == 0) {
            for (int i = lane; i < 16 * 72 / 2; i += 64) *(unsigned*)(smem + RS_ST + i * 4) = 0u;
        } else {
            const int c0 = (sw < RNCH) ? sw : RNCH - 1;
            RW_LD(0, tokbase + (size_t)c0 * RC + 0); RW_LD(1, tokbase + (size_t)c0 * RC + 1); RW_LD(2, tokbase + (size_t)c0 * RC + 2); RW_LD(3, tokbase + (size_t)c0 * RC + 3); RW_LDPREV(c0);
        }
        __syncthreads();
        if (wid == 0) {
            for (int per = 0; per < RNCH + 7; ++per) {
                const int c = per - 7;
                if (c >= 0) {
                    const char* sl = smem + (c & 7) * RS_SLOT;
                    const bf16_t* STr = (const bf16_t*)(smem + RS_ST) + fr * 72 + fq * 8;
                    const bf16x8 st0 = *(const bf16x8*)(STr), st1 = *(const bf16x8*)(STr + 32);
                    const bf16_t* ATr = (const bf16_t*)(sl + RS_AT) + fr * 64 + fq * 8;
                    const bf16x8 a0 = *(const bf16x8*)(ATr), a1 = *(const bf16x8*)(ATr + 32);
                    const bf16_t* RTr = (const bf16_t*)(sl + RS_RT) + fr * 64 + fq * 8;
                    const bf16x8 r0 = *(const bf16x8*)(RTr), r1 = *(const bf16x8*)(RTr + 32);
                    const bf16x8 akp = *(const bf16x8*)((const bf16_t*)(sl + RS_AKP) + fr * 32 + fq * 8);
                    const bf16x8 brp = *(const bf16x8*)((const bf16_t*)(sl + RS_BRP) + fr * 32 + fq * 8);
                    const bf16x8 tpf = *(const bf16x8*)((const bf16_t*)(sl + RS_TP) + fr * 32 + fq * 8);
                    const uint2 vt = *(const uint2*)((const bf16_t*)(sl + RS_VT) + fr * 16 + fq * 4);
                    bf16x8 bk[4]; f32x4 wc4[4];
#pragma unroll
                    for (int kt = 0; kt < 4; ++kt) { bk[kt] = *(const bf16x8*)((const bf16_t*)(sl + RS_BKT) + (kt * 16 + fr) * 32 + fq * 8); wc4[kt] = *(const f32x4*)((const float*)(sl + RS_WC) + kt * 16 + fq * 4); }
                    f32x4 u = {0.f, 0.f, 0.f, 0.f};
                    u = __builtin_amdgcn_mfma_f32_16x16x32_bf16(a0, st0, u, 0, 0, 0);
                    u = __builtin_amdgcn_mfma_f32_16x16x32_bf16(a1, st1, u, 0, 0, 0);
                    u = __builtin_amdgcn_mfma_f32_16x16x32_bf16(akp, mk_frag(vt.x, vt.y, 0u, 0u), u, 0, 0, 0);
                    f32x4 sv = {0.f, 0.f, 0.f, 0.f};
                    sv = __builtin_amdgcn_mfma_f32_16x16x32_bf16(tpf, mk_frag(pack2bf(u.x, u.y), pack2bf(u.z, u.w), 0u, 0u), sv, 0, 0, 0);
                    const bf16x8 f3 = mk_frag(pack2bf(sv.x, sv.y), pack2bf(sv.z, sv.w), vt.x, vt.y);
                    f32x4 yv = {0.f, 0.f, 0.f, 0.f};
                    yv = __builtin_amdgcn_mfma_f32_16x16x32_bf16(st0, r0, yv, 0, 0, 0);
                    yv = __builtin_amdgcn_mfma_f32_16x16x32_bf16(st1, r1, yv, 0, 0, 0);
                    yv = __builtin_amdgcn_mfma_f32_16x16x32_bf16(f3, brp, yv, 0, 0, 0);
                    *(f32x4*)(Y + (tokbase + (size_t)c * RC + fr) * 1024 + h * 64 + rg * 16 + fq * 4) = yv;
#pragma unroll
                    for (int kt = 0; kt < 4; ++kt) {
                        accS[kt] = accS[kt] * wc4[kt];
                        accS[kt] = __builtin_amdgcn_mfma_f32_16x16x32_bf16(bk[kt], f3, accS[kt], 0, 0, 0);
                        uint2 pk; pk.x = pack2bf(accS[kt].x, accS[kt].y); pk.y = pack2bf(accS[kt].z, accS[kt].w);
                        *(uint2*)((bf16_t*)(smem + RS_ST) + fr * 72 + kt * 16 + fq * 4) = pk;
                    }
                }
                __syncthreads();
            }
        } else {
            for (int per = 0; per < RNCH + 7; ++per) {
                const int q = per - sw;
                const int c = (q >= 0) ? 7 * (q / 7) + sw : RNCH;
                if (c < RNCH) {
                    const int part = q % 7;
                    char* sl = smem + (c & 7) * RS_SLOT;
                    bf16_t* ATw = (bf16_t*)(sl + RS_AT); bf16_t* RTw = (bf16_t*)(sl + RS_RT);
                    const size_t tok0 = tokbase + (size_t)c * RC;
                    unsigned short cr[4], ck[4], cv[4], ca[4]; float cw[4];
#pragma unroll
                    for (int i = 0; i < 4; ++i) { cr[i] = st.nr[i]; ck[i] = st.nk[i]; cv[i] = st.nv[i]; ca[i] = st.na[i]; cw[i] = st.nw[i]; }
#define RW_TS(J, S) do { const float r0_ = bf2f(cr[S]), k0_ = bf2f(ck[S]), v0_ = bf2f(cv[S]); const float w_ = cw[S], a_ = h2f(ca[S]); \
                        const float r1_ = r0_ + (st.pr - r0_) * mur, k1_ = k0_ + (st.pk - k0_) * muk, v1_ = v0_ + (st.pv - v0_) * muv; st.pr = r0_; st.pk = k0_; st.pv = v0_; \
                        const float kkv_ = k1_ * kkc; const float n2_ = wave_sum64(kkv_ * kkv_); const float kk_ = kkv_ * rsqrtf(fmaxf(n2_, 1e-24f)); \
                        const float k2_ = k1_ * (1.f + (a_ - 1.f) * kac); \
                        const float at_ = -kk_ * st.W; st.W *= w_; const float rt_ = r1_ * st.W; const float iw_ = __builtin_amdgcn_rcpf(st.W); \
                        const float bt_ = kk_ * a_ * iw_, kt_ = k2_ * iw_; st.bt[J] = bt_; st.kt[J] = kt_; \
                        ATw[(J) * 64 + lane] = f2bf(at_); RTw[(J) * 64 + lane] = f2bf(rt_); BTs[(J) * 64 + lane] = f2bf(bt_); KTs[(J) * 64 + lane] = f2bf(kt_); \
                        *((fq == rg) ? ((bf16_t*)(sl + RS_VT) + fr * 16 + (J)) : ((bf16_t*)(smem + RS_ST + 2304) + lane)) = f2bf(v1_); } while (0)
                    switch (part) {
                    case 0: {
                        RW_LD(0, tok0 + 4); RW_LD(1, tok0 + 5); RW_LD(2, tok0 + 6); RW_LD(3, tok0 + 7);
                        st.W = 1.f;
                        if (c > 0) { st.pr = bf2f(st.ppr); st.pk = bf2f(st.ppk); st.pv = bf2f(st.ppv); } else { st.pr = 0.f; st.pk = 0.f; st.pv = 0.f; }
                        RW_TS(0, 0); RW_TS(1, 1); RW_TS(2, 2); RW_TS(3, 3);
                    } break;
                    case 1: { RW_LD(0, tok0 + 8); RW_LD(1, tok0 + 9); RW_LD(2, tok0 + 10); RW_LD(3, tok0 + 11); RW_TS(4, 0); RW_TS(5, 1); RW_TS(6, 2); RW_TS(7, 3); } break;
                    case 2: { RW_LD(0, tok0 + 12); RW_LD(1, tok0 + 13); RW_LD(2, tok0 + 14); RW_LD(3, tok0 + 15); RW_TS(8, 0); RW_TS(9, 1); RW_TS(10, 2); RW_TS(11, 3); } break;
                    case 3: {
                        RW_TS(12, 0); RW_TS(13, 1); RW_TS(14, 2); RW_TS(15, 3);
                        const float WC = st.W;
                        ((float*)(sl + RS_WC))[lane] = WC;
                        bf16_t* BKw = (bf16_t*)(sl + RS_BKT) + lane * 32;
#define RW_BKG(G) do { uint4 o; \
                            o.x = pack2bf(st.bt[4 * (G) + 0] * WC, st.bt[4 * (G) + 1] * WC); o.y = pack2bf(st.bt[4 * (G) + 2] * WC, st.bt[4 * (G) + 3] * WC); \
                            o.z = pack2bf(st.kt[4 * (G) + 0] * WC, st.kt[4 * (G) + 1] * WC); o.w = pack2bf(st.kt[4 * (G) + 2] * WC, st.kt[4 * (G) + 3] * WC); \
                            *(uint4*)(BKw + (G) * 8) = o; } while (0)
                        RW_BKG(0); RW_BKG(1); RW_BKG(2); RW_BKG(3);
#undef RW_BKG
                    } break;
                    case 4: {
                        const bf16_t* ATr = ATw + fr * 64 + fq * 8; const bf16_t* RTr = RTw + fr * 64 + fq * 8; const bf16_t* BTr = BTs + fr * 64 + fq * 8; const bf16_t* KTr = KTs + fr * 64 + fq * 8;
                        const bf16x8 a0 = *(const bf16x8*)(ATr), a1 = *(const bf16x8*)(ATr + 32), r0 = *(const bf16x8*)(RTr), r1 = *(const bf16x8*)(RTr + 32);
                        const bf16x8 b0 = *(const bf16x8*)(BTr), b1 = *(const bf16x8*)(BTr + 32), k0 = *(const bf16x8*)(KTr), k1 = *(const bf16x8*)(KTr + 32);
                        f32x4 gab = {0.f, 0.f, 0.f, 0.f}, gak = gab, grb = gab, grk = gab;
                        gab = __builtin_amdgcn_mfma_f32_16x16x32_bf16(b0, a0, gab, 0, 0, 0); gab = __builtin_amdgcn_mfma_f32_16x16x32_bf16(b1, a1, gab, 0, 0, 0);
                        gak = __builtin_amdgcn_mfma_f32_16x16x32_bf16(k0, a0, gak, 0, 0, 0); gak = __builtin_amdgcn_mfma_f32_16x16x32_bf16(k1, a1, gak, 0, 0, 0);
                        grb = __builtin_amdgcn_mfma_f32_16x16x32_bf16(b0, r0, grb, 0, 0, 0); grb = __builtin_amdgcn_mfma_f32_16x16x32_bf16(b1, r1, grb, 0, 0, 0);
                        grk = __builtin_amdgcn_mfma_f32_16x16x32_bf16(k0, r0, grk, 0, 0, 0); grk = __builtin_amdgcn_mfma_f32_16x16x32_bf16(k1, r1, grk, 0, 0, 0);
                        const int j0 = fq * 4;
                        gab.x = (j0 + 0 < fr) ? gab.x : 0.f; gab.y = (j0 + 1 < fr) ? gab.y : 0.f; gab.z = (j0 + 2 < fr) ? gab.z : 0.f; gab.w = (j0 + 3 < fr) ? gab.w : 0.f;
                        gak.x = (j0 + 0 < fr) ? gak.x : 0.f; gak.y = (j0 + 1 < fr) ? gak.y : 0.f; gak.z = (j0 + 2 < fr) ? gak.z : 0.f; gak.w = (j0 + 3 < fr) ? gak.w : 0.f;
                        grb.x = (j0 + 0 <= fr) ? grb.x : 0.f; grb.y = (j0 + 1 <= fr) ? grb.y : 0.f; grb.z = (j0 + 2 <= fr) ? grb.z : 0.f; grb.w = (j0 + 3 <= fr) ? grb.w : 0.f;
                        grk.x = (j0 + 0 <= fr) ? grk.x : 0.f; grk.y = (j0 + 1 <= fr) ? grk.y : 0.f; grk.z = (j0 + 2 <= fr) ? grk.z : 0.f; grk.w = (j0 + 3 <= fr) ? grk.w : 0.f;
                        *(uint4*)((bf16_t*)(sl + RS_AKP) + fr * 32 + fq * 8) = make_uint4(pack2bf(gak.x, gak.y), pack2bf(gak.z, gak.w), 0u, 0u);
                        *(uint4*)((bf16_t*)(sl + RS_BRP) + fr * 32 + fq * 8) = make_uint4(pack2bf(grb.x, grb.y), pack2bf(grb.z, grb.w), pack2bf(grk.x, grk.y), pack2bf(grk.z, grk.w));
                        st.gx = __float_as_int(gab.x); st.gy = __float_as_int(gab.y); st.gz = __float_as_int(gab.z); st.gw = __float_as_int(gab.w);
                    } break;
#define RW_GSEL(J) ((((J) & 3) == 0) ? st.gx : ((((J) & 3) == 1) ? st.gy : ((((J) & 3) == 2) ? st.gz : st.gw)))
#define RW_TJ(T, J) do { if ((J) < (T)) acc = fmaf(rw_nfetch<(T) + 16 * ((J) >> 2)>(RW_GSEL(J), acc), Tr[(J)], acc); } while (0)
#define RW_TROW(T) do { float acc = ((T) == fr) ? 1.f : 0.f; RW_TJ(T, 0); RW_TJ(T, 1); RW_TJ(T, 2); RW_TJ(T, 3); RW_TJ(T, 4); RW_TJ(T, 5); RW_TJ(T, 6); RW_TJ(T, 7); \
                        RW_TJ(T, 8); RW_TJ(T, 9); RW_TJ(T, 10); RW_TJ(T, 11); RW_TJ(T, 12); RW_TJ(T, 13); RW_TJ(T, 14); RW_TJ(T, 15); Tr[(T)] = acc; } while (0)
                    case 5: {
                        float Tr[16];
                        RW_TROW(0); RW_TROW(1); RW_TROW(2); RW_TROW(3); RW_TROW(4); RW_TROW(5); RW_TROW(6); RW_TROW(7); RW_TROW(8); RW_TROW(9); RW_TROW(10);
                        float* TS_ = (float*)BTs + lane;
#define RW_TSV(T) TS_[(T) * 64] = Tr[(T)]
                        RW_TSV(0); RW_TSV(1); RW_TSV(2); RW_TSV(3); RW_TSV(4); RW_TSV(5); RW_TSV(6); RW_TSV(7); RW_TSV(8); RW_TSV(9); RW_TSV(10);
#undef RW_TSV
                    } break;
                    default: {
                        { const int cn = (c + 7 < RNCH) ? c + 7 : c; const size_t tn = tokbase + (size_t)cn * RC; RW_LD(0, tn + 0); RW_LD(1, tn + 1); RW_LD(2, tn + 2); RW_LD(3, tn + 3); RW_LDPREV(cn); }
                        float Tr[16];
                        const float* TS_ = (const float*)BTs + lane;
#define RW_TLD(T) Tr[(T)] = TS_[(T) * 64]
                        RW_TLD(0); RW_TLD(1); RW_TLD(2); RW_TLD(3); RW_TLD(4); RW_TLD(5); RW_TLD(6); RW_TLD(7); RW_TLD(8); RW_TLD(9); RW_TLD(10);
#undef RW_TLD
                        RW_TROW(11); RW_TROW(12); RW_TROW(13); RW_TROW(14); RW_TROW(15);
                        if (fq < 2) {
                            bf16_t* TPw = (bf16_t*)(sl + RS_TP) + (fr >> 2) * 8 + (fr & 3) + fq * 4;
#define RW_TPW(T) TPw[(T) * 32] = (fq == 0) ? f2bf(Tr[(T)]) : (bf16_t)0
                            RW_TPW(0); RW_TPW(1); RW_TPW(2); RW_TPW(3); RW_TPW(4); RW_TPW(5); RW_TPW(6); RW_TPW(7); RW_TPW(8); RW_TPW(9); RW_TPW(10); RW_TPW(11); RW_TPW(12); RW_TPW(13); RW_TPW(14); RW_TPW(15);
#undef RW_TPW
                        }
                    } break;
#undef RW_TROW
#undef RW_TJ
#undef RW_GSEL
                    }
#undef RW_TS
                }
                __syncthreads();
            }
        }
#undef RW_LD
#undef RW_LDPREV
    }
}

__device__ __forceinline__ float half_sum32(float v);
__device__ __forceinline__ void rwkv_elem_phase(const Params& p) {
    bf16_t* P = (bf16_t*)(p.ws + OFF_P);
    float* Wd = (float*)(p.ws + OFF_X);
    unsigned short* Ai = (unsigned short*)(p.ws + OFF_Y);
    bf16_t* KT2 = (bf16_t*)p.out + (size_t)M_TOK * 1024;
    float* BON = (float*)(p.ws + OFF_LIN);
    const float* mu = p.in[4]; const float* k_k = p.in[9]; const float* k_a = p.in[10]; const float* r_k = p.in[11];
    const int tid = otid(), lane = tid & 63, wid = __builtin_amdgcn_readfirstlane(tid >> 6);
    const int gw = blockIdx.x * 8 + wid, ngw = gridDim.x * 8;
    for (int u = gw; u < 64 * RNCH; u += ngw) {
        const int bh = u >> 9, c = u & (RNCH - 1), b = bh >> 4, h = bh & 15, col = h * 64 + lane;
        const size_t tok0 = (size_t)b * SEQ_T + (size_t)c * RC;
        const float mur = mu[col], muk = mu[1024 + col], kkc = k_k[col], kac = k_a[col], rkc = r_k[col];
        unsigned short rr[16], rk[16], ra[16]; float rw[16];
        const bf16_t* pr = P + tok0 * RW_COLS + col;
        const bf16_t* pp = (c > 0) ? pr - RW_COLS : pr;
        const unsigned short p0r = pp[0], p0k = pp[1024];
#pragma unroll
        for (int j = 0; j < 16; ++j) { rr[j] = pr[(size_t)j * RW_COLS]; rk[j] = pr[(size_t)j * RW_COLS + 1024]; rw[j] = Wd[(tok0 + j) * 1024 + col]; ra[j] = Ai[(tok0 + j) * 1024 + col]; }
        asm volatile("s_waitcnt vmcnt(0)" ::: "memory");
        float W = 1.f, prv = (c > 0) ? bf2f(p0r) : 0.f, pkv = (c > 0) ? bf2f(p0k) : 0.f;
#pragma unroll
        for (int j = 0; j < 16; ++j) {
            const float r0 = bf2f(rr[j]), k0 = bf2f(rk[j]), w = rw[j], a = h2f(ra[j]);
            const float r1 = r0 + (prv - r0) * mur, k1 = k0 + (pkv - k0) * muk; prv = r0; pkv = k0;
            const float kkv = k1 * kkc; const float n2 = wave_sum64(kkv * kkv); const float kk = kkv * rsqrtf(fmaxf(n2, 1e-24f));
            const float k2 = k1 * (1.f + (a - 1.f) * kac);
            const float bon = wave_sum64(r1 * k2 * rkc);
            const float at = -kk * W; W *= w; const float rt = r1 * W; const float iw = __builtin_amdgcn_rcpf(W);
            const float bt = kk * a * iw, kt = k2 * iw;
            bf16_t* ar = (bf16_t*)(Wd + (tok0 + j) * 1024 + h * 64);
            ar[lane] = f2bf(at); ar[64 + lane] = f2bf(rt);
            Ai[(tok0 + j) * 1024 + col] = f2bf(bt);
            KT2[(tok0 + j) * 1024 + col] = f2bf(kt);
            if (lane == 0) BON[(tok0 + j) * 16 + h] = bon;
        }
        ((float*)(P + (tok0 + h) * RW_COLS + 3072))[lane] = W;
    }
}
#ifndef XLAS
#define XLAS __attribute__((address_space(3)))
#endif
struct RwStg2 { int gx, gy, gz, gw; };
__device__ __forceinline__ void rwkv_chunk2_phase(const Params& p, char* smem) {
    const bf16_t* P = (const bf16_t*)(p.ws + OFF_P);
    const char* WdB = (const char*)(p.ws + OFF_X);
    const bf16_t* BT2 = (const bf16_t*)(p.ws + OFF_Y);
    const bf16_t* KT2 = (const bf16_t*)p.out + (size_t)M_TOK * 1024;
    bf16_t* Yb = (bf16_t*)p.out;
    const float* mu = p.in[4];
    const int tid = otid(), lane = tid & 63, wid = __builtin_amdgcn_readfirstlane(tid >> 6), fr = lane & 15, fq = lane >> 4;
    for (int unit = blockIdx.x; unit < 256; unit += gridDim.x) {
        const int xcd_ = unit & 7, idx_ = unit >> 3;
        const int bh = xcd_ * 8 + (idx_ >> 2), rg = idx_ & 3, b = bh >> 4, h = bh & 15;
        const size_t tokbase = (size_t)b * SEQ_T;
        __syncthreads();
        f32x4 accS[4];
#pragma unroll
        for (int i = 0; i < 4; ++i) accS[i] = (f32x4){0.f, 0.f, 0.f, 0.f};
        RwStg2 st; st.gx = 0; st.gy = 0; st.gz = 0; st.gw = 0;
        const int sw = wid - 1;
        const int scr_off = RS_SCR + (sw < 0 ? 0 : sw) * 4096;
        bf16_t* BTs = (bf16_t*)(smem + scr_off);
        bf16_t* KTs = BTs + 1024;
        const float muv = mu[2048 + h * 64 + rg * 16 + fr];
        if (wid == 0) {
            for (int i = lane; i < 16 * 72 / 2; i += 64) *(unsigned*)(smem + RS_ST + i * 4) = 0u;
        }
        __syncthreads();
        if (wid == 0) {
            __builtin_amdgcn_s_setprio(2);
            bf16x8 pa0 = {}, pa1 = {}, pr0 = {}, pr1 = {}, pakp = {}, pbrp = {}; uint2 pvt = make_uint2(0u, 0u); bf16x8 pbk[4] = {}; f32x4 pwc[4] = {};
            for (int per = 0; per < RNCH + 7; ++per) {
                const int c = per - 7;
                if (c >= 0) {
                    const char* sl = smem + (c & 7) * RS_SLOT;
                    const bf16_t* STr = (const bf16_t*)(smem + RS_ST) + fr * 72 + fq * 8;
                    const bf16x8 st0 = *(const bf16x8*)(STr), st1 = *(const bf16x8*)(STr + 32);
                    const bf16x8 tpf = *(const bf16x8*)((const bf16_t*)(sl + RS_TP) + fr * 32 + fq * 8);
                    const bf16x8 a0 = pa0, a1 = pa1, r0 = pr0, r1 = pr1, akp = pakp, brp = pbrp; const uint2 vt = pvt;
                    f32x4 u = {0.f, 0.f, 0.f, 0.f};
                    u = __builtin_amdgcn_mfma_f32_16x16x32_bf16(a0, st0, u, 0, 0, 0);
                    u = __builtin_amdgcn_mfma_f32_16x16x32_bf16(a1, st1, u, 0, 0, 0);
                    u = __builtin_amdgcn_mfma_f32_16x16x32_bf16(akp, mk_frag(vt.x, vt.y, 0u, 0u), u, 0, 0, 0);
                    f32x4 sv = {0.f, 0.f, 0.f, 0.f};
                    sv = __builtin_amdgcn_mfma_f32_16x16x32_bf16(tpf, mk_frag(pack2bf(u.x, u.y), pack2bf(u.z, u.w), 0u, 0u), sv, 0, 0, 0);
                    const bf16x8 f3 = mk_frag(pack2bf(sv.x, sv.y), pack2bf(sv.z, sv.w), vt.x, vt.y);
                    f32x4 yv = {0.f, 0.f, 0.f, 0.f};
                    yv = __builtin_amdgcn_mfma_f32_16x16x32_bf16(st0, r0, yv, 0, 0, 0);
                    yv = __builtin_amdgcn_mfma_f32_16x16x32_bf16(st1, r1, yv, 0, 0, 0);
                    yv = __builtin_amdgcn_mfma_f32_16x16x32_bf16(f3, brp, yv, 0, 0, 0);
                    { uint2 py; py.x = pack2bf(yv.x, yv.y); py.y = pack2bf(yv.z, yv.w); *(uint2*)(Yb + (tokbase + (size_t)c * RC + fr) * 1024 + h * 64 + rg * 16 + fq * 4) = py; }
#pragma unroll
                    for (int kt = 0; kt < 4; ++kt) {
                        accS[kt] = accS[kt] * pwc[kt];
                        accS[kt] = __builtin_amdgcn_mfma_f32_16x16x32_bf16(pbk[kt], f3, accS[kt], 0, 0, 0);
                        uint2 pk; pk.x = pack2bf(accS[kt].x, accS[kt].y); pk.y = pack2bf(accS[kt].z, accS[kt].w);
                        *(uint2*)((bf16_t*)(smem + RS_ST) + fr * 72 + kt * 16 + fq * 4) = pk;
                    }
                }
                if (c + 1 >= 0 && c + 1 < RNCH) {
                    const char* sn = smem + ((c + 1) & 7) * RS_SLOT;
                    const bf16_t* ATr = (const bf16_t*)(sn + RS_AT) + fr * 128;
                    pa0 = *(const bf16x8*)(ATr + ((fq) ^ fr) * 8); pa1 = *(const bf16x8*)(ATr + ((4 + fq) ^ fr) * 8);
                    pr0 = *(const bf16x8*)(ATr + ((8 + fq) ^ fr) * 8); pr1 = *(const bf16x8*)(ATr + ((12 + fq) ^ fr) * 8);
                    pakp = *(const bf16x8*)((const bf16_t*)(sn + RS_AKP) + fr * 32 + fq * 8);
                    pbrp = *(const bf16x8*)((const bf16_t*)(sn + RS_BRP) + fr * 32 + fq * 8);
                    pvt = *(const uint2*)((const bf16_t*)(sn + RS_VT) + fr * 16 + fq * 4);
#pragma unroll
                    for (int kt = 0; kt < 4; ++kt) { pbk[kt] = *(const bf16x8*)((const bf16_t*)(sn + RS_BKT) + (kt * 16 + fr) * 32 + fq * 8); pwc[kt] = *(const f32x4*)((const float*)(sn + RS_WC) + kt * 16 + fq * 4); }
                }
                asm volatile("s_waitcnt lgkmcnt(0)" ::: "memory"); __builtin_amdgcn_s_barrier(); asm volatile("" ::: "memory");
            }
            __builtin_amdgcn_s_setprio(0);
        } else {
            for (int per = 0; per < RNCH + 7; ++per) {
                const int q = per - sw;
                const int c = (q >= 0) ? 7 * (q / 7) + sw : RNCH;
                if (c < RNCH) {
                    const int part = q % 7;
                    const int sl_off = (c & 7) * RS_SLOT;
                    char* sl = smem + sl_off;
                    bf16_t* ATw = (bf16_t*)(sl + RS_AT);
                    switch (part) {
                    case 0: {
                        const size_t t0 = tokbase + (size_t)c * RC;
#pragma unroll
                        for (int i = 0; i < 4; ++i)
                            __builtin_amdgcn_global_load_lds((const unsigned*)(WdB + ((t0 + i * 4 + fq) * 1024 + h * 64) * 4 + (fr ^ (i * 4 + fq)) * 16), (XLAS unsigned*)(smem + sl_off + RS_AT + i * 1024), 16, 0, 0);
#pragma unroll
                        for (int i = 0; i < 2; ++i) {
                            const size_t o = (t0 + i * 8 + (lane >> 3)) * 1024 + h * 64 + (lane & 7) * 8;
                            __builtin_amdgcn_global_load_lds((const unsigned*)(BT2 + o), (XLAS unsigned*)(smem + scr_off + i * 1024), 16, 0, 0);
                            __builtin_amdgcn_global_load_lds((const unsigned*)(KT2 + o), (XLAS unsigned*)(smem + scr_off + 2048 + i * 1024), 16, 0, 0);
                        }
                        __builtin_amdgcn_global_load_lds((const unsigned*)((const float*)(P + (t0 + h) * RW_COLS + 3072) + lane), (XLAS unsigned*)(smem + sl_off + RS_WC), 4, 0, 0);
#pragma unroll
                        for (int i = 0; i < 3; ++i) {
                            const int idx = i * 64 + lane; int row = idx >> 3; row = row > 16 ? 16 : row; const int dwq = idx & 7;
                            int tt = c * RC - 1 + row; tt = tt < 0 ? 0 : tt;
                            __builtin_amdgcn_global_load_lds((const unsigned*)(P + (tokbase + tt) * RW_COLS + 2048 + h * 64 + rg * 16 + dwq * 2), (XLAS unsigned*)(smem + sl_off + RS_TP + i * 256), 4, 0, 0);
                        }
                    } break;
                    case 1: break;
                    case 2: {
                        asm volatile("s_waitcnt vmcnt(0)" ::: "memory");
                    } break;
                    case 3: {
                        { const unsigned short* vr = (const unsigned short*)(sl + RS_TP) + (fq * 4) * 16 + fr;
                          const float pv = (c == 0 && fq == 0) ? 0.f : bf2f(vr[0]);
                          const float v0 = bf2f(vr[16]), v1 = bf2f(vr[32]), v2 = bf2f(vr[48]), v3 = bf2f(vr[64]);
                          uint2 o; o.x = pack2bf(v0 + (pv - v0) * muv, v1 + (v0 - v1) * muv); o.y = pack2bf(v2 + (v1 - v2) * muv, v3 + (v2 - v3) * muv);
                          *(uint2*)((bf16_t*)(sl + RS_VT) + fr * 16 + fq * 4) = o; }
                        const float WC = ((const float*)(sl + RS_WC))[lane];
                        bf16_t* BKw = (bf16_t*)(sl + RS_BKT) + lane * 32;
#define RW_BKG(G) do { uint4 o; \
                            o.x = pack2bf(bf2f(BTs[(4 * (G) + 0) * 64 + lane]) * WC, bf2f(BTs[(4 * (G) + 1) * 64 + lane]) * WC); o.y = pack2bf(bf2f(BTs[(4 * (G) + 2) * 64 + lane]) * WC, bf2f(BTs[(4 * (G) + 3) * 64 + lane]) * WC); \
                            o.z = pack2bf(bf2f(KTs[(4 * (G) + 0) * 64 + lane]) * WC, bf2f(KTs[(4 * (G) + 1) * 64 + lane]) * WC); o.w = pack2bf(bf2f(KTs[(4 * (G) + 2) * 64 + lane]) * WC, bf2f(KTs[(4 * (G) + 3) * 64 + lane]) * WC); \
                            *(uint4*)(BKw + (G) * 8) = o; } while (0)
                        RW_BKG(0); RW_BKG(1); RW_BKG(2); RW_BKG(3);
#undef RW_BKG
                    } break;
                    case 4: {
                        const bf16_t* ATr = ATw + fr * 128; const bf16_t* BTr = BTs + fr * 64 + fq * 8; const bf16_t* KTr = KTs + fr * 64 + fq * 8;
                        const bf16x8 a0 = *(const bf16x8*)(ATr + ((fq) ^ fr) * 8), a1 = *(const bf16x8*)(ATr + ((4 + fq) ^ fr) * 8), r0 = *(const bf16x8*)(ATr + ((8 + fq) ^ fr) * 8), r1 = *(const bf16x8*)(ATr + ((12 + fq) ^ fr) * 8);
                        const bf16x8 b0 = *(const bf16x8*)(BTr), b1 = *(const bf16x8*)(BTr + 32), k0 = *(const bf16x8*)(KTr), k1 = *(const bf16x8*)(KTr + 32);
                        f32x4 gab = {0.f, 0.f, 0.f, 0.f}, gak = gab, grb = gab, grk = gab;
                        gab = __builtin_amdgcn_mfma_f32_16x16x32_bf16(b0, a0, gab, 0, 0, 0); gab = __builtin_amdgcn_mfma_f32_16x16x32_bf16(b1, a1, gab, 0, 0, 0);
                        gak = __builtin_amdgcn_mfma_f32_16x16x32_bf16(k0, a0, gak, 0, 0, 0); gak = __builtin_amdgcn_mfma_f32_16x16x32_bf16(k1, a1, gak, 0, 0, 0);
                        grb = __builtin_amdgcn_mfma_f32_16x16x32_bf16(b0, r0, grb, 0, 0, 0); grb = __builtin_amdgcn_mfma_f32_16x16x32_bf16(b1, r1, grb, 0, 0, 0);
                        grk = __builtin_amdgcn_mfma_f32_16x16x32_bf16(k0, r0, grk, 0, 0, 0); grk = __builtin_amdgcn_mfma_f32_16x16x32_bf16(k1, r1, grk, 0, 0, 0);
                        const int j0 = fq * 4;
                        gab.x = (j0 + 0 < fr) ? gab.x : 0.f; gab.y = (j0 + 1 < fr) ? gab.y : 0.f; gab.z = (j0 + 2 < fr) ? gab.z : 0.f; gab.w = (j0 + 3 < fr) ? gab.w : 0.f;
                        gak.x = (j0 + 0 < fr) ? gak.x : 0.f; gak.y = (j0 + 1 < fr) ? gak.y : 0.f; gak.z = (j0 + 2 < fr) ? gak.z : 0.f; gak.w = (j0 + 3 < fr) ? gak.w : 0.f;
                        grb.x = (j0 + 0 <= fr) ? grb.x : 0.f; grb.y = (j0 + 1 <= fr) ? grb.y : 0.f; grb.z = (j0 + 2 <= fr) ? grb.z : 0.f; grb.w = (j0 + 3 <= fr) ? grb.w : 0.f;
                        grk.x = (j0 + 0 <= fr) ? grk.x : 0.f; grk.y = (j0 + 1 <= fr) ? grk.y : 0.f; grk.z = (j0 + 2 <= fr) ? grk.z : 0.f; grk.w = (j0 + 3 <= fr) ? grk.w : 0.f;
                        *(uint4*)((bf16_t*)(sl + RS_AKP) + fr * 32 + fq * 8) = make_uint4(pack2bf(gak.x, gak.y), pack2bf(gak.z, gak.w), 0u, 0u);
                        *(uint4*)((bf16_t*)(sl + RS_BRP) + fr * 32 + fq * 8) = make_uint4(pack2bf(grb.x, grb.y), pack2bf(grb.z, grb.w), pack2bf(grk.x, grk.y), pack2bf(grk.z, grk.w));
                        st.gx = __float_as_int(gab.x); st.gy = __float_as_int(gab.y); st.gz = __float_as_int(gab.z); st.gw = __float_as_int(gab.w);
                    } break;
#define RW_GSEL(J) ((((J) & 3) == 0) ? st.gx : ((((J) & 3) == 1) ? st.gy : ((((J) & 3) == 2) ? st.gz : st.gw)))
#define RW_TJ2(T, J) do { if ((J) + 1 < (T)) rw_pair<(T) + 16 * ((J) >> 2), (T) + 16 * (((J) + 1) >> 2)>(acc0, acc1, RW_GSEL(J), RW_GSEL((J) + 1), Tr[(J)], Tr[((J) + 1) & 15]); \
                        else if ((J) < (T)) acc0 = fmaf(rw_nfetch<(T) + 16 * ((J) >> 2)>(RW_GSEL(J), acc0), Tr[(J)], acc0); } while (0)
#define RW_TROW(T) do { float acc0 = ((T) == fr) ? 1.f : 0.f, acc1 = 0.f; RW_TJ2(T, 0); RW_TJ2(T, 2); RW_TJ2(T, 4); RW_TJ2(T, 6); RW_TJ2(T, 8); RW_TJ2(T, 10); RW_TJ2(T, 12); RW_TJ2(T, 14); \
                        Tr[(T)] = acc0 + acc1; (void)rowdep; } while (0)
                    case 5: {
                        float Tr[16]; float rowdep = 0.f;
                        RW_TROW(0); RW_TROW(1); RW_TROW(2); RW_TROW(3); RW_TROW(4); RW_TROW(5); RW_TROW(6); RW_TROW(7); RW_TROW(8); RW_TROW(9); RW_TROW(10);
                        float* TS_ = (float*)BTs + lane;
#define RW_TSV(T) TS_[(T) * 64] = Tr[(T)]
                        RW_TSV(0); RW_TSV(1); RW_TSV(2); RW_TSV(3); RW_TSV(4); RW_TSV(5); RW_TSV(6); RW_TSV(7); RW_TSV(8); RW_TSV(9); RW_TSV(10);
#undef RW_TSV
                    } break;
                    default: {
                        float Tr[16]; float rowdep = 0.f;
                        const float* TS_ = (const float*)BTs + lane;
#define RW_TLD(T) Tr[(T)] = TS_[(T) * 64]
                        RW_TLD(0); RW_TLD(1); RW_TLD(2); RW_TLD(3); RW_TLD(4); RW_TLD(5); RW_TLD(6); RW_TLD(7); RW_TLD(8); RW_TLD(9); RW_TLD(10);
#undef RW_TLD
                        RW_TROW(11); RW_TROW(12); RW_TROW(13); RW_TROW(14); RW_TROW(15);
                        if (fq < 2) {
                            bf16_t* TPw = (bf16_t*)(sl + RS_TP) + (fr >> 2) * 8 + (fr & 3) + fq * 4;
#define RW_TPW(T) TPw[(T) * 32] = (fq == 0) ? f2bf(Tr[(T)]) : (bf16_t)0
                            RW_TPW(0); RW_TPW(1); RW_TPW(2); RW_TPW(3); RW_TPW(4); RW_TPW(5); RW_TPW(6); RW_TPW(7); RW_TPW(8); RW_TPW(9); RW_TPW(10); RW_TPW(11); RW_TPW(12); RW_TPW(13); RW_TPW(14); RW_TPW(15);
#undef RW_TPW
                        }
                    } break;
#undef RW_TROW
#undef RW_TJ2
#undef RW_GSEL
                    }
                }
                asm volatile("s_waitcnt lgkmcnt(0)" ::: "memory"); __builtin_amdgcn_s_barrier(); asm volatile("" ::: "memory");
            }
        }
    }
}
__device__ __forceinline__ void rwkv_post2_phase(const Params& p) {
    const bf16_t* P = (const bf16_t*)(p.ws + OFF_P);
    const bf16_t* Yb = (const bf16_t*)p.out;
    const float* BON = (const float*)(p.ws + OFF_LIN);
    bf16_t* Z = (bf16_t*)(p.ws + OFF_X);
    const float* mu = p.in[4];
    const int ch = otid() * 2;
    const float mv0 = mu[2048 + ch], mv1 = mu[2049 + ch], mg0 = mu[3200 + ch], mg1 = mu[3201 + ch];
    const float gg0 = p.in[12][ch], gg1 = p.in[12][ch + 1], gb0 = p.in[13][ch], gb1 = p.in[13][ch + 1];
    for (int tok = blockIdx.x; tok < M_TOK; tok += gridDim.x) {
        const bf16_t* pr = P + (size_t)tok * RW_COLS + ch;
        const unsigned uv = *(const unsigned*)(pr + 2048), ug = *(const unsigned*)(pr + 3200);
        unsigned pv_ = 0u, pg_ = 0u;
        if ((tok & (SEQ_T - 1)) != 0) { const bf16_t* pp = pr - RW_COLS; pv_ = *(const unsigned*)(pp + 2048); pg_ = *(const unsigned*)(pp + 3200); }
        const unsigned yu = *(const unsigned*)(Yb + (size_t)tok * 1024 + ch);
        const float y0 = bflo(yu), y1 = bfhi(yu);
        const float sb = BON[(size_t)tok * 16 + (ch >> 6)];
        const float v0 = bflo(uv) + (bflo(pv_) - bflo(uv)) * mv0, v1 = bfhi(uv) + (bfhi(pv_) - bfhi(uv)) * mv1;
        const float g0 = bflo(ug) + (bflo(pg_) - bflo(ug)) * mg0, g1 = bfhi(ug) + (bfhi(pg_) - bfhi(ug)) * mg1;
        const float mean = half_sum32(y0 + y1) * (1.f / 64.f);
        const float d0 = y0 - mean, d1 = y1 - mean;
        const float var = half_sum32(d0 * d0 + d1 * d1) * (1.f / 64.f);
        const float rstd = rsqrtf(var + 64e-5f);
        const float o0 = (d0 * rstd * gg0 + gb0 + sb * v0) * siluf_(g0);
        const float o1 = (d1 * rstd * gg1 + gb1 + sb * v1) * siluf_(g1);
        *(unsigned*)(Z + (size_t)tok * 1024 + ch) = pack2bf(o0, o1);
    }
}

__device__ __forceinline__ float half_sum32(float v) {
#pragma unroll
    for (int o = 1; o < 32; o <<= 1) v += __shfl_xor(v, o);
    return v;
}
__device__ __forceinline__ void rwkv_post_phase(const Params& p) {
    const bf16_t* P = (const bf16_t*)(p.ws + OFF_P);
    const unsigned short* Ai = (const unsigned short*)(p.ws + OFF_Y);
    const float* Y = p.out;
    bf16_t* Z = (bf16_t*)(p.ws + OFF_X);
    const float* mu = p.in[4];
    const int ch = otid() * 2;
    const float mr0 = mu[ch], mr1 = mu[ch + 1], mk0 = mu[1024 + ch], mk1 = mu[1025 + ch], mv0 = mu[2048 + ch], mv1 = mu[2049 + ch], mg0 = mu[3200 + ch], mg1 = mu[3201 + ch];
    const float ka0 = p.in[10][ch], ka1 = p.in[10][ch + 1], rk0 = p.in[11][ch], rk1 = p.in[11][ch + 1];
    const float gg0 = p.in[12][ch], gg1 = p.in[12][ch + 1], gb0 = p.in[13][ch], gb1 = p.in[13][ch + 1];
    for (int tok = blockIdx.x; tok < M_TOK; tok += gridDim.x) {
        const bf16_t* pr = P + (size_t)tok * RW_COLS + ch;
        const unsigned ur = *(const unsigned*)(pr), uk = *(const unsigned*)(pr + 1024), uv = *(const unsigned*)(pr + 2048), ug = *(const unsigned*)(pr + 3200);
        unsigned pr_ = 0u, pk_ = 0u, pv_ = 0u, pg_ = 0u;
        if ((tok & (SEQ_T - 1)) != 0) { const bf16_t* pp = pr - RW_COLS; pr_ = *(const unsigned*)(pp); pk_ = *(const unsigned*)(pp + 1024); pv_ = *(const unsigned*)(pp + 2048); pg_ = *(const unsigned*)(pp + 3200); }
        const unsigned ua = *(const unsigned*)(Ai + (size_t)tok * 1024 + ch);
        const float a0 = h2f((unsigned short)(ua & 0xFFFFu)), a1 = h2f((unsigned short)(ua >> 16));
        const float2 y2 = *(const float2*)(Y + (size_t)tok * 1024 + ch);
        const float r0 = bflo(ur) + (bflo(pr_) - bflo(ur)) * mr0, r1 = bfhi(ur) + (bfhi(pr_) - bfhi(ur)) * mr1;
        float k0 = bflo(uk) + (bflo(pk_) - bflo(uk)) * mk0, k1 = bfhi(uk) + (bfhi(pk_) - bfhi(uk)) * mk1;
        const float v0 = bflo(uv) + (bflo(pv_) - bflo(uv)) * mv0, v1 = bfhi(uv) + (bfhi(pv_) - bfhi(uv)) * mv1;
        const float g0 = bflo(ug) + (bflo(pg_) - bflo(ug)) * mg0, g1 = bfhi(ug) + (bfhi(pg_) - bfhi(ug)) * mg1;
        k0 = k0 * (1.f + (a0 - 1.f) * ka0); k1 = k1 * (1.f + (a1 - 1.f) * ka1);
        const float mean = half_sum32(y2.x + y2.y) * (1.f / 64.f);
        const float d0 = y2.x - mean, d1 = y2.y - mean;
        const float var = half_sum32(d0 * d0 + d1 * d1) * (1.f / 64.f);
        const float rstd = rsqrtf(var + 64e-5f);
        const float sb = half_sum32(r0 * k0 * rk0 + r1 * k1 * rk1);
        const float o0 = (d0 * rstd * gg0 + gb0 + sb * v0) * siluf_(g0);
        const float o1 = (d1 * rstd * gg1 + gb1 + sb * v1) * siluf_(g1);
        *(unsigned*)(Z + (size_t)tok * 1024 + ch) = pack2bf(o0, o1);
    }
}

constexpr int HG_TC = 32, HG_STRIDE = 272;
struct HgRaw { uint4 q, k, v; };
__device__ __forceinline__ HgRaw hg_load_raw(const bf16_t* P, size_t tok, int h, int vg, int q) {
    HgRaw r;
    const bf16_t* pr = P + tok * 4096 + h * 128 + 8 * q;
    r.q = *(const uint4*)(pr); r.k = *(const uint4*)(pr + 1024);
    r.v = *(const uint4*)(P + tok * 4096 + 2048 + h * 128 + vg * 16 + 8 * (q & 1));
    return r;
}
__device__ __forceinline__ void hg_process(const HgRaw& x, float* d, int q) {
    *(f32x4*)(d + 8 * q) = (f32x4){bflo(x.q.x), bfhi(x.q.x), bflo(x.q.y), bfhi(x.q.y)};
    *(f32x4*)(d + 8 * q + 4) = (f32x4){bflo(x.q.z), bfhi(x.q.z), bflo(x.q.w), bfhi(x.q.w)};
    *(f32x4*)(d + 128 + 8 * q) = (f32x4){h2f((unsigned short)(x.k.x & 0xFFFFu)), h2f((unsigned short)(x.k.x >> 16)), h2f((unsigned short)(x.k.y & 0xFFFFu)), h2f((unsigned short)(x.k.y >> 16))};
    *(f32x4*)(d + 128 + 8 * q + 4) = (f32x4){h2f((unsigned short)(x.k.z & 0xFFFFu)), h2f((unsigned short)(x.k.z >> 16)), h2f((unsigned short)(x.k.w & 0xFFFFu)), h2f((unsigned short)(x.k.w >> 16))};
    if (q < 2) {
        *(f32x4*)(d + 256 + 8 * q) = (f32x4){bflo(x.v.x), bfhi(x.v.x), bflo(x.v.y), bfhi(x.v.y)};
        *(f32x4*)(d + 256 + 8 * q + 4) = (f32x4){bflo(x.v.z), bfhi(x.v.z), bflo(x.v.w), bfhi(x.v.w)};
    }
}
__device__ __forceinline__ void hgrn_scan_phase(const Params& p, char* smem) {
    float* buf = (float*)smem;
    const bf16_t* P = (const bf16_t*)(p.ws + OFF_P);
    float* O = (float*)(p.ws + OFF_X);
    const int tid = otid(), lane = tid & 63, wid = __builtin_amdgcn_readfirstlane(tid >> 6);
    constexpr int NCH = SEQ_T / HG_TC;
    const int sub = lane >> 4, q = lane & 15;
    for (int unit = blockIdx.x; unit < 256; unit += gridDim.x) {
        const int bh = unit >> 3, vg = unit & 7, b = bh >> 3, h = bh & 7;
        const size_t tokbase = (size_t)b * SEQ_T;
        __syncthreads();
        if (wid >= 4) {
            const int lw = wid - 4, tl0 = lw * 4 + sub, tl1 = 16 + lw * 4 + sub;
            HgRaw x0 = hg_load_raw(P, tokbase + tl0, h, vg, q), x1 = hg_load_raw(P, tokbase + tl1, h, vg, q);
            for (int c = -1; c < NCH; ++c) {
                if (c + 1 < NCH) {
                    const int cn = c + 1; float* db = buf + (cn & 1) * (HG_TC * HG_STRIDE);
                    hg_process(x0, db + tl0 * HG_STRIDE, q);
                    hg_process(x1, db + tl1 * HG_STRIDE, q);
                    if (cn + 1 < NCH) { x0 = hg_load_raw(P, tokbase + (cn + 1) * HG_TC + tl0, h, vg, q); x1 = hg_load_raw(P, tokbase + (cn + 1) * HG_TC + tl1, h, vg, q); }
                }
                __syncthreads();
            }
        } else {
            f32x2 S[4];
#pragma unroll
            for (int e = 0; e < 4; ++e) S[e] = (f32x2){0.f, 0.f};
            const int rowl = wid * 4 + sub;
            float* obase = O + tokbase * 1024 + h * 128 + vg * 16 + rowl;
            __syncthreads();
            for (int c = 0; c < NCH; ++c) {
                const float* cb = buf + (c & 1) * (HG_TC * HG_STRIDE) + q * 8;
                const float* vb = buf + (c & 1) * (HG_TC * HG_STRIDE) + 256 + rowl;
                f32x4 q0 = *(const f32x4*)(cb), q1 = *(const f32x4*)(cb + 4), k0 = *(const f32x4*)(cb + 128), k1 = *(const f32x4*)(cb + 132);
                float vv = vb[0];
                float okeep = 0.f;
#pragma unroll
                for (int tl = 0; tl < HG_TC; ++tl) {
                    f32x4 nq0 = q0, nq1 = q1, nk0 = k0, nk1 = k1; float nv = vv;
                    if (tl + 1 < HG_TC) {
                        const float* s = cb + (tl + 1) * HG_STRIDE;
                        nq0 = *(const f32x4*)(s); nq1 = *(const f32x4*)(s + 4); nk0 = *(const f32x4*)(s + 128); nk1 = *(const f32x4*)(s + 132);
                        nv = vb[(tl + 1) * HG_STRIDE];
                    }
                    __builtin_amdgcn_sched_barrier(0);
                    const f32x2 v2 = {vv, vv};
                    S[0] = __builtin_elementwise_fma((f32x2){k0.x, k0.y}, v2 - S[0], S[0]);
                    S[1] = __builtin_elementwise_fma((f32x2){k0.z, k0.w}, v2 - S[1], S[1]);
                    S[2] = __builtin_elementwise_fma((f32x2){k1.x, k1.y}, v2 - S[2], S[2]);
                    S[3] = __builtin_elementwise_fma((f32x2){k1.z, k1.w}, v2 - S[3], S[3]);
                    f32x2 po = S[0] * (f32x2){q0.x, q0.y};
                    f32x2 pp = S[1] * (f32x2){q0.z, q0.w};
                    po = __builtin_elementwise_fma(S[2], (f32x2){q1.x, q1.y}, po);
                    pp = __builtin_elementwise_fma(S[3], (f32x2){q1.z, q1.w}, pp);
                    po = po + pp;
                    const float o = sum16(po.x + po.y);
                    okeep = (q == (tl & 15)) ? o : okeep;
                    if ((tl & 15) == 15) obase[(size_t)(c * HG_TC + (tl - 15) + q) * 1024] = okeep;
                    __builtin_amdgcn_sched_barrier(0);
                    q0 = nq0; q1 = nq1; k0 = nk0; k1 = nk1; vv = nv;
                }
                __syncthreads();
            }
        }
    }
}
constexpr int HCK = 32;
constexpr size_t OFF_ATTG = OFF_X, OFF_DLG = OFF_X + 16 * MiB;
struct HcRaw { unsigned short q[8], k[8]; };
__device__ __forceinline__ void hc_load(HcRaw& r, const bf16_t* P, size_t tok0, int h, int tid) {
    const int k = tid & 127, tg = tid >> 7;
    const bf16_t* pr = P + (tok0 + tg * 8) * 4096 + h * 128 + k;
#pragma unroll
    for (int j = 0; j < 8; ++j) { r.q[j] = pr[(size_t)j * 4096]; r.k[j] = pr[(size_t)j * 4096 + 1024]; }
}
__device__ __forceinline__ void hgrn_prep_phase(const Params& p, char* smem) {
    bf16_t* P = (bf16_t*)(p.ws + OFF_P);
    bf16_t* ATTg = (bf16_t*)(p.ws + OFF_ATTG);
    float* DLg = (float*)(p.ws + OFF_DLG);
    const int tid = otid(), lane = tid & 63, wid = __builtin_amdgcn_readfirstlane(tid >> 6), fr = lane & 15, fq = lane >> 4;
    const int kch = tid & 127, tg = tid >> 7;
    float* TOT = (float*)(smem);
    bf16_t* QM = (bf16_t*)(smem + 4096);
    bf16_t* KM = (bf16_t*)(smem + 4096 + 8704);
    const int G = gridDim.x;
    __syncthreads();
    HcRaw rawA, rawB;
    {   const int u0 = blockIdx.x, u1 = blockIdx.x + G;
        const int u1c = (u1 < 8192) ? u1 : u0;
        hc_load(rawA, P, (size_t)(u0 >> 11) * SEQ_T + (size_t)(u0 & 255) * HCK, (u0 >> 8) & 7, tid);
        hc_load(rawB, P, (size_t)(u1c >> 11) * SEQ_T + (size_t)(u1c & 255) * HCK, (u1c >> 8) & 7, tid); }
#define HP_BODY(RAW, U) do { \
        const int u_ = (U); const int h_ = (u_ >> 8) & 7; const size_t tok0 = (size_t)(u_ >> 11) * SEQ_T + (size_t)(u_ & 255) * HCK; \
        float kf[8], l[8], qf[8]; \
        { float run = 0.f; _Pragma("unroll") for (int j = 0; j < 8; ++j) { kf[j] = h2f(RAW.k[j]); qf[j] = bf2f(RAW.q[j]); run += __logf(1.0f - kf[j]); l[j] = run; } } \
        { const int un = (u_ + 2 * G < 8192) ? u_ + 2 * G : u_; hc_load(RAW, P, (size_t)(un >> 11) * SEQ_T + (size_t)(un & 255) * HCK, (un >> 8) & 7, tid); } \
        TOT[tg * 128 + kch] = l[7]; if (tg == 2) TOT[4 * 128 + kch] = l[0]; \
        __syncthreads(); \
        { const float t0 = TOT[kch], t1 = TOT[128 + kch], t2 = TOT[256 + kch], t3 = TOT[384 + kch], g16 = TOT[512 + kch]; \
          const float off = (tg > 0 ? t0 : 0.f) + (tg > 1 ? t1 : 0.f) + (tg > 2 ? t2 : 0.f); \
          const float m = t0 + t1 + g16, blast = (t0 + t1) + (t2 + t3); \
          const float em = __expf(m), elm = __expf(blast - m); \
          bf16_t* pq = P + (tok0 + tg * 8) * 4096 + h_ * 128 + kch; float ko8[8]; \
          _Pragma("unroll") for (int j = 0; j < 8; ++j) { const int t = tg * 8 + j; const float bb = off + l[j]; \
              const float e1 = __expf(bb - m), e2 = __builtin_amdgcn_rcpf(e1); const float qm = qf[j] * e1, km = kf[j] * e2; \
              QM[t * 136 + kch] = f2bf(qm); KM[t * 136 + kch] = f2bf(km); pq[(size_t)j * 4096] = f2bf(qm * em); ko8[j] = km * elm; } \
          { uint4 kt; kt.x = pack2bf(ko8[0], ko8[1]); kt.y = pack2bf(ko8[2], ko8[3]); kt.z = pack2bf(ko8[4], ko8[5]); kt.w = pack2bf(ko8[6], ko8[7]); \
            const int idx = kch * 64 + tg * 16;   \
            *(uint4*)(P + (tok0 + (idx >> 8)) * 4096 + 1024 + h_ * 128 + ((idx & 255) >> 1)) = kt; } \
          if (tg == 0) DLg[(size_t)u_ * 128 + kch] = __expf(blast); } \
        __syncthreads(); \
        if (wid < 4) { \
            const int mi = wid >> 1, ni = wid & 1; f32x4 at = {0.f, 0.f, 0.f, 0.f}; \
            if (ni <= mi) { const bf16_t* KMr = KM + (ni * 16 + fr) * 136 + fq * 8; const bf16_t* QMr = QM + (mi * 16 + fr) * 136 + fq * 8; \
                _Pragma("unroll") for (int ks = 0; ks < 4; ++ks) at = __builtin_amdgcn_mfma_f32_16x16x32_bf16(*(const bf16x8*)(KMr + ks * 32), *(const bf16x8*)(QMr + ks * 32), at, 0, 0, 0); } \
            const int t = mi * 16 + fr, s0 = ni * 16 + fq * 4; \
            at.x = (s0 + 0 <= t) ? at.x : 0.f; at.y = (s0 + 1 <= t) ? at.y : 0.f; at.z = (s0 + 2 <= t) ? at.z : 0.f; at.w = (s0 + 3 <= t) ? at.w : 0.f; \
            uint2 pk; pk.x = pack2bf(at.x, at.y); pk.y = pack2bf(at.z, at.w); \
            *(uint2*)(ATTg + (size_t)u_ * 1024 + t * 32 + s0) = pk; \
        } \
    } while (0)
    for (int u = blockIdx.x; u < 8192; u += 2 * G) { HP_BODY(rawA, u); if (u + G < 8192) HP_BODY(rawB, u + G); }
#undef HP_BODY
}
constexpr int H2_QI = 0, H2_KOT = 8704, H2_VT = 18944, H2_ATT = 20224, H2_DL = 22784, H2_PAR = 23296, H2_ST = 2 * H2_PAR, H2_STSZ = 4352;
struct H2Raw { uint4 qi, ko, v, att; f32x4 dl; };
__device__ __forceinline__ void h2_load(H2Raw& r, const bf16_t* P, const bf16_t* ATTg, const float* DLg, size_t tok0, int u, int h, int vg, int tid) {
    const int row = tid >> 4, seg = tid & 15;
    const bf16_t* pr = P + (tok0 + row) * 4096 + h * 128 + seg * 8;
    r.qi = *(const uint4*)(pr); r.ko = *(const uint4*)(pr + 1024);
    r.v = *(const uint4*)(P + (tok0 + ((tid & 63) >> 1)) * 4096 + 2048 + h * 128 + vg * 16 + (tid & 1) * 8);
    r.att = *(const uint4*)(ATTg + (size_t)u * 1024 + (tid & 127) * 8);
    r.dl = *(const f32x4*)(DLg + (size_t)u * 128 + (tid & 31) * 4);
}
__device__ __forceinline__ void hgrn_chunk_phase(const Params& p, char* smem) {
    bf16_t* P = (bf16_t*)(p.ws + OFF_P);
    const bf16_t* ATTg = (const bf16_t*)(p.ws + OFF_ATTG);
    const float* DLg = (const float*)(p.ws + OFF_DLG);
    const int tid = otid(), lane = tid & 63, wid = __builtin_amdgcn_readfirstlane(tid >> 6), fr = lane & 15, fq = lane >> 4;
    constexpr int NCH = SEQ_T / HCK;
    for (int unit = blockIdx.x; unit < 256; unit += gridDim.x) {
        const int xcd_ = unit & 7, idx_ = unit >> 3;
        const int bh = xcd_ * 4 + (idx_ >> 3), vg = idx_ & 7, b = bh >> 3, h = bh & 7;
        const size_t tokbase = (size_t)b * SEQ_T;
        __syncthreads();
        for (int i = tid; i < H2_STSZ / 4; i += NTHREADS) *(unsigned*)(smem + H2_ST + i * 4) = 0u;
        f32x4 accS = {0.f, 0.f, 0.f, 0.f};
        H2Raw rawA, rawB;
        h2_load(rawA, P, ATTg, DLg, tokbase, bh * 256, h, vg, tid);
        h2_load(rawB, P, ATTg, DLg, tokbase + HCK, bh * 256 + 1, h, vg, tid);
#define H2_BODY(RAW, C) do { \
        const int c_ = (C); char* pb = smem + (c_ & 1) * H2_PAR; \
        { const int row = tid >> 4, seg = tid & 15; \
          *(uint4*)((bf16_t*)(pb + H2_QI) + row * 136 + seg * 8) = RAW.qi; \
            \
          { uint4 kov; kov.x = RAW.ko.x; kov.y = RAW.ko.y; kov.z = RAW.ko.z; kov.w = RAW.ko.w; *(uint4*)((bf16_t*)(pb + H2_KOT) + (tid >> 2) * 40 + (tid & 3) * 8) = kov; } \
          if (tid < 64) { bf16_t* VT = (bf16_t*)(pb + H2_VT) + ((tid & 1) * 8) * 40 + (tid >> 1); \
              VT[0] = (bf16_t)(RAW.v.x & 0xFFFFu); VT[40] = (bf16_t)(RAW.v.x >> 16); VT[80] = (bf16_t)(RAW.v.y & 0xFFFFu); VT[120] = (bf16_t)(RAW.v.y >> 16); \
              VT[160] = (bf16_t)(RAW.v.z & 0xFFFFu); VT[200] = (bf16_t)(RAW.v.z >> 16); VT[240] = (bf16_t)(RAW.v.w & 0xFFFFu); VT[280] = (bf16_t)(RAW.v.w >> 16); } \
          if (tid < 128) *(uint4*)((bf16_t*)(pb + H2_ATT) + (tid >> 2) * 40 + (tid & 3) * 8) = RAW.att; \
          if (tid < 32) *(f32x4*)((float*)(pb + H2_DL) + tid * 4) = RAW.dl; } \
        { const int cn_ = (c_ + 2 < NCH) ? c_ + 2 : NCH - 1; h2_load(RAW, P, ATTg, DLg, tokbase + (size_t)cn_ * HCK, bh * 256 + cn_, h, vg, tid); } \
        __syncthreads(); \
        if (wid >= 4 && wid < 6) { \
            const int mi = wid - 4; f32x4 acco = {0.f, 0.f, 0.f, 0.f}; \
            const bf16_t* STr = (const bf16_t*)(smem + H2_ST + (c_ & 1) * H2_STSZ) + fr * 136 + fq * 8; const bf16_t* QIr = (const bf16_t*)(pb + H2_QI) + (mi * 16 + fr) * 136 + fq * 8; \
            _Pragma("unroll") for (int ks = 0; ks < 4; ++ks) acco = __builtin_amdgcn_mfma_f32_16x16x32_bf16(*(const bf16x8*)(STr + ks * 32), *(const bf16x8*)(QIr + ks * 32), acco, 0, 0, 0); \
            const bf16x8 va = *(const bf16x8*)((const bf16_t*)(pb + H2_VT) + fr * 40 + fq * 8); \
            const bf16x8 ab = *(const bf16x8*)((const bf16_t*)(pb + H2_ATT) + (mi * 16 + fr) * 40 + fq * 8); \
            acco = __builtin_amdgcn_mfma_f32_16x16x32_bf16(va, ab, acco, 0, 0, 0); \
            uint2 po; po.x = pack2bf(acco.x, acco.y); po.y = pack2bf(acco.z, acco.w); \
            *(uint2*)(P + (tokbase + (size_t)c_ * HCK + mi * 16 + fr) * 4096 + 2048 + h * 128 + vg * 16 + fq * 4) = po; \
        } \
        { const f32x4 dl = *(const f32x4*)((const float*)(pb + H2_DL) + wid * 16 + fq * 4); accS = accS * dl; \
          const bf16x8 ka = *(const bf16x8*)((const bf16_t*)(pb + H2_KOT) + (wid * 16 + fr) * 40 + fq * 8); \
          const bf16x8 vb = *(const bf16x8*)((const bf16_t*)(pb + H2_VT) + fr * 40 + fq * 8); \
          accS = __builtin_amdgcn_mfma_f32_16x16x32_bf16(ka, vb, accS, 0, 0, 0); \
          uint2 pk; pk.x = pack2bf(accS.x, accS.y); pk.y = pack2bf(accS.z, accS.w); \
          *(uint2*)((bf16_t*)(smem + H2_ST + ((c_ + 1) & 1) * H2_STSZ) + fr * 136 + wid * 16 + fq * 4) = pk; } \
    } while (0)
        for (int c = 0; c < NCH; c += 2) { H2_BODY(rawA, c); H2_BODY(rawB, c + 1); }
#undef H2_BODY
    }
}

__device__ __forceinline__ void hgrn_post_phase(const Params& p) {
    const bf16_t* P = (const bf16_t*)(p.ws + OFF_P);
    bf16_t* Z = (bf16_t*)(p.ws + OFF_Y);
    const int ch = otid() * 2;
    const float g0 = p.in[17][ch], g1 = p.in[17][ch + 1];
    for (int tok = blockIdx.x; tok < M_TOK; tok += gridDim.x) {
        const unsigned ou = *(const unsigned*)(P + (size_t)tok * 4096 + 2048 + ch);
        const float2 o2 = make_float2(bflo(ou), bfhi(ou));
        const unsigned sg = *(const unsigned*)(P + (size_t)tok * 4096 + 3072 + ch);
        const float ss = wave_sum(o2.x * o2.x + o2.y * o2.y);
        const float rs = rsqrtf(ss * (1.f / 128.f) + 1e-6f);
        *(unsigned*)(Z + (size_t)tok * 1024 + ch) = pack2bf(o2.x * rs * g0 * bflo(sg), o2.y * rs * g1 * bfhi(sg));
    }
}

__device__ __forceinline__ void conv_post_phase(const Params& p) {
    const bf16_t* Yc = (const bf16_t*)(p.ws + OFF_P);
    const bf16_t* U = Yc + (size_t)M_TOK * 1024;
    bf16_t* Z = (bf16_t*)(p.ws + OFF_X);
    const float* cw = p.in[20];
    const int ch = otid() * 2;
    const float w00 = cw[ch], w01 = cw[ch + 1], w10 = cw[1024 + ch], w11 = cw[1025 + ch], w20 = cw[2048 + ch], w21 = cw[2049 + ch];
    for (int tok = blockIdx.x; tok < M_TOK; tok += gridDim.x) {
        const int t = tok & (SEQ_T - 1);
        const unsigned y0 = *(const unsigned*)(Yc + (size_t)tok * 1024 + ch);
        unsigned y1 = 0u, y2 = 0u;
        if (t >= 1) y1 = *(const unsigned*)(Yc + (size_t)(tok - 1) * 1024 + ch);
        if (t >= 2) y2 = *(const unsigned*)(Yc + (size_t)(tok - 2) * 1024 + ch);
        const unsigned u = *(const unsigned*)(U + (size_t)tok * 1024 + ch);
        const float c0 = w00 * bflo(y2) + w10 * bflo(y1) + w20 * bflo(y0);
        const float c1 = w01 * bfhi(y2) + w11 * bfhi(y1) + w21 * bfhi(y0);
        *(unsigned*)(Z + (size_t)tok * 1024 + ch) = pack2bf(bflo(u) * c0, bfhi(u) * c1);
    }
}

constexpr int SG_LS = 136;
__device__ __forceinline__ void gmlp_spatial_phase(const Params& p, char* smem) {
    float* rsA = (float*)smem;
    bf16_t* Aw = (bf16_t*)(smem + 1024);
    bf16_t* VT = Aw + 128 * SG_LS;
    const bf16_t* P = (const bf16_t*)(p.ws + OFF_P);
    const bf16_t* Wsb = (const bf16_t*)(p.ws + OFF_WS_GMLP);
    bf16_t* Z = (bf16_t*)(p.ws + OFF_X);
    const float* vg = p.in[23]; const float* bs = p.in[25];
    const int tid = otid(), lane = tid & 63, wid = tid >> 6, wr = wid >> 1, wc = wid & 1, fr = lane & 15, fq = lane >> 4;
    for (int unit = blockIdx.x; unit < 256; unit += gridDim.x) {
        const size_t tok0 = (size_t)unit * 128;
        __syncthreads();
        for (int i = 0; i < 16; ++i) {
            const int r = wid * 16 + i;
            const bf16_t* vr = P + (tok0 + r) * 3072 + 1024 + lane * 16;
            const uint4 a = *(const uint4*)(vr), b = *(const uint4*)(vr + 8);
            const unsigned w[8] = {a.x, a.y, a.z, a.w, b.x, b.y, b.z, b.w};
            float ss = 0.f;
#pragma unroll
            for (int e = 0; e < 8; ++e) { const float lo = bflo(w[e]), hi = bfhi(w[e]); ss += lo * lo + hi * hi; }
            ss = wave_sum(ss);
            if (lane == 0) rsA[r] = rsqrtf(ss * (1.f / 1024.f) + 1e-6f);
        }
        __syncthreads();
        for (int g = 0; g < 8; ++g) {
#pragma unroll
            for (int i = 0; i < 4; ++i) {
                const int idx = tid + i * 512, row = idx >> 4, c16 = idx & 15;
                *(uint4*)(Aw + row * SG_LS + c16 * 8) = *(const uint4*)(Wsb + (size_t)g * 16384 + row * 128 + c16 * 8);
            }
            {
                const int s = tid >> 2, cp = tid & 3;
                const float rs = rsA[s];
                const bf16_t* vr = P + (tok0 + s) * 3072 + 1024 + g * 128 + cp * 32;
#pragma unroll
                for (int i = 0; i < 4; ++i) {
                    const uint4 a = *(const uint4*)(vr + i * 8);
                    const unsigned w[4] = {a.x, a.y, a.z, a.w};
#pragma unroll
                    for (int e = 0; e < 4; ++e) {
                        const int c = cp * 32 + i * 8 + e * 2;
                        const float g0 = vg[g * 128 + c], g1 = vg[g * 128 + c + 1];
                        VT[c * SG_LS + s] = f2bf(bflo(w[e]) * rs * g0);
                        VT[(c + 1) * SG_LS + s] = f2bf(bfhi(w[e]) * rs * g1);
                    }
                }
            }
            __syncthreads();
            f32x4 acc[2][4];
#pragma unroll
            for (int i = 0; i < 2; ++i)
#pragma unroll
                for (int j = 0; j < 4; ++j) acc[i][j] = (f32x4){0.f, 0.f, 0.f, 0.f};
#pragma unroll
            for (int ks = 0; ks < 4; ++ks) {
                bf16x8 af[2], bfr[4];
#pragma unroll
                for (int i = 0; i < 2; ++i) af[i] = *(const bf16x8*)(Aw + (wr * 32 + i * 16 + fr) * SG_LS + ks * 32 + fq * 8);
#pragma unroll
                for (int i = 0; i < 4; ++i) bfr[i] = *(const bf16x8*)(VT + (wc * 64 + i * 16 + fr) * SG_LS + ks * 32 + fq * 8);
#pragma unroll
                for (int mi = 0; mi < 2; ++mi)
#pragma unroll
                    for (int ni = 0; ni < 4; ++ni) acc[mi][ni] = __builtin_amdgcn_mfma_f32_16x16x32_bf16(bfr[ni], af[mi], acc[mi][ni], 0, 0, 0);
            }
#pragma unroll
            for (int mi = 0; mi < 2; ++mi) {
                const int t = wr * 32 + mi * 16 + fr;
                const float bias = bs[g * 128 + t];
                const bf16_t* pr = P + (tok0 + t) * 3072;
#pragma unroll
                for (int ni = 0; ni < 4; ++ni) {
                    const int c = g * 128 + wc * 64 + ni * 16 + fq * 4;
                    const uint2 uu = *(const uint2*)(pr + c), sg = *(const uint2*)(pr + 2048 + c);
                    const f32x4 a = acc[mi][ni];
                    uint2 pk;
                    pk.x = pack2bf(bflo(uu.x) * (a.x + bias) * bflo(sg.x), bfhi(uu.x) * (a.y + bias) * bfhi(sg.x));
                    pk.y = pack2bf(bflo(uu.y) * (a.z + bias) * bflo(sg.y), bfhi(uu.y) * (a.w + bias) * bfhi(sg.y));
                    *(uint2*)(Z + (tok0 + t) * 1024 + c) = pk;
                }
            }
            __syncthreads();
        }
    }
}


#define XB_TMO      128
#define XB_XCNT(j)  (256  + 64 * (j))
#define XB_XSUB(j)  (1280 + 64 * (j))
#define XB_XGEN(j)  (2304 + 64 * (j))
#define XB_TOP      3328
#define XB_TOPGEN   3392
#define XCD_BAR_WORDS 3456
#define XB_SPIN_CAP (1u << 20)
#define XLAS __attribute__((address_space(3)))
__device__ __forceinline__ unsigned xb_ld(unsigned* p)              { return __hip_atomic_load(p, __ATOMIC_RELAXED, __HIP_MEMORY_SCOPE_AGENT); }
__device__ __forceinline__ unsigned xb_add(unsigned* p, unsigned v) { return __hip_atomic_fetch_add(p, v, __ATOMIC_RELAXED, __HIP_MEMORY_SCOPE_AGENT); }
__device__ __forceinline__ unsigned xb_xcc_id() { return (unsigned)__builtin_amdgcn_s_getreg((3 << 11) | 20) & 0xFu; }
#define XB_SPIN(cond, bar) do { unsigned _sp = 0; while (cond) { __builtin_amdgcn_s_sleep(1); \
    if ((++_sp & 255u) == 0u) { if (xb_ld(&(bar)[XB_TMO])) break; if (_sp > XB_SPIN_CAP) { atomicAdd(&(bar)[XB_TMO], 1u); break; } } } } while (0)
struct XcdBarrier { unsigned* bar; unsigned x; volatile XLAS unsigned* st; };
__device__ __forceinline__ XcdBarrier xcd_barrier_post(unsigned* bar, volatile XLAS unsigned* st) {
    XcdBarrier b; b.bar = bar; b.x = xb_xcc_id(); b.st = st;
    if (otid() == 0) (void)xb_add(&bar[XB_XCNT(b.x)], 1u);
    return b;
}
__device__ __forceinline__ void xcd_barrier_complete(unsigned* bar, unsigned x, unsigned& nloc, unsigned& nx) {
    const unsigned G = gridDim.x * gridDim.y * gridDim.z;
    unsigned sum, cnt, mine, sp = 0u;
    for (;;) {
        sum = 0u; cnt = 0u; mine = 0u;
#pragma unroll
        for (unsigned j = 0; j < 16; ++j) { const unsigned c = xb_ld(&bar[XB_XCNT(j)]); sum += c; cnt += (c > 0u) ? 1u : 0u; mine = (j == x) ? c : mine; }
        if (sum == G) break;
        __builtin_amdgcn_s_sleep(1);
        if ((++sp & 255u) == 0u) { if (xb_ld(&bar[XB_TMO])) break; if (sp > XB_SPIN_CAP) { atomicAdd(&bar[XB_TMO], 1u); break; } }
    }
    nloc = mine > 0u ? mine : 1u; nx = cnt > 0u ? cnt : 1u;
}
__device__ __forceinline__ void xcd_barrier(const XcdBarrier& b) {
    asm volatile("s_waitcnt vmcnt(0)" ::: "memory");
    __syncthreads();
    if (otid() == 0) {
        unsigned* bar = b.bar;
        __builtin_amdgcn_s_waitcnt(0);
        unsigned nloc = b.st[0], nx = b.st[1];
        if (nloc == 0u) { xcd_barrier_complete(bar, b.x, nloc, nx); b.st[0] = nloc; b.st[1] = nx; }
        const unsigned old = xb_add(&bar[XB_XSUB(b.x)], 1u);
        const unsigned gen = old / nloc;
        if (old + 1u == (gen + 1u) * nloc) {
            __builtin_amdgcn_fence(__ATOMIC_RELEASE, "agent");
            asm volatile("s_waitcnt vmcnt(0)" ::: "memory");
            const unsigned og = xb_add(&bar[XB_TOP], 1u);
            const unsigned tg = og / nx;
            if (og + 1u == (tg + 1u) * nx) xb_add(&bar[XB_TOPGEN], 1u);
            else XB_SPIN(xb_ld(&bar[XB_TOPGEN]) == tg, bar);
            __builtin_amdgcn_fence(__ATOMIC_ACQUIRE, "agent");
            xb_add(&bar[XB_XGEN(b.x)], 1u);
            asm volatile("s_waitcnt vmcnt(0)" ::: "memory");
        } else {
            XB_SPIN(xb_ld(&bar[XB_XGEN(b.x)]) == gen, bar);
            __builtin_amdgcn_fence(__ATOMIC_ACQUIRE, "agent");
            asm volatile("s_waitcnt vmcnt(0)" ::: "memory");
        }
    }
    __syncthreads();
}

__global__ void __launch_bounds__(NTHREADS) fwd_megakernel(Params p) {
    extern __shared__ __attribute__((aligned(16))) char smem[];
    cg::grid_group grid = cg::this_grid();
    unsigned char* ws = p.ws;
    bf16_t* HN = (bf16_t*)(ws + OFF_X);
    bf16_t* Pb = (bf16_t*)(ws + OFF_P);
    bf16_t* Zx = (bf16_t*)(ws + OFF_X);
    bf16_t* Zy = (bf16_t*)(ws + OFF_Y);
    bf16_t* Lin = (bf16_t*)(ws + OFF_LIN);
    const float* ng = p.in[1];
    volatile XLAS unsigned* xst = (volatile XLAS unsigned*)(smem + LDS_STAGE);
    if (threadIdx.x == 0) { xst[0] = 0u; xst[1] = 0u; }
    __syncthreads();
    const XcdBarrier xbar = xcd_barrier_post((unsigned*)(ws + OFF_BAR), xst);

    phase_weights(p, smem);
    rmsnorm_phase<true>(p.in[0], ng, HN);
    grid.sync();
    for (int rep = 0; rep < REP_GEMM; ++rep) {
    pg8::run(smem, HN, (const bf16_t*)(ws + OFF_WT_RWKV_IN), 4352, pg8::EStoreBf16{Pb, RW_COLS, RW_COLS});
    xcd_barrier(xbar); }
    rwkv_lin_phase(Pb, p.in[4], Lin);
    xcd_barrier(xbar);
    gemm_phase(Lin, 128, (const bf16_t*)(ws + OFF_WT_W2), 64, 1024, 64, EpiLoraW{p.in[5], (float*)(ws + OFF_X)}, smem);
    gemm_phase(Lin + 64, 128, (const bf16_t*)(ws + OFF_WT_A2), 64, 1024, 64, EpiLoraA{p.in[7], (unsigned short*)(ws + OFF_Y)}, smem);
    xcd_barrier(xbar);
    for (int rep = 0; rep < REP_RSCAN; ++rep) {
    rwkv_elem_phase(p);
    xcd_barrier(xbar);
    rwkv_chunk2_phase(p, smem);
    xcd_barrier(xbar); }
    for (int rep = 0; rep < REP_MISC; ++rep) {
    rwkv_post2_phase(p);
    xcd_barrier(xbar); }
    pg8::run(smem, Zx, (const bf16_t*)(ws + OFF_WT_RWKV_OUT), 1024, pg8::EResid{p.in[0], p.out});
    xcd_barrier(xbar);
    rmsnorm_phase<true>(p.out, ng + 1024, HN);
    xcd_barrier(xbar);
    for (int rep = 0; rep < REP_GEMM; ++rep) {
    pg8::run(smem, HN, (const bf16_t*)(ws + OFF_WT_HGRN_IN), 4096, pg8::EHgrn{Pb, (const float*)(ws + OFF_LB)});
    xcd_barrier(xbar); }
    for (int rep = 0; rep < REP_HSCAN; ++rep) {
    hgrn_prep_phase(p, smem);
    xcd_barrier(xbar);
    hgrn_chunk_phase(p, smem);
    xcd_barrier(xbar); }
    for (int rep = 0; rep < REP_MISC; ++rep) {
    hgrn_post_phase(p);
    xcd_barrier(xbar); }
    pg8::run(smem, Zy, (const bf16_t*)(ws + OFF_WT_HGRN_OUT), 1024, pg8::EResid{p.out, p.out});
    xcd_barrier(xbar);
    rmsnorm_phase<true>(p.out, ng + 2048, HN);
    xcd_barrier(xbar);
    for (int rep = 0; rep < REP_GEMM; ++rep) {
    pg8::run(smem, HN, (const bf16_t*)(ws + OFF_WT_CONV_IN), 4096, pg8::EConv{Pb, Pb + (size_t)M_TOK * 1024});
    xcd_barrier(xbar); }
    for (int rep = 0; rep < REP_MISC; ++rep) {
    conv_post_phase(p);
    xcd_barrier(xbar); }
    pg8::run(smem, Zx, (const bf16_t*)(ws + OFF_WT_CONV_OUT), 1024, pg8::EResid{p.out, p.out});
    xcd_barrier(xbar);
    rmsnorm_phase<true>(p.out, ng + 3072, HN);
    xcd_barrier(xbar);
    for (int rep = 0; rep < REP_GEMM; ++rep) {
    pg8::run(smem, HN, (const bf16_t*)(ws + OFF_WT_GMLP_IN), 3072, pg8::EGmlp{Pb});
    xcd_barrier(xbar); }
    for (int rep = 0; rep < REP_MISC; ++rep) {
    gmlp_spatial_phase(p, smem);
    xcd_barrier(xbar); }
    pg8::run(smem, Zx, (const bf16_t*)(ws + OFF_WT_GMLP_OUT), 1024, pg8::EResid{p.out, p.out});
    xcd_barrier(xbar);
    rmsnorm_phase<false>(p.out, p.in[2], p.out);
}

extern "C" void kernel_launch(void* const* d_in, const int* in_sizes, int n_in, void* d_out, int out_size, void* d_ws, size_t ws_size, hipStream_t stream) {
    static int grid = 0;
    if (grid == 0) {
        if (n_in != 27 || out_size != M_TOK * DM || ws_size < WS_END) {
            fprintf(stderr, "kernel_launch: unexpected problem (n_in %d, out %d, ws %zu, need %zu)\n", n_in, out_size, ws_size, (size_t)WS_END);
            grid = -1; return;
        }
        int dev = 0, cus = 0, per_cu = 0;
        hipGetDevice(&dev);
        hipDeviceGetAttribute(&cus, hipDeviceAttributeMultiprocessorCount, dev);
        if (hipFuncSetAttribute((const void*)fwd_megakernel, hipFuncAttributeMaxDynamicSharedMemorySize, LDS_BYTES) != hipSuccess) {
            fprintf(stderr, "kernel_launch: hipFuncSetAttribute failed\n"); grid = -1; return;
        }
        hipOccupancyMaxActiveBlocksPerMultiprocessor(&per_cu, (const void*)fwd_megakernel, NTHREADS, LDS_BYTES);
        if (per_cu < 1) { fprintf(stderr, "kernel_launch: occupancy query says %d blocks per CU\n", per_cu); per_cu = 1; }
        (void)hipGetLastError();
        grid = cus;
    }
    if (grid < 0) return;
    Params p{};
    for (int i = 0; i < 27; ++i) p.in[i] = (const float*)d_in[i];
    p.out = (float*)d_out; p.ws = (unsigned char*)d_ws;
    (void)hipMemsetAsync((unsigned char*)d_ws + OFF_BAR, 0, XCD_BAR_WORDS * 4, stream);
    void* args[] = {&p};
    hipError_t e = hipLaunchCooperativeKernel((const void*)fwd_megakernel, dim3(grid), dim3(NTHREADS), args, LDS_BYTES, stream);
    if (e != hipSuccess) fprintf(stderr, "cooperative launch failed: %s (grid %d)\n", hipGetErrorString(e), grid);
}
```

```cpp
#include <hip/hip_runtime.h>
#include <hip/hip_cooperative_groups.h>
#include <hip/hip_fp16.h>
#include <cstdio>
#include <cstdint>
namespace cg = cooperative_groups;

typedef unsigned short bf16_t;
typedef short bf16x8 __attribute__((ext_vector_type(8)));
typedef float f32x4 __attribute__((ext_vector_type(4)));

constexpr int M_TOK = 32768, DM = 1024, SEQ_T = 8192;
constexpr int NTHREADS = 512;
constexpr int LDS_STAGE = 131072;
constexpr int LDS_BYTES = LDS_STAGE + 16;
constexpr int RW_COLS = 4224;
#ifndef REP_GEMM
#define REP_GEMM 1
#endif
#ifndef REP_RSCAN
#define REP_RSCAN 1
#endif
#ifndef REP_HSCAN
#define REP_HSCAN 1
#endif
#ifndef REP_MISC
#define REP_MISC 1
#endif

constexpr size_t MiB = 1048576;
constexpr size_t OFF_WT_RWKV_IN = 0;
constexpr size_t OFF_WT_RWKV_OUT = OFF_WT_RWKV_IN + (size_t)RW_COLS * 1024 * 2;
constexpr size_t OFF_WT_HGRN_IN = OFF_WT_RWKV_OUT + 2 * MiB;
constexpr size_t OFF_WT_HGRN_OUT = OFF_WT_HGRN_IN + 8 * MiB;
constexpr size_t OFF_WT_CONV_IN = OFF_WT_HGRN_OUT + 2 * MiB;
constexpr size_t OFF_WT_CONV_OUT = OFF_WT_CONV_IN + 8 * MiB;
constexpr size_t OFF_WT_GMLP_IN = OFF_WT_CONV_OUT + 2 * MiB;
constexpr size_t OFF_WT_GMLP_OUT = OFF_WT_GMLP_IN + 6 * MiB;
constexpr size_t OFF_WT_W2 = OFF_WT_GMLP_OUT + 2 * MiB;
constexpr size_t OFF_WT_A2 = OFF_WT_W2 + 131072;
constexpr size_t OFF_WS_GMLP = OFF_WT_A2 + 131072;
constexpr size_t OFF_LB = OFF_WS_GMLP + 262144;
constexpr size_t OFF_BAR = OFF_LB + 4096;
constexpr size_t OFF_P = 39 * MiB;
constexpr size_t OFF_X = OFF_P + 264 * MiB;
constexpr size_t OFF_Y = OFF_X + 128 * MiB;
constexpr size_t OFF_LIN = OFF_Y + 64 * MiB;
constexpr size_t WS_END = OFF_LIN + 8 * MiB;
static_assert(OFF_BAR + 16384 <= OFF_P, "small region overflow");

struct Params {
    const float* in[27];
    float* out;
    unsigned char* ws;
};

__device__ __forceinline__ int otid() { int t = (int)threadIdx.x; asm volatile("" : "+v"(t)); return t; }
__device__ __forceinline__ bf16_t f2bf(float f) { unsigned u = __float_as_uint(f); u += 0x7FFFu + ((u >> 16) & 1u); return (bf16_t)(u >> 16); }
__device__ __forceinline__ float bf2f(unsigned h) { return __uint_as_float(h << 16); }
typedef __bf16 hwbf16x2 __attribute__((ext_vector_type(2)));
typedef float f32x2c __attribute__((ext_vector_type(2)));
__device__ __forceinline__ unsigned pack2bf(float a, float b) { const f32x2c v = {a, b}; const hwbf16x2 r = __builtin_convertvector(v, hwbf16x2); return __builtin_bit_cast(unsigned, r); }
__device__ __forceinline__ float bflo(unsigned u) { return __uint_as_float(u << 16); }
__device__ __forceinline__ float bfhi(unsigned u) { return __uint_as_float(u & 0xFFFF0000u); }
__device__ __forceinline__ float h2f(unsigned short h) { return __half2float(__ushort_as_half(h)); }
__device__ __forceinline__ unsigned short f2h(float f) { return __half_as_ushort(__float2half(f)); }
__device__ __forceinline__ float sigmoidf_(float x) { return __builtin_amdgcn_rcpf(1.0f + __expf(-x)); }
__device__ __forceinline__ float siluf_(float x) { return x * __builtin_amdgcn_rcpf(1.0f + __expf(-x)); }

__device__ __forceinline__ float wave_sum(float v) {
#pragma unroll
    for (int o = 1; o < 64; o <<= 1) v += __shfl_xor(v, o);
    return v;
}
template <int CTRL>
__device__ __forceinline__ float dpp_mov(float x) {
    return __int_as_float(__builtin_amdgcn_update_dpp(0, __float_as_int(x), CTRL, 0xF, 0xF, true));
}
__device__ __forceinline__ float sum16(float x) {
    x += dpp_mov<0xB1>(x);
    x += dpp_mov<0x4E>(x);
    x += dpp_mov<0x141>(x);
    x += dpp_mov<0x140>(x);
    return x;
}

__device__ __forceinline__ int conv_perm(int n) { const int blk = n >> 10, ch = n & 1023, chin = ch & 63; return (ch >> 6) * 256 + (blk >> 1) * 128 + (chin >> 4) * 32 + (blk & 1) * 16 + (chin & 15); }

__device__ __forceinline__ void transpose_convert(const float* __restrict__ W, int K, int N, bf16_t* __restrict__ WT, bool perm, float* tile) {
    const int tid = otid();
    const int nnb = N / 64, items = (K / 64) * nnb;
    for (int it = blockIdx.x; it < items; it += gridDim.x) {
        const int kb = it / nnb, nb = it % nnb, k0 = kb * 64, n0 = nb * 64;
#pragma unroll
        for (int i = 0; i < 2; ++i) {
            const int idx = tid + i * 512, kk = idx >> 4, n4 = (idx & 15) * 4;
            const f32x4 v = *(const f32x4*)(W + (size_t)(k0 + kk) * N + n0 + n4);
            float* d = tile + kk * 65 + n4;
            d[0] = v.x; d[1] = v.y; d[2] = v.z; d[3] = v.w;
        }
        __syncthreads();
        {
            const int n = tid >> 3, k8 = (tid & 7) * 8;
            const float* s = tile + k8 * 65 + n;
            uint4 o;
            o.x = pack2bf(s[0 * 65], s[1 * 65]); o.y = pack2bf(s[2 * 65], s[3 * 65]);
            o.z = pack2bf(s[4 * 65], s[5 * 65]); o.w = pack2bf(s[6 * 65], s[7 * 65]);
            const int ncol = n0 + n, nrow = perm ? conv_perm(ncol) : ncol;
            *(uint4*)(WT + (size_t)nrow * K + k0 + k8) = o;
        }
        __syncthreads();
    }
}

__device__ __forceinline__ void phase_weights(const Params& p, char* smem) {
    float* tile = (float*)smem;
    unsigned char* ws = p.ws;
    transpose_convert(p.in[3], 1024, RW_COLS, (bf16_t*)(ws + OFF_WT_RWKV_IN), false, tile);
    transpose_convert(p.in[14], 1024, 1024, (bf16_t*)(ws + OFF_WT_RWKV_OUT), false, tile);
    transpose_convert(p.in[16], 1024, 4096, (bf16_t*)(ws + OFF_WT_HGRN_IN), false, tile);
    transpose_convert(p.in[18], 1024, 1024, (bf16_t*)(ws + OFF_WT_HGRN_OUT), false, tile);
    transpose_convert(p.in[19], 1024, 4096, (bf16_t*)(ws + OFF_WT_CONV_IN), true, tile);
    transpose_convert(p.in[21], 1024, 1024, (bf16_t*)(ws + OFF_WT_CONV_OUT), false, tile);
    transpose_convert(p.in[22], 1024, 3072, (bf16_t*)(ws + OFF_WT_GMLP_IN), false, tile);
    transpose_convert(p.in[26], 1024, 1024, (bf16_t*)(ws + OFF_WT_GMLP_OUT), false, tile);
    transpose_convert(p.in[6], 64, 1024, (bf16_t*)(ws + OFF_WT_W2), false, tile);
    transpose_convert(p.in[8], 64, 1024, (bf16_t*)(ws + OFF_WT_A2), false, tile);
    const int gtid = blockIdx.x * NTHREADS + otid(), gsz = gridDim.x * NTHREADS;
    {
        const float* w = p.in[24]; bf16_t* o = (bf16_t*)(ws + OFF_WS_GMLP);
        for (int i = gtid; i < 8 * 128 * 128; i += gsz) { const int t = (i >> 7) & 127, s = i & 127; o[i] = (s <= t) ? f2bf(w[i]) : (bf16_t)0; }
    }
    {
        const float* l = p.in[15]; float* lb = (float*)(ws + OFF_LB);
        for (int c = gtid; c < 1024; c += gsz) {
            const float l0 = l[c], l1 = l[1024 + c], l2 = l[2048 + c], l3 = l[3072 + c];
            const float m = fmaxf(fmaxf(l0, l1), fmaxf(l2, l3));
            const float e0 = expf(l0 - m), e1 = expf(l1 - m), e2 = expf(l2 - m), e3 = expf(l3 - m);
            lb[c] = e1 / (e0 + e1 + e2 + e3);
        }
    }
}

template <bool OUT_BF16>
__device__ __forceinline__ void rmsnorm_phase(const float* in, const float* __restrict__ g, void* outp) {
    const int lane = otid() & 63, wid = otid() >> 6;
    const int gw = blockIdx.x * 8 + wid, ngw = gridDim.x * 8;
    f32x4 gv[4];
#pragma unroll
    for (int j = 0; j < 4; ++j) gv[j] = *(const f32x4*)(g + lane * 4 + j * 256);
    for (int row = gw; row < M_TOK; row += ngw) {
        const float* xr = in + (size_t)row * 1024 + lane * 4;
        f32x4 v[4]; float ss = 0.f;
#pragma unroll
        for (int j = 0; j < 4; ++j) { v[j] = *(const f32x4*)(xr + j * 256); ss += v[j].x * v[j].x + v[j].y * v[j].y + v[j].z * v[j].z + v[j].w * v[j].w; }
        ss = wave_sum(ss);
        const float rs = rsqrtf(ss * (1.0f / 1024.0f) + 1e-6f);
#pragma unroll
        for (int j = 0; j < 4; ++j) {
            const f32x4 o = v[j] * rs * gv[j];
            if (OUT_BF16) {
                uint2 pk; pk.x = pack2bf(o.x, o.y); pk.y = pack2bf(o.z, o.w);
                *(uint2*)((bf16_t*)outp + (size_t)row * 1024 + lane * 4 + j * 256) = pk;
            } else {
                *(f32x4*)((float*)outp + (size_t)row * 1024 + lane * 4 + j * 256) = o;
            }
        }
    }
}

constexpr int G_BM = 256, G_BN = 128, G_BK = 64, G_LS = 72;
constexpr int G_ASTAGE = G_BM * G_LS, G_BSTAGE = G_BN * G_LS;

template <class Epi>
__device__ __forceinline__ void gemm_phase(const bf16_t* A, int lda, const bf16_t* Bt, int ldb, int N, int K, const Epi epi, char* smem) {
    const int tid = otid(), lane = tid & 63, wid = tid >> 6, wr = wid >> 1, wc = wid & 1, fr = lane & 15, fq = lane >> 4;
    bf16_t* As = (bf16_t*)smem;
    bf16_t* Bs = As + 2 * G_ASTAGE;
    const int nTn = N / G_BN, nT = (M_TOK / G_BM) * nTn, nk = K / G_BK;
    const int lrow = tid >> 3, lc = (tid & 7) * 8;
    for (int tile = blockIdx.x; tile < nT; tile += gridDim.x) {
        const int tm = tile / nTn, tn = tile % nTn;
        const bf16_t* Ag = A + (size_t)(tm * G_BM + lrow) * lda + lc;
        const bf16_t* Bg = Bt + (size_t)(tn * G_BN + lrow) * ldb + lc;
        f32x4 acc[4][4];
#pragma unroll
        for (int i = 0; i < 4; ++i)
#pragma unroll
            for (int j = 0; j < 4; ++j) acc[i][j] = (f32x4){0.f, 0.f, 0.f, 0.f};
        uint4 ra[4], rb[2];
#pragma unroll
        for (int i = 0; i < 4; ++i) ra[i] = *(const uint4*)(Ag + (size_t)i * 64 * lda);
#pragma unroll
        for (int i = 0; i < 2; ++i) rb[i] = *(const uint4*)(Bg + (size_t)i * 64 * ldb);
#pragma unroll
        for (int i = 0; i < 4; ++i) *(uint4*)(As + (lrow + i * 64) * G_LS + lc) = ra[i];
#pragma unroll
        for (int i = 0; i < 2; ++i) *(uint4*)(Bs + (lrow + i * 64) * G_LS + lc) = rb[i];
        __syncthreads();
        for (int kt = 0; kt < nk; ++kt) {
            const int buf = kt & 1;
            const bool more = (kt + 1 < nk);
            if (more) {
#pragma unroll
                for (int i = 0; i < 4; ++i) ra[i] = *(const uint4*)(Ag + (size_t)i * 64 * lda + (kt + 1) * G_BK);
#pragma unroll
                for (int i = 0; i < 2; ++i) rb[i] = *(const uint4*)(Bg + (size_t)i * 64 * ldb + (kt + 1) * G_BK);
            }
            const bf16_t* as = As + buf * G_ASTAGE + (wr * 64 + fr) * G_LS + fq * 8;
            const bf16_t* bs = Bs + buf * G_BSTAGE + (wc * 64 + fr) * G_LS + fq * 8;
#pragma unroll
            for (int ks = 0; ks < 2; ++ks) {
                bf16x8 af[4], bfr[4];
#pragma unroll
                for (int i = 0; i < 4; ++i) { af[i] = *(const bf16x8*)(as + i * 16 * G_LS + ks * 32); bfr[i] = *(const bf16x8*)(bs + i * 16 * G_LS + ks * 32); }
#pragma unroll
                for (int mi = 0; mi < 4; ++mi)
#pragma unroll
                    for (int ni = 0; ni < 4; ++ni) acc[mi][ni] = __builtin_amdgcn_mfma_f32_16x16x32_bf16(bfr[ni], af[mi], acc[mi][ni], 0, 0, 0);
            }
            if (more) {
                bf16_t* ad = As + (buf ^ 1) * G_ASTAGE; bf16_t* bd = Bs + (buf ^ 1) * G_BSTAGE;
#pragma unroll
                for (int i = 0; i < 4; ++i) *(uint4*)(ad + (lrow + i * 64) * G_LS + lc) = ra[i];
#pragma unroll
                for (int i = 0; i < 2; ++i) *(uint4*)(bd + (lrow + i * 64) * G_LS + lc) = rb[i];
            }
            __syncthreads();
        }
        epi(acc, tm * G_BM + wr * 64, tn * G_BN + wc * 64, fr, fq);
    }
}

struct EpiStoreBf16 {
    bf16_t* C; int ldc;
    __device__ __forceinline__ void operator()(f32x4 (&acc)[4][4], int row0, int col0, int fr, int fq) const {
#pragma unroll
        for (int mi = 0; mi < 4; ++mi)
#pragma unroll
            for (int ni = 0; ni < 4; ++ni) {
                const f32x4 a = acc[mi][ni]; uint2 pk; pk.x = pack2bf(a.x, a.y); pk.y = pack2bf(a.z, a.w);
                *(uint2*)(C + (size_t)(row0 + mi * 16 + fr) * ldc + col0 + ni * 16 + fq * 4) = pk;
            }
    }
};
struct EpiHgrn {
    bf16_t* C; const float* lb;
    __device__ __forceinline__ void operator()(f32x4 (&acc)[4][4], int row0, int col0, int fr, int fq) const {
        const int blk = col0 >> 10;
#pragma unroll
        for (int mi = 0; mi < 4; ++mi)
#pragma unroll
            for (int ni = 0; ni < 4; ++ni) {
                f32x4 a = acc[mi][ni]; const int col = col0 + ni * 16 + fq * 4; uint2 pk;
                if (blk == 1) {
                    const f32x4 l = *(const f32x4*)(lb + (col - 1024));
                    a.x = (1.f - l.x) * sigmoidf_(-a.x); a.y = (1.f - l.y) * sigmoidf_(-a.y); a.z = (1.f - l.z) * sigmoidf_(-a.z); a.w = (1.f - l.w) * sigmoidf_(-a.w);
                    pk.x = (unsigned)f2h(a.x) | ((unsigned)f2h(a.y) << 16); pk.y = (unsigned)f2h(a.z) | ((unsigned)f2h(a.w) << 16);
                } else {
                    if (blk == 3) { a.x = siluf_(a.x); a.y = siluf_(a.y); a.z = siluf_(a.z); a.w = siluf_(a.w); }
                    pk.x = pack2bf(a.x, a.y); pk.y = pack2bf(a.z, a.w);
                }
                *(uint2*)(C + (size_t)(row0 + mi * 16 + fr) * 4096 + col) = pk;
            }
    }
};
struct EpiConv {
    bf16_t* Yc; bf16_t* U;
    __device__ __forceinline__ void operator()(f32x4 (&acc)[4][4], int row0, int col0, int fr, int fq) const {
        const int ch = (col0 >> 6) * 16 + fq * 4;
#pragma unroll
        for (int mi = 0; mi < 4; ++mi) {
            const f32x4 b = acc[mi][0], c = acc[mi][1], z = acc[mi][2], g = acc[mi][3];
            const size_t o = (size_t)(row0 + mi * 16 + fr) * 1024 + ch;
            uint2 py, pu;
            py.x = pack2bf(c.x * z.x, c.y * z.y); py.y = pack2bf(c.z * z.z, c.w * z.w);
            pu.x = pack2bf(b.x * siluf_(g.x), b.y * siluf_(g.y)); pu.y = pack2bf(b.z * siluf_(g.z), b.w * siluf_(g.w));
            *(uint2*)(Yc + o) = py; *(uint2*)(U + o) = pu;
        }
    }
};
struct EpiGmlp {
    bf16_t* C;
    __device__ __forceinline__ void operator()(f32x4 (&acc)[4][4], int row0, int col0, int fr, int fq) const {
        const int blk = col0 >> 10;
#pragma unroll
        for (int mi = 0; mi < 4; ++mi)
#pragma unroll
            for (int ni = 0; ni < 4; ++ni) {
                f32x4 a = acc[mi][ni];
                if (blk == 2) { a.x = siluf_(a.x); a.y = siluf_(a.y); a.z = siluf_(a.z); a.w = siluf_(a.w); }
                uint2 pk; pk.x = pack2bf(a.x, a.y); pk.y = pack2bf(a.z, a.w);
                *(uint2*)(C + (size_t)(row0 + mi * 16 + fr) * 3072 + col0 + ni * 16 + fq * 4) = pk;
            }
    }
};
struct EpiResid {
    const float* R; float* O;
    __device__ __forceinline__ void operator()(f32x4 (&acc)[4][4], int row0, int col0, int fr, int fq) const {
#pragma unroll
        for (int mi = 0; mi < 4; ++mi)
#pragma unroll
            for (int ni = 0; ni < 4; ++ni) {
                const size_t o = (size_t)(row0 + mi * 16 + fr) * 1024 + col0 + ni * 16 + fq * 4;
                const f32x4 r = *(const f32x4*)(R + o);
                *(f32x4*)(O + o) = r + acc[mi][ni];
            }
    }
};
__device__ __forceinline__ float rwkv_decay(float v) {
    return __expf(-0.60653065971263342f * sigmoidf_(v));
}
struct EpiLoraW {
    const float* w0; float* Wd;
    __device__ __forceinline__ void operator()(f32x4 (&acc)[4][4], int row0, int col0, int fr, int fq) const {
#pragma unroll
        for (int mi = 0; mi < 4; ++mi)
#pragma unroll
            for (int ni = 0; ni < 4; ++ni) {
                const int col = col0 + ni * 16 + fq * 4;
                const f32x4 b = *(const f32x4*)(w0 + col); const f32x4 a = acc[mi][ni] + b;
                f32x4 o; o.x = rwkv_decay(a.x); o.y = rwkv_decay(a.y); o.z = rwkv_decay(a.z); o.w = rwkv_decay(a.w);
                *(f32x4*)(Wd + (size_t)(row0 + mi * 16 + fr) * 1024 + col) = o;
            }
    }
};
struct EpiLoraA {
    const float* a0; unsigned short* Ai;
    __device__ __forceinline__ void operator()(f32x4 (&acc)[4][4], int row0, int col0, int fr, int fq) const {
#pragma unroll
        for (int mi = 0; mi < 4; ++mi)
#pragma unroll
            for (int ni = 0; ni < 4; ++ni) {
                const int col = col0 + ni * 16 + fq * 4;
                const f32x4 b = *(const f32x4*)(a0 + col); const f32x4 a = acc[mi][ni] + b;
                uint2 pk;
                pk.x = (unsigned)f2h(sigmoidf_(a.x)) | ((unsigned)f2h(sigmoidf_(a.y)) << 16);
                pk.y = (unsigned)f2h(sigmoidf_(a.z)) | ((unsigned)f2h(sigmoidf_(a.w)) << 16);
                *(uint2*)(Ai + (size_t)(row0 + mi * 16 + fr) * 1024 + col) = pk;
            }
    }
};


namespace pg8 {
#define PG8_LAS __attribute__((address_space(3)))
constexpr int BM = 256, BK = 64, HALF = 128, HTB = HALF * BK * 2, NXCD = 8, WGM = 8;
__device__ __forceinline__ int lds_byte(int r, int c) { const int st = (r >> 4) * 2 + (c >> 5), rr = r & 15, cc = c & 31, ob = rr * 64 + cc * 2; return st * 1024 + (ob ^ (((ob >> 9) & 1) << 5)); }
__device__ __forceinline__ void stage_rc(int b, int& R, int& C) { const int st = b / 1024, sb = b % 1024, swz = sb ^ (((sb >> 9) & 1) << 5); R = (st >> 1) * 16 + swz / 64; C = (st & 1) * 32 + (swz % 64) / 2; }
struct Unit { int pm, pn; };
struct Gemm { const bf16_t* A; const bf16_t* Bt; int M, N, K; };
struct StaticOrder {
    int nM, nN, nwg, G, c;
    __device__ void init(int M, int N, int G_, int c_) { nM = M / BM; nN = N / BM; nwg = nM * nN; G = G_; c = c_; }
    __device__ bool next(int i, Unit& u) const {
        const long L = (long)i * G + c; if (L >= nwg) return false;
        int wgid = (int)L; { const int q = nwg / NXCD, r = nwg % NXCD, xcd = wgid % NXCD, off = wgid / NXCD; wgid = (xcd < r ? xcd * (q + 1) : r * (q + 1) + (xcd - r) * q) + off; }
        const int nig = WGM * nN, gid = wgid / nig, fm = gid * WGM, gsz = (nM - fm) < WGM ? (nM - fm) : WGM;
        u.pm = fm + ((wgid % nig) % gsz); u.pn = (wgid % nig) / gsz; return true;
    }
};
template <class Epi>
__device__ __forceinline__ void gemm_phase(PG8_LAS unsigned char* lds, const Gemm g, const StaticOrder& S, const Epi& E) {
    const int tid = otid(), wid = __builtin_amdgcn_readfirstlane(tid >> 6), lane = tid & 63, wr = wid >> 2, wc = wid & 3, fr = lane & 15, fq = lane >> 4;
    const int K = g.K, nt = K / BK;
    unsigned voffA[2], voffB[2];
#pragma unroll
    for (int i = 0; i < 2; ++i) { int R, C; stage_rc(tid * 16 + i * 8192, R, C); voffA[i] = (unsigned)(R * K + C) * 2u; voffB[i] = (unsigned)(R * K + C) * 2u; }
    const size_t kstep = (size_t)(BK * 2);
    const size_t hstep = (size_t)HALF * K * 2;
    const size_t tstep = 2 * hstep;
    const unsigned ldsw = (unsigned)wid * 1024u;
    const int aoff = lds_byte(wr * 64 + fr, fq * 8), boff = lds_byte(wc * 32 + fr, fq * 8);
#define PG8_SA(b, h) (((b) * 2 + (h)) * HTB)
#define PG8_SB(b, h) ((4 + (b) * 2 + (h)) * HTB)
#define PG8_STAGE(bufoff, gbase, voff) do { _Pragma("unroll") for (int _i = 0; _i < 2; ++_i) \
        __builtin_amdgcn_global_load_lds((const unsigned*)((const char*)(gbase) + (voff)[_i]), (PG8_LAS unsigned*)(lds + (bufoff) + ldsw + _i * 8192), 16, 0, 0); } while (0)
#define PG8_LDA(dst, b, h) do { _Pragma("unroll") for (int m = 0; m < 4; ++m) _Pragma("unroll") for (int k = 0; k < 2; ++k) dst[m][k] = *(const PG8_LAS bf16x8*)(lds + PG8_SA(b, h) + aoff + m * 2048 + k * 1024); } while (0)
#define PG8_LDB(dst, b, h) do { _Pragma("unroll") for (int n = 0; n < 2; ++n) _Pragma("unroll") for (int k = 0; k < 2; ++k) dst[n][k] = *(const PG8_LAS bf16x8*)(lds + PG8_SB(b, h) + boff + n * 2048 + k * 1024); } while (0)
#define PG8_MMA(ai, bj, At, Bt) do { __builtin_amdgcn_s_setprio(1); _Pragma("unroll") for (int m = 0; m < 4; ++m) _Pragma("unroll") for (int n = 0; n < 2; ++n) _Pragma("unroll") for (int k = 0; k < 2; ++k) \
        acc[ai][bj][m][n] = __builtin_amdgcn_mfma_f32_16x16x32_bf16(Bt[n][k], At[m][k], acc[ai][bj][m][n], 0, 0, 0); __builtin_amdgcn_s_setprio(0); } while (0)
#define PG8_WAIT_V(n) asm volatile("s_waitcnt vmcnt(" #n ")" ::: "memory")
#define PG8_WAIT_L(n) asm volatile("s_waitcnt lgkmcnt(" #n ")" ::: "memory")
#define PG8_BAR __builtin_amdgcn_s_barrier()
#define PG8_SCHED __builtin_amdgcn_sched_barrier(0)
    Unit cur, nxt; int ui = 0;
    if (!S.next(0, cur)) return;
    f32x4 acc[2][2][4][2];
#pragma unroll
    for (int a = 0; a < 2; ++a)
#pragma unroll
        for (int b = 0; b < 2; ++b)
#pragma unroll
            for (int m = 0; m < 4; ++m)
#pragma unroll
                for (int n = 0; n < 2; ++n) acc[a][b][m][n] = (f32x4){0.f, 0.f, 0.f, 0.f};
    bf16x8 At[4][2], B0[2][2], B1[2][2];
    const char* cA = (const char*)g.A + (size_t)cur.pm * tstep; const char* cB = (const char*)g.Bt + (size_t)cur.pn * tstep;
    PG8_STAGE(PG8_SB(0, 0), cB, voffB); PG8_STAGE(PG8_SA(0, 0), cA, voffA); PG8_STAGE(PG8_SB(0, 1), cB + hstep, voffB); PG8_STAGE(PG8_SA(0, 1), cA + hstep, voffA);
    if (wr == 1) PG8_BAR;
    PG8_WAIT_V(4); PG8_BAR;
    PG8_STAGE(PG8_SB(1, 0), cB + kstep, voffB); PG8_STAGE(PG8_SA(1, 0), cA + kstep, voffA); PG8_STAGE(PG8_SB(1, 1), cB + hstep + kstep, voffB);
    PG8_WAIT_V(6); PG8_BAR;
    for (;;) {
        const bool has_next = S.next(ui + 1, nxt);
        const char* nA = has_next ? (const char*)g.A + (size_t)nxt.pm * tstep : cA; const char* nB = has_next ? (const char*)g.Bt + (size_t)nxt.pn * tstep : cB;
        for (int t = 0; t < nt; t += 2) {
            const bool last = (t == nt - 2);
            const char* a1 = cA + (size_t)(t + 1) * kstep;
            const char* a2 = last ? nA : cA + (size_t)(t + 2) * kstep; const char* b2 = last ? nB : cB + (size_t)(t + 2) * kstep;
            const char* a3 = a2 + kstep; const char* b3 = b2 + kstep;
            PG8_LDB(B0, 0, 0); PG8_SCHED; PG8_LDA(At, 0, 0); PG8_STAGE(PG8_SA(1, 1), a1 + hstep, voffA);
            PG8_WAIT_L(8); PG8_BAR; PG8_WAIT_L(0); PG8_MMA(0, 0, At, B0); PG8_BAR; PG8_SCHED;
            PG8_LDB(B1, 0, 1); PG8_STAGE(PG8_SB(0, 0), b2, voffB);
            PG8_BAR; PG8_WAIT_L(0); PG8_MMA(0, 1, At, B1); PG8_BAR;
            PG8_LDA(At, 0, 1); PG8_STAGE(PG8_SA(0, 0), a2, voffA);
            PG8_BAR; PG8_WAIT_L(0); PG8_MMA(1, 0, At, B0); PG8_BAR; PG8_SCHED;
            PG8_STAGE(PG8_SB(0, 1), b2 + hstep, voffB);
            PG8_WAIT_V(6); PG8_BAR; PG8_MMA(1, 1, At, B1); PG8_BAR;
            PG8_LDB(B0, 1, 0); PG8_SCHED; PG8_LDA(At, 1, 0); PG8_STAGE(PG8_SA(0, 1), a2 + hstep, voffA);
            PG8_WAIT_L(8); PG8_BAR; PG8_WAIT_L(0); PG8_MMA(0, 0, At, B0); PG8_BAR; PG8_SCHED;
            PG8_LDB(B1, 1, 1); PG8_STAGE(PG8_SB(1, 0), b3, voffB);
            PG8_BAR; PG8_WAIT_L(0); PG8_MMA(0, 1, At, B1); PG8_BAR;
            PG8_LDA(At, 1, 1); PG8_STAGE(PG8_SA(1, 0), a3, voffA);
            PG8_BAR; PG8_WAIT_L(0); PG8_MMA(1, 0, At, B0); PG8_BAR; PG8_SCHED;
            PG8_STAGE(PG8_SB(1, 1), b3 + hstep, voffB);
            PG8_WAIT_V(6); PG8_BAR; PG8_MMA(1, 1, At, B1); PG8_BAR;
        }
        E(acc, cur, wr, wc, fr, fq);
        if (!has_next) break;
#pragma unroll
        for (int a = 0; a < 2; ++a)
#pragma unroll
            for (int b = 0; b < 2; ++b)
#pragma unroll
                for (int m = 0; m < 4; ++m)
#pragma unroll
                    for (int n = 0; n < 2; ++n) acc[a][b][m][n] = (f32x4){0.f, 0.f, 0.f, 0.f};
        cur = nxt; cA = nA; cB = nB; ++ui;
    }
    PG8_WAIT_V(0);
    if (wr == 0) PG8_BAR;
    PG8_BAR;
#undef PG8_SA
#undef PG8_SB
#undef PG8_STAGE
#undef PG8_LDA
#undef PG8_LDB
#undef PG8_MMA
#undef PG8_WAIT_V
#undef PG8_WAIT_L
#undef PG8_BAR
#undef PG8_SCHED
}
#define PG8_FOREACH(body) \
    _Pragma("unroll") for (int ai = 0; ai < 2; ++ai) _Pragma("unroll") for (int m = 0; m < 4; ++m) { const int row = u.pm * 256 + ai * 128 + wr * 64 + m * 16 + fr; \
    _Pragma("unroll") for (int bj = 0; bj < 2; ++bj) _Pragma("unroll") for (int n = 0; n < 2; ++n) { const int col = u.pn * 256 + bj * 128 + wc * 32 + n * 16 + fq * 4; f32x4 a = acc[ai][bj][m][n]; body } }
struct EStoreBf16 {
    bf16_t* C; int ldc; int ncols;
    __device__ __forceinline__ void operator()(const f32x4 (&acc)[2][2][4][2], const Unit& u, int wr, int wc, int fr, int fq) const {
        const int nbj = (u.pn * 256 + 256 <= ncols) ? 2 : 1;
#pragma unroll
        for (int ai = 0; ai < 2; ++ai)
#pragma unroll
            for (int m = 0; m < 4; ++m) { const int row = u.pm * 256 + ai * 128 + wr * 64 + m * 16 + fr;
                for (int bj = 0; bj < nbj; ++bj)
#pragma unroll
                    for (int n = 0; n < 2; ++n) { const int col = u.pn * 256 + bj * 128 + wc * 32 + n * 16 + fq * 4; const f32x4 a = acc[ai][bj][m][n];
                        uint2 pk; pk.x = pack2bf(a.x, a.y); pk.y = pack2bf(a.z, a.w); *(uint2*)(C + (size_t)row * ldc + col) = pk; } }
    }
};
struct EHgrn {
    bf16_t* C; const float* lb;
    __device__ __forceinline__ void operator()(const f32x4 (&acc)[2][2][4][2], const Unit& u, int wr, int wc, int fr, int fq) const {
        const int blk = (u.pn * 256) >> 10;
        PG8_FOREACH( uint2 pk;
            if (blk == 1) { const f32x4 l = *(const f32x4*)(lb + (col - 1024));
                a.x = (1.f - l.x) * sigmoidf_(-a.x); a.y = (1.f - l.y) * sigmoidf_(-a.y); a.z = (1.f - l.z) * sigmoidf_(-a.z); a.w = (1.f - l.w) * sigmoidf_(-a.w);
                pk.x = (unsigned)f2h(a.x) | ((unsigned)f2h(a.y) << 16); pk.y = (unsigned)f2h(a.z) | ((unsigned)f2h(a.w) << 16);
            } else { if (blk == 3) { a.x = siluf_(a.x); a.y = siluf_(a.y); a.z = siluf_(a.z); a.w = siluf_(a.w); }
                pk.x = pack2bf(a.x, a.y); pk.y = pack2bf(a.z, a.w); }
            *(uint2*)(C + (size_t)row * 4096 + col) = pk; )
    }
};
struct EGmlp {
    bf16_t* C;
    __device__ __forceinline__ void operator()(const f32x4 (&acc)[2][2][4][2], const Unit& u, int wr, int wc, int fr, int fq) const {
        const int blk = (u.pn * 256) >> 10;
        PG8_FOREACH( if (blk == 2) { a.x = siluf_(a.x); a.y = siluf_(a.y); a.z = siluf_(a.z); a.w = siluf_(a.w); }
            uint2 pk; pk.x = pack2bf(a.x, a.y); pk.y = pack2bf(a.z, a.w); *(uint2*)(C + (size_t)row * 3072 + col) = pk; )
    }
};
struct EResid {
    const float* R; float* O;
    __device__ __forceinline__ void operator()(const f32x4 (&acc)[2][2][4][2], const Unit& u, int wr, int wc, int fr, int fq) const {
        PG8_FOREACH( const size_t o = (size_t)row * 1024 + col; const f32x4 r = *(const f32x4*)(R + o); *(f32x4*)(O + o) = r + a; )
    }
};
struct EConv {
    bf16_t* Yc; bf16_t* U;
    __device__ __forceinline__ void operator()(const f32x4 (&acc)[2][2][4][2], const Unit& u, int wr, int wc, int fr, int fq) const {
        const int ch = u.pn * 64 + wc * 16 + fq * 4;
#pragma unroll
        for (int ai = 0; ai < 2; ++ai)
#pragma unroll
            for (int m = 0; m < 4; ++m) {
                const int row = u.pm * 256 + ai * 128 + wr * 64 + m * 16 + fr;
                const f32x4 b = acc[ai][0][m][0], c = acc[ai][0][m][1], z = acc[ai][1][m][0], g = acc[ai][1][m][1];
                const size_t o = (size_t)row * 1024 + ch;
                uint2 py, pu;
                py.x = pack2bf(c.x * z.x, c.y * z.y); py.y = pack2bf(c.z * z.z, c.w * z.w);
                pu.x = pack2bf(b.x * siluf_(g.x), b.y * siluf_(g.y)); pu.y = pack2bf(b.z * siluf_(g.z), b.w * siluf_(g.w));
                *(uint2*)(Yc + o) = py; *(uint2*)(U + o) = pu;
            }
    }
};
template <class Epi>
__device__ __forceinline__ void run(char* smem, const bf16_t* A, const bf16_t* Bt, int N, const Epi& E) {
    StaticOrder S; S.init(M_TOK, N, (int)gridDim.x, (int)blockIdx.x);
    gemm_phase((PG8_LAS unsigned char*)smem, Gemm{A, Bt, M_TOK, N, 1024}, S, E);
    __syncthreads();
}
}

__device__ __forceinline__ void rwkv_lin_phase(const bf16_t* P, const float* __restrict__ mu, bf16_t* Lin) {
    const int gtid = blockIdx.x * NTHREADS + otid(), gsz = gridDim.x * NTHREADS;
    for (int idx = gtid; idx < M_TOK * 64; idx += gsz) {
        const int tok = idx >> 6, cp = (idx & 63) * 2, col = 3072 + cp;
        const unsigned pc = *(const unsigned*)(P + (size_t)tok * RW_COLS + col);
        unsigned pp = 0u;
        if ((tok & (SEQ_T - 1)) != 0) pp = *(const unsigned*)(P + (size_t)(tok - 1) * RW_COLS + col);
        const float m0 = mu[col], m1 = mu[col + 1];
        float x0 = bflo(pc) + (bflo(pp) - bflo(pc)) * m0;
        float x1 = bfhi(pc) + (bfhi(pp) - bfhi(pc)) * m1;
        if (cp < 64) { x0 = tanhf(x0); x1 = tanhf(x1); }
        *(unsigned*)(Lin + (size_t)tok * 128 + cp) = pack2bf(x0, x1);
    }
}

constexpr int RW_TC = 32;
typedef float f32x2 __attribute__((ext_vector_type(2)));
struct RwRaw { uint2 cr, ck, cv, pr, pk, pv, a; f32x4 w; };
__device__ __forceinline__ RwRaw rw_load_raw(const bf16_t* P, const float* Wd, const unsigned short* Ai, size_t tokbase, int t, int hcol) {
    RwRaw r;
    const size_t tok = tokbase + t;
    const bf16_t* pr = P + tok * RW_COLS + hcol;
    r.cr = *(const uint2*)(pr); r.ck = *(const uint2*)(pr + 1024); r.cv = *(const uint2*)(pr + 2048);
    { const bf16_t* pp = (t > 0) ? pr - RW_COLS : pr; r.pr = *(const uint2*)(pp); r.pk = *(const uint2*)(pp + 1024); r.pv = *(const uint2*)(pp + 2048);
      const unsigned msk = (t > 0) ? 0xFFFFFFFFu : 0u; r.pr.x &= msk; r.pr.y &= msk; r.pk.x &= msk; r.pk.y &= msk; r.pv.x &= msk; r.pv.y &= msk; }
    r.w = *(const f32x4*)(Wd + tok * 1024 + hcol);
    r.a = *(const uint2*)(Ai + tok * 1024 + hcol);
    return r;
}
__device__ __forceinline__ void rw_process(const RwRaw& x, const f32x4 mur, const f32x4 muk, const f32x4 muv, const f32x4 kkc, const f32x4 kac, float* d) {
    f32x4 rc = {bflo(x.cr.x), bfhi(x.cr.x), bflo(x.cr.y), bfhi(x.cr.y)}, rp = {bflo(x.pr.x), bfhi(x.pr.x), bflo(x.pr.y), bfhi(x.pr.y)};
    f32x4 kc = {bflo(x.ck.x), bfhi(x.ck.x), bflo(x.ck.y), bfhi(x.ck.y)}, kp = {bflo(x.pk.x), bfhi(x.pk.x), bflo(x.pk.y), bfhi(x.pk.y)};
    f32x4 vc = {bflo(x.cv.x), bfhi(x.cv.x), bflo(x.cv.y), bfhi(x.cv.y)}, vp = {bflo(x.pv.x), bfhi(x.pv.x), bflo(x.pv.y), bfhi(x.pv.y)};
    const f32x4 a = {h2f((unsigned short)(x.a.x & 0xFFFFu)), h2f((unsigned short)(x.a.x >> 16)), h2f((unsigned short)(x.a.y & 0xFFFFu)), h2f((unsigned short)(x.a.y >> 16))};
    const f32x4 r1 = rc + (rp - rc) * mur, k1 = kc + (kp - kc) * muk, v1 = vc + (vp - vc) * muv;
    const f32x4 kkv = k1 * kkc;
    float n2 = kkv.x * kkv.x + kkv.y * kkv.y + kkv.z * kkv.z + kkv.w * kkv.w;
    n2 = sum16(n2);
    const float inv = rsqrtf(fmaxf(n2, 1e-24f));
    const f32x4 kk = kkv * inv;
    const f32x4 k2 = k1 * (1.f + (a - 1.f) * kac);
    *(f32x4*)(d) = r1; *(f32x4*)(d + 64) = x.w; *(f32x4*)(d + 128) = k2; *(f32x4*)(d + 192) = v1; *(f32x4*)(d + 256) = -kk; *(f32x4*)(d + 320) = kk * a;
}
__device__ __forceinline__ void rwkv_scan_phase(const Params& p, char* smem) {
    float* buf = (float*)smem;
    const bf16_t* P = (const bf16_t*)(p.ws + OFF_P);
    const float* Wd = (const float*)(p.ws + OFF_X);
    const unsigned short* Ai = (const unsigned short*)(p.ws + OFF_Y);
    float* Y = p.out;
    const float* mu = p.in[4]; const float* k_k = p.in[9]; const float* k_a = p.in[10];
    const int tid = otid(), lane = tid & 63, wid = __builtin_amdgcn_readfirstlane(tid >> 6);
    constexpr int NCH = SEQ_T / RW_TC;
    const int sub = lane >> 4, q = lane & 15;
    for (int unit = blockIdx.x; unit < 256; unit += gridDim.x) {
        const int bh = unit >> 2, rg = unit & 3, b = bh >> 4, h = bh & 15;
        const size_t tokbase = (size_t)b * SEQ_T;
        __syncthreads();
        if (wid >= 4) {
            const int hcol = h * 64 + q * 4, lw = wid - 4;
            const f32x4 mur = *(const f32x4*)(mu + hcol), muk = *(const f32x4*)(mu + 1024 + hcol), muv = *(const f32x4*)(mu + 2048 + hcol);
            const f32x4 kkc = *(const f32x4*)(k_k + hcol), kac = *(const f32x4*)(k_a + hcol);
            const int tl0 = lw * 4 + sub, tl1 = 16 + lw * 4 + sub;
            RwRaw x0 = rw_load_raw(P, Wd, Ai, tokbase, tl0, hcol), x1 = rw_load_raw(P, Wd, Ai, tokbase, tl1, hcol);
            for (int c = -1; c < NCH; ++c) {
                if (c + 1 < NCH) {
                    const int cn = c + 1; float* db = buf + (cn & 1) * (RW_TC * 384) + q * 4;
                    rw_process(x0, mur, muk, muv, kkc, kac, db + tl0 * 384);
                    rw_process(x1, mur, muk, muv, kkc, kac, db + tl1 * 384);
                    { const int cl = (cn + 1 < NCH) ? cn + 1 : cn; x0 = rw_load_raw(P, Wd, Ai, tokbase, cl * RW_TC + tl0, hcol); x1 = rw_load_raw(P, Wd, Ai, tokbase, cl * RW_TC + tl1, hcol); }
                }
                __syncthreads();
            }
        } else {
            f32x2 Sa = {0.f, 0.f}, Sb = {0.f, 0.f};
            const int rowl = wid * 4 + sub;
            float* ybase = Y + tokbase * 1024 + h * 64 + rg * 16 + rowl;
            __syncthreads();
            for (int c = 0; c < NCH; ++c) {
                const float* cb = buf + (c & 1) * (RW_TC * 384) + q * 4;
                const float* vb = buf + (c & 1) * (RW_TC * 384) + 192 + rg * 16 + rowl;
                f32x4 r4 = *(const f32x4*)(cb), w4 = *(const f32x4*)(cb + 64), k4 = *(const f32x4*)(cb + 128), a4 = *(const f32x4*)(cb + 256), b4 = *(const f32x4*)(cb + 320);
                float vv = vb[0];
                float ykeep = 0.f;
#pragma unroll
                for (int tl = 0; tl < RW_TC; ++tl) {
                    f32x4 nr = r4, nw = w4, nk = k4, na = a4, nb = b4; float nv = vv;
                    if (tl + 1 < RW_TC) {
                        const float* s = cb + (tl + 1) * 384;
                        nr = *(const f32x4*)(s); nw = *(const f32x4*)(s + 64); nk = *(const f32x4*)(s + 128); na = *(const f32x4*)(s + 256); nb = *(const f32x4*)(s + 320);
                        nv = vb[(tl + 1) * 384];
                    }
                    __builtin_amdgcn_sched_barrier(0);
                    f32x2 pa = Sa * (f32x2){a4.x, a4.y};
                    pa = __builtin_elementwise_fma(Sb, (f32x2){a4.z, a4.w}, pa);
                    const float sa = sum16(pa.x + pa.y);
                    const f32x2 ta = __builtin_elementwise_fma((f32x2){k4.x, k4.y}, (f32x2){vv, vv}, (f32x2){b4.x, b4.y} * sa);
                    const f32x2 tb = __builtin_elementwise_fma((f32x2){k4.z, k4.w}, (f32x2){vv, vv}, (f32x2){b4.z, b4.w} * sa);
                    Sa = __builtin_elementwise_fma(Sa, (f32x2){w4.x, w4.y}, ta);
                    Sb = __builtin_elementwise_fma(Sb, (f32x2){w4.z, w4.w}, tb);
                    f32x2 py = Sa * (f32x2){r4.x, r4.y};
                    py = __builtin_elementwise_fma(Sb, (f32x2){r4.z, r4.w}, py);
                    const float y = sum16(py.x + py.y);
                    ykeep = (q == (tl & 15)) ? y : ykeep;
                    if ((tl & 15) == 15) ybase[(size_t)(c * RW_TC + (tl - 15) + q) * 1024] = ykeep;
                    __builtin_amdgcn_sched_barrier(0);
                    r4 = nr; w4 = nw; k4 = nk; a4 = na; b4 = nb; vv = nv;
                }
                __syncthreads();
            }
        }
    }
}

constexpr int RC = 16, RNCH = SEQ_T / RC;
constexpr int RS_AT = 0, RS_RT = 2048, RS_BKT = 4096, RS_AKP = 8192, RS_BRP = 9216, RS_TP = 10240, RS_VT = 11264, RS_WC = 11776, RS_SLOT = 12032;
constexpr int RS_SCR = 8 * RS_SLOT, RS_ST = RS_SCR + 7 * 4096;
static_assert(RS_ST + 16 * 72 * 2 + 128 <= LDS_STAGE, "rwkv chunk LDS overflow");
__device__ __forceinline__ float wave_sum64(float x) {
    x = sum16(x);
    unsigned xi = __float_as_uint(x);
    const auto r = __builtin_amdgcn_permlane16_swap(xi, xi, false, false);
    x = __uint_as_float(r[0]) + __uint_as_float(r[1]);
    xi = __float_as_uint(x);
    const auto r2 = __builtin_amdgcn_permlane32_swap(xi, xi, false, false);
    return __uint_as_float(r2[0]) + __uint_as_float(r2[1]);
}
__device__ __forceinline__ bf16x8 mk_frag(unsigned a, unsigned b, unsigned c, unsigned d) { const uint4 u = make_uint4(a, b, c, d); return __builtin_bit_cast(bf16x8, u); }
template <int L0, int L1>
__device__ __forceinline__ void rw_pair(float& acc0, float& acc1, int g0, int g1, float tr0, float tr1) {
    int t0, t1;
    asm volatile("v_readlane_b32 %2, %4, %8\n\tv_readlane_b32 %3, %5, %9\n\tv_fmac_f32 %0, %2, %6\n\tv_fmac_f32 %1, %3, %7"
                 : "+v"(acc0), "+v"(acc1), "=&s"(t0), "=&s"(t1) : "v"(g0), "v"(g1), "v"(tr0), "v"(tr1), "n"(L0), "n"(L1));
}
template <int L>
__device__ __forceinline__ float rw_nfetch(int g, float dep) {
    int r;
    asm volatile("v_readlane_b32 %0, %1, %2\n\ts_nop 0" : "=s"(r) : "v"(g), "n"(L), "v"(dep));
    return __int_as_float(r);
}
struct RwStg {
    float W, pr, pk, pv;
    float bt[16], kt[16];
    unsigned short nr[4], nk[4], nv[4], na[4]; float nw[4];
    unsigned short ppr, ppk, ppv;
    int gx, gy, gz, gw;
};
__device__ __forceinline__ void rwkv_chunk_phase(const Params& p, char* smem) {
    const bf16_t* P = (const bf16_t*)(p.ws + OFF_P);
    const float* Wd = (const float*)(p.ws + OFF_X);
    const unsigned short* Ai = (const unsigned short*)(p.ws + OFF_Y);
    float* Y = p.out;
    const float* mu = p.in[4]; const float* k_k = p.in[9]; const float* k_a = p.in[10];
    const int tid = otid(), lane = tid & 63, wid = __builtin_amdgcn_readfirstlane(tid >> 6), fr = lane & 15, fq = lane >> 4;
    for (int unit = blockIdx.x; unit < 256; unit += gridDim.x) {
        const int bh = unit >> 2, rg = unit & 3, b = bh >> 4, h = bh & 15;
        const size_t tokbase = (size_t)b * SEQ_T;
        __syncthreads();
        f32x4 accS[4];
#pragma unroll
        for (int i = 0; i < 4; ++i) accS[i] = (f32x4){0.f, 0.f, 0.f, 0.f};
        RwStg st; st.W = 1.f; st.pr = 0.f; st.pk = 0.f; st.pv = 0.f;
        const int col = h * 64 + lane;
        const float mur = mu[col], muk = mu[1024 + col], muv = mu[2048 + col], kkc = k_k[col], kac = k_a[col];
        const int sw = wid - 1;
        bf16_t* BTs = (bf16_t*)(smem + RS_SCR + (sw < 0 ? 0 : sw) * 4096);
        bf16_t* KTs = BTs + 1024;
        const bf16_t* Pl = P + tokbase * RW_COLS + col; const float* Wl = Wd + tokbase * 1024 + col; const unsigned short* Al = Ai + tokbase * 1024 + col;
#define RW_LD(S, TOK) do { const unsigned tr_ = (unsigned)__builtin_amdgcn_readfirstlane((int)((TOK) - tokbase)); const bf16_t* pr_ = Pl + tr_ * (unsigned)RW_COLS; st.nr[S] = pr_[0]; st.nk[S] = pr_[1024]; st.nv[S] = pr_[2048]; \
            st.nw[S] = Wl[tr_ * 1024u]; st.na[S] = Al[tr_ * 1024u]; } while (0)
#define RW_LDPREV(CH) do { const int ch_ = (CH); const unsigned tr_ = (unsigned)__builtin_amdgcn_readfirstlane(ch_ > 0 ? ch_ * RC - 1 : 0); const bf16_t* pp_ = Pl + tr_ * (unsigned)RW_COLS; \
            st.ppr = pp_[0]; st.ppk = pp_[1024]; st.ppv = pp_[2048]; } while (0)
        if (wid == 0) {
            for (int i = lane; i < 16 * 72 / 2; i += 64) *(unsigned*)(smem + RS_ST + i * 4) = 0u;
        } else {
            const int c0 = (sw < RNCH) ? sw : RNCH - 1;
            RW_LD(0, tokbase + (size_t)c0 * RC + 0); RW_LD(1, tokbase + (size_t)c0 * RC + 1); RW_LD(2, tokbase + (size_t)c0 * RC + 2); RW_LD(3, tokbase + (size_t)c0 * RC + 3); RW_LDPREV(c0);
        }
        __syncthreads();
        if (wid == 0) {
            for (int per = 0; per < RNCH + 7; ++per) {
                const int c = per - 7;
                if (c >= 0) {
                    const char* sl = smem + (c & 7) * RS_SLOT;
                    const bf16_t* STr = (const bf16_t*)(smem + RS_ST) + fr * 72 + fq * 8;
                    const bf16x8 st0 = *(const bf16x8*)(STr), st1 = *(const bf16x8*)(STr + 32);
                    const bf16_t* ATr = (const bf16_t*)(sl + RS_AT) + fr * 64 + fq * 8;
                    const bf16x8 a0 = *(const bf16x8*)(ATr), a1 = *(const bf16x8*)(ATr + 32);
                    const bf16_t* RTr = (const bf16_t*)(sl + RS_RT) + fr * 64 + fq * 8;
                    const bf16x8 r0 = *(const bf16x8*)(RTr), r1 = *(const bf16x8*)(RTr + 32);
                    const bf16x8 akp = *(const bf16x8*)((const bf16_t*)(sl + RS_AKP) + fr * 32 + fq * 8);
                    const bf16x8 brp = *(const bf16x8*)((const bf16_t*)(sl + RS_BRP) + fr * 32 + fq * 8);
                    const bf16x8 tpf = *(const bf16x8*)((const bf16_t*)(sl + RS_TP) + fr * 32 + fq * 8);
                    const uint2 vt = *(const uint2*)((const bf16_t*)(sl + RS_VT) + fr * 16 + fq * 4);
                    bf16x8 bk[4]; f32x4 wc4[4];
#pragma unroll
                    for (int kt = 0; kt < 4; ++kt) { bk[kt] = *(const bf16x8*)((const bf16_t*)(sl + RS_BKT) + (kt * 16 + fr) * 32 + fq * 8); wc4[kt] = *(const f32x4*)((const float*)(sl + RS_WC) + kt * 16 + fq * 4); }
                    f32x4 u = {0.f, 0.f, 0.f, 0.f};
                    u = __builtin_amdgcn_mfma_f32_16x16x32_bf16(a0, st0, u, 0, 0, 0);
                    u = __builtin_amdgcn_mfma_f32_16x16x32_bf16(a1, st1, u, 0, 0, 0);
                    u = __builtin_amdgcn_mfma_f32_16x16x32_bf16(akp, mk_frag(vt.x, vt.y, 0u, 0u), u, 0, 0, 0);
                    f32x4 sv = {0.f, 0.f, 0.f, 0.f};
                    sv = __builtin_amdgcn_mfma_f32_16x16x32_bf16(tpf, mk_frag(pack2bf(u.x, u.y), pack2bf(u.z, u.w), 0u, 0u), sv, 0, 0, 0);
                    const bf16x8 f3 = mk_frag(pack2bf(sv.x, sv.y), pack2bf(sv.z, sv.w), vt.x, vt.y);
                    f32x4 yv = {0.f, 0.f, 0.f, 0.f};
                    yv = __builtin_amdgcn_mfma_f32_16x16x32_bf16(st0, r0, yv, 0, 0, 0);
                    yv = __builtin_amdgcn_mfma_f32_16x16x32_bf16(st1, r1, yv, 0, 0, 0);
                    yv = __builtin_amdgcn_mfma_f32_16x16x32_bf16(f3, brp, yv, 0, 0, 0);
                    *(f32x4*)(Y + (tokbase + (size_t)c * RC + fr) * 1024 + h * 64 + rg * 16 + fq * 4) = yv;
#pragma unroll
                    for (int kt = 0; kt < 4; ++kt) {
                        accS[kt] = accS[kt] * wc4[kt];
                        accS[kt] = __builtin_amdgcn_mfma_f32_16x16x32_bf16(bk[kt], f3, accS[kt], 0, 0, 0);
                        uint2 pk; pk.x = pack2bf(accS[kt].x, accS[kt].y); pk.y = pack2bf(accS[kt].z, accS[kt].w);
                        *(uint2*)((bf16_t*)(smem + RS_ST) + fr * 72 + kt * 16 + fq * 4) = pk;
                    }
                }
                __syncthreads();
            }
        } else {
            for (int per = 0; per < RNCH + 7; ++per) {
                const int q = per - sw;
                const int c = (q >= 0) ? 7 * (q / 7) + sw : RNCH;
                if (c < RNCH) {
                    const int part = q % 7;
                    char* sl = smem + (c & 7) * RS_SLOT;
                    bf16_t* ATw = (bf16_t*)(sl + RS_AT); bf16_t* RTw = (bf16_t*)(sl + RS_RT);
                    const size_t tok0 = tokbase + (size_t)c * RC;
                    unsigned short cr[4], ck[4], cv[4], ca[4]; float cw[4];
#pragma unroll
                    for (int i = 0; i < 4; ++i) { cr[i] = st.nr[i]; ck[i] = st.nk[i]; cv[i] = st.nv[i]; ca[i] = st.na[i]; cw[i] = st.nw[i]; }
#define RW_TS(J, S) do { const float r0_ = bf2f(cr[S]), k0_ = bf2f(ck[S]), v0_ = bf2f(cv[S]); const float w_ = cw[S], a_ = h2f(ca[S]); \
                        const float r1_ = r0_ + (st.pr - r0_) * mur, k1_ = k0_ + (st.pk - k0_) * muk, v1_ = v0_ + (st.pv - v0_) * muv; st.pr = r0_; st.pk = k0_; st.pv = v0_; \
                        const float kkv_ = k1_ * kkc; const float n2_ = wave_sum64(kkv_ * kkv_); const float kk_ = kkv_ * rsqrtf(fmaxf(n2_, 1e-24f)); \
                        const float k2_ = k1_ * (1.f + (a_ - 1.f) * kac); \
                        const float at_ = -kk_ * st.W; st.W *= w_; const float rt_ = r1_ * st.W; const float iw_ = __builtin_amdgcn_rcpf(st.W); \
                        const float bt_ = kk_ * a_ * iw_, kt_ = k2_ * iw_; st.bt[J] = bt_; st.kt[J] = kt_; \
                        ATw[(J) * 64 + lane] = f2bf(at_); RTw[(J) * 64 + lane] = f2bf(rt_); BTs[(J) * 64 + lane] = f2bf(bt_); KTs[(J) * 64 + lane] = f2bf(kt_); \
                        *((fq == rg) ? ((bf16_t*)(sl + RS_VT) + fr * 16 + (J)) : ((bf16_t*)(smem + RS_ST + 2304) + lane)) = f2bf(v1_); } while (0)
                    switch (part) {
                    case 0: {
                        RW_LD(0, tok0 + 4); RW_LD(1, tok0 + 5); RW_LD(2, tok0 + 6); RW_LD(3, tok0 + 7);
                        st.W = 1.f;
                        if (c > 0) { st.pr = bf2f(st.ppr); st.pk = bf2f(st.ppk); st.pv = bf2f(st.ppv); } else { st.pr = 0.f; st.pk = 0.f; st.pv = 0.f; }
                        RW_TS(0, 0); RW_TS(1, 1); RW_TS(2, 2); RW_TS(3, 3);
                    } break;
                    case 1: { RW_LD(0, tok0 + 8); RW_LD(1, tok0 + 9); RW_LD(2, tok0 + 10); RW_LD(3, tok0 + 11); RW_TS(4, 0); RW_TS(5, 1); RW_TS(6, 2); RW_TS(7, 3); } break;
                    case 2: { RW_LD(0, tok0 + 12); RW_LD(1, tok0 + 13); RW_LD(2, tok0 + 14); RW_LD(3, tok0 + 15); RW_TS(8, 0); RW_TS(9, 1); RW_TS(10, 2); RW_TS(11, 3); } break;
                    case 3: {
                        RW_TS(12, 0); RW_TS(13, 1); RW_TS(14, 2); RW_TS(15, 3);
                        const float WC = st.W;
                        ((float*)(sl + RS_WC))[lane] = WC;
                        bf16_t* BKw = (bf16_t*)(sl + RS_BKT) + lane * 32;
#define RW_BKG(G) do { uint4 o; \
                            o.x = pack2bf(st.bt[4 * (G) + 0] * WC, st.bt[4 * (G) + 1] * WC); o.y = pack2bf(st.bt[4 * (G) + 2] * WC, st.bt[4 * (G) + 3] * WC); \
                            o.z = pack2bf(st.kt[4 * (G) + 0] * WC, st.kt[4 * (G) + 1] * WC); o.w = pack2bf(st.kt[4 * (G) + 2] * WC, st.kt[4 * (G) + 3] * WC); \
                            *(uint4*)(BKw + (G) * 8) = o; } while (0)
                        RW_BKG(0); RW_BKG(1); RW_BKG(2); RW_BKG(3);
#undef RW_BKG
                    } break;
                    case 4: {
                        const bf16_t* ATr = ATw + fr * 64 + fq * 8; const bf16_t* RTr = RTw + fr * 64 + fq * 8; const bf16_t* BTr = BTs + fr * 64 + fq * 8; const bf16_t* KTr = KTs + fr * 64 + fq * 8;
                        const bf16x8 a0 = *(const bf16x8*)(ATr), a1 = *(const bf16x8*)(ATr + 32), r0 = *(const bf16x8*)(RTr), r1 = *(const bf16x8*)(RTr + 32);
                        const bf16x8 b0 = *(const bf16x8*)(BTr), b1 = *(const bf16x8*)(BTr + 32), k0 = *(const bf16x8*)(KTr), k1 = *(const bf16x8*)(KTr + 32);
                        f32x4 gab = {0.f, 0.f, 0.f, 0.f}, gak = gab, grb = gab, grk = gab;
                        gab = __builtin_amdgcn_mfma_f32_16x16x32_bf16(b0, a0, gab, 0, 0, 0); gab = __builtin_amdgcn_mfma_f32_16x16x32_bf16(b1, a1, gab, 0, 0, 0);
                        gak = __builtin_amdgcn_mfma_f32_16x16x32_bf16(k0, a0, gak, 0, 0, 0); gak = __builtin_amdgcn_mfma_f32_16x16x32_bf16(k1, a1, gak, 0, 0, 0);
                        grb = __builtin_amdgcn_mfma_f32_16x16x32_bf16(b0, r0, grb, 0, 0, 0); grb = __builtin_amdgcn_mfma_f32_16x16x32_bf16(b1, r1, grb, 0, 0, 0);
                        grk = __builtin_amdgcn_mfma_f32_16x16x32_bf16(k0, r0, grk, 0, 0, 0); grk = __builtin_amdgcn_mfma_f32_16x16x32_bf16(k1, r1, grk, 0, 0, 0);
                        const int j0 = fq * 4;
                        gab.x = (j0 + 0 < fr) ? gab.x : 0.f; gab.y = (j0 + 1 < fr) ? gab.y : 0.f; gab.z = (j0 + 2 < fr) ? gab.z : 0.f; gab.w = (j0 + 3 < fr) ? gab.w : 0.f;
                        gak.x = (j0 + 0 < fr) ? gak.x : 0.f; gak.y = (j0 + 1 < fr) ? gak.y : 0.f; gak.z = (j0 + 2 < fr) ? gak.z : 0.f; gak.w = (j0 + 3 < fr) ? gak.w : 0.f;
                        grb.x = (j0 + 0 <= fr) ? grb.x : 0.f; grb.y = (j0 + 1 <= fr) ? grb.y : 0.f; grb.z = (j0 + 2 <= fr) ? grb.z : 0.f; grb.w = (j0 + 3 <= fr) ? grb.w : 0.f;
                        grk.x = (j0 + 0 <= fr) ? grk.x : 0.f; grk.y = (j0 + 1 <= fr) ? grk.y : 0.f; grk.z = (j0 + 2 <= fr) ? grk.z : 0.f; grk.w = (j0 + 3 <= fr) ? grk.w : 0.f;
                        *(uint4*)((bf16_t*)(sl + RS_AKP) + fr * 32 + fq * 8) = make_uint4(pack2bf(gak.x, gak.y), pack2bf(gak.z, gak.w), 0u, 0u);
                        *(uint4*)((bf16_t*)(sl + RS_BRP) + fr * 32 + fq * 8) = make_uint4(pack2bf(grb.x, grb.y), pack2bf(grb.z, grb.w), pack2bf(grk.x, grk.y), pack2bf(grk.z, grk.w));
                        st.gx = __float_as_int(gab.x); st.gy = __float_as_int(gab.y); st.gz = __float_as_int(gab.z); st.gw = __float_as_int(gab.w);
                    } break;
#define RW_GSEL(J) ((((J) & 3) == 0) ? st.gx : ((((J) & 3) == 1) ? st.gy : ((((J) & 3) == 2) ? st.gz : st.gw)))
#define RW_TJ(T, J) do { if ((J) < (T)) acc = fmaf(rw_nfetch<(T) + 16 * ((J) >> 2)>(RW_GSEL(J), acc), Tr[(J)], acc); } while (0)
#define RW_TROW(T) do { float acc = ((T) == fr) ? 1.f : 0.f; RW_TJ(T, 0); RW_TJ(T, 1); RW_TJ(T, 2); RW_TJ(T, 3); RW_TJ(T, 4); RW_TJ(T, 5); RW_TJ(T, 6); RW_TJ(T, 7); \
                        RW_TJ(T, 8); RW_TJ(T, 9); RW_TJ(T, 10); RW_TJ(T, 11); RW_TJ(T, 12); RW_TJ(T, 13); RW_TJ(T, 14); RW_TJ(T, 15); Tr[(T)] = acc; } while (0)
                    case 5: {
                        float Tr[16];
                        RW_TROW(0); RW_TROW(1); RW_TROW(2); RW_TROW(3); RW_TROW(4); RW_TROW(5); RW_TROW(6); RW_TROW(7); RW_TROW(8); RW_TROW(9); RW_TROW(10);
                        float* TS_ = (float*)BTs + lane;
#define RW_TSV(T) TS_[(T) * 64] = Tr[(T)]
                        RW_TSV(0); RW_TSV(1); RW_TSV(2); RW_TSV(3); RW_TSV(4); RW_TSV(5); RW_TSV(6); RW_TSV(7); RW_TSV(8); RW_TSV(9); RW_TSV(10);
#undef RW_TSV
                    } break;
                    default: {
                        { const int cn = (c + 7 < RNCH) ? c + 7 : c; const size_t tn = tokbase + (size_t)cn * RC; RW_LD(0, tn + 0); RW_LD(1, tn + 1); RW_LD(2, tn + 2); RW_LD(3, tn + 3); RW_LDPREV(cn); }
                        float Tr[16];
                        const float* TS_ = (const float*)BTs + lane;
#define RW_TLD(T) Tr[(T)] = TS_[(T) * 64]
                        RW_TLD(0); RW_TLD(1); RW_TLD(2); RW_TLD(3); RW_TLD(4); RW_TLD(5); RW_TLD(6); RW_TLD(7); RW_TLD(8); RW_TLD(9); RW_TLD(10);
#undef RW_TLD
                        RW_TROW(11); RW_TROW(12); RW_TROW(13); RW_TROW(14); RW_TROW(15);
                        if (fq < 2) {
                            bf16_t* TPw = (bf16_t*)(sl + RS_TP) + (fr >> 2) * 8 + (fr & 3) + fq * 4;
#define RW_TPW(T) TPw[(T) * 32] = (fq == 0) ? f2bf(Tr[(T)]) : (bf16_t)0
                            RW_TPW(0); RW_TPW(1); RW_TPW(2); RW_TPW(3); RW_TPW(4); RW_TPW(5); RW_TPW(6); RW_TPW(7); RW_TPW(8); RW_TPW(9); RW_TPW(10); RW_TPW(11); RW_TPW(12); RW_TPW(13); RW_TPW(14); RW_TPW(15);
#undef RW_TPW
                        }
                    } break;
#undef RW_TROW
#undef RW_TJ
#undef RW_GSEL
                    }
#undef RW_TS
                }
                __syncthreads();
            }
        }
#undef RW_LD
#undef RW_LDPREV
    }
}

__device__ __forceinline__ float half_sum32(float v);
__device__ __forceinline__ void rwkv_elem_phase(const Params& p) {
    bf16_t* P = (bf16_t*)(p.ws + OFF_P);
    float* Wd = (float*)(p.ws + OFF_X);
    unsigned short* Ai = (unsigned short*)(p.ws + OFF_Y);
    bf16_t* KT2 = (bf16_t*)p.out + (size_t)M_TOK * 1024;
    float* BON = (float*)(p.ws + OFF_LIN);
    const float* mu = p.in[4]; const float* k_k = p.in[9]; const float* k_a = p.in[10]; const float* r_k = p.in[11];
    const int tid = otid(), lane = tid & 63, wid = __builtin_amdgcn_readfirstlane(tid >> 6);
    const int gw = blockIdx.x * 8 + wid, ngw = gridDim.x * 8;
    for (int u = gw; u < 64 * RNCH; u += ngw) {
        const int bh = u >> 9, c = u & (RNCH - 1), b = bh >> 4, h = bh & 15, col = h * 64 + lane;
        const size_t tok0 = (size_t)b * SEQ_T + (size_t)c * RC;
        const float mur = mu[col], muk = mu[1024 + col], kkc = k_k[col], kac = k_a[col], rkc = r_k[col];
        unsigned short rr[16], rk[16], ra[16]; float rw[16];
        const bf16_t* pr = P + tok0 * RW_COLS + col;
        const bf16_t* pp = (c > 0) ? pr - RW_COLS : pr;
        const unsigned short p0r = pp[0], p0k = pp[1024];
#pragma unroll
        for (int j = 0; j < 16; ++j) { rr[j] = pr[(size_t)j * RW_COLS]; rk[j] = pr[(size_t)j * RW_COLS + 1024]; rw[j] = Wd[(tok0 + j) * 1024 + col]; ra[j] = Ai[(tok0 + j) * 1024 + col]; }
        asm volatile("s_waitcnt vmcnt(0)" ::: "memory");
        float W = 1.f, prv = (c > 0) ? bf2f(p0r) : 0.f, pkv = (c > 0) ? bf2f(p0k) : 0.f;
#pragma unroll
        for (int j = 0; j < 16; ++j) {
            const float r0 = bf2f(rr[j]), k0 = bf2f(rk[j]), w = rw[j], a = h2f(ra[j]);
            const float r1 = r0 + (prv - r0) * mur, k1 = k0 + (pkv - k0) * muk; prv = r0; pkv = k0;
            const float kkv = k1 * kkc; const float n2 = wave_sum64(kkv * kkv); const float kk = kkv * rsqrtf(fmaxf(n2, 1e-24f));
            const float k2 = k1 * (1.f + (a - 1.f) * kac);
            const float bon = wave_sum64(r1 * k2 * rkc);
            const float at = -kk * W; W *= w; const float rt = r1 * W; const float iw = __builtin_amdgcn_rcpf(W);
            const float bt = kk * a * iw, kt = k2 * iw;
            bf16_t* ar = (bf16_t*)(Wd + (tok0 + j) * 1024 + h * 64);
            ar[lane] = f2bf(at); ar[64 + lane] = f2bf(rt);
            Ai[(tok0 + j) * 1024 + col] = f2bf(bt);
            KT2[(tok0 + j) * 1024 + col] = f2bf(kt);
            if (lane == 0) BON[(tok0 + j) * 16 + h] = bon;
        }
        ((float*)(P + (tok0 + h) * RW_COLS + 3072))[lane] = W;
    }
}
#ifndef XLAS
#define XLAS __attribute__((address_space(3)))
#endif
struct RwStg2 { int gx, gy, gz, gw; };
__device__ __forceinline__ void rwkv_chunk2_phase(const Params& p, char* smem) {
    const bf16_t* P = (const bf16_t*)(p.ws + OFF_P);
    const char* WdB = (const char*)(p.ws + OFF_X);
    const bf16_t* BT2 = (const bf16_t*)(p.ws + OFF_Y);
    const bf16_t* KT2 = (const bf16_t*)p.out + (size_t)M_TOK * 1024;
    bf16_t* Yb = (bf16_t*)p.out;
    const float* mu = p.in[4];
    const int tid = otid(), lane = tid & 63, wid = __builtin_amdgcn_readfirstlane(tid >> 6), fr = lane & 15, fq = lane >> 4;
    for (int unit = blockIdx.x; unit < 256; unit += gridDim.x) {
        const int xcd_ = unit & 7, idx_ = unit >> 3;
        const int bh = xcd_ * 8 + (idx_ >> 2), rg = idx_ & 3, b = bh >> 4, h = bh & 15;
        const size_t tokbase = (size_t)b * SEQ_T;
        __syncthreads();
        f32x4 accS[4];
#pragma unroll
        for (int i = 0; i < 4; ++i) accS[i] = (f32x4){0.f, 0.f, 0.f, 0.f};
        RwStg2 st; st.gx = 0; st.gy = 0; st.gz = 0; st.gw = 0;
        const int sw = wid - 1;
        const int scr_off = RS_SCR + (sw < 0 ? 0 : sw) * 4096;
        bf16_t* BTs = (bf16_t*)(smem + scr_off);
        bf16_t* KTs = BTs + 1024;
        const float muv = mu[2048 + h * 64 + rg * 16 + fr];
        if (wid == 0) {
            for (int i = lane; i < 16 * 72 / 2; i += 64) *(unsigned*)(smem + RS_ST + i * 4) = 0u;
        }
        __syncthreads();
        if (wid == 0) {
            __builtin_amdgcn_s_setprio(2);
            bf16x8 pa0 = {}, pa1 = {}, pr0 = {}, pr1 = {}, pakp = {}, pbrp = {}; uint2 pvt = make_uint2(0u, 0u); bf16x8 pbk[4] = {}; f32x4 pwc[4] = {};
            for (int per = 0; per < RNCH + 7; ++per) {
                const int c = per - 7;
                if (c >= 0) {
                    const char* sl = smem + (c & 7) * RS_SLOT;
                    const bf16_t* STr = (const bf16_t*)(smem + RS_ST) + fr * 72 + fq * 8;
                    const bf16x8 st0 = *(const bf16x8*)(STr), st1 = *(const bf16x8*)(STr + 32);
                    const bf16x8 tpf = *(const bf16x8*)((const bf16_t*)(sl + RS_TP) + fr * 32 + fq * 8);
                    const bf16x8 a0 = pa0, a1 = pa1, r0 = pr0, r1 = pr1, akp = pakp, brp = pbrp; const uint2 vt = pvt;
                    f32x4 u = {0.f, 0.f, 0.f, 0.f};
                    u = __builtin_amdgcn_mfma_f32_16x16x32_bf16(a0, st0, u, 0, 0, 0);
                    u = __builtin_amdgcn_mfma_f32_16x16x32_bf16(a1, st1, u, 0, 0, 0);
                    u = __builtin_amdgcn_mfma_f32_16x16x32_bf16(akp, mk_frag(vt.x, vt.y, 0u, 0u), u, 0, 0, 0);
                    f32x4 sv = {0.f, 0.f, 0.f, 0.f};
                    sv = __builtin_amdgcn_mfma_f32_16x16x32_bf16(tpf, mk_frag(pack2bf(u.x, u.y), pack2bf(u.z, u.w), 0u, 0u), sv, 0, 0, 0);
                    const bf16x8 f3 = mk_frag(pack2bf(sv.x, sv.y), pack2bf(sv.z, sv.w), vt.x, vt.y);
                    f32x4 yv = {0.f, 0.f, 0.f, 0.f};
                    yv = __builtin_amdgcn_mfma_f32_16x16x32_bf16(st0, r0, yv, 0, 0, 0);
                    yv = __builtin_amdgcn_mfma_f32_16x16x32_bf16(st1, r1, yv, 0, 0, 0);
                    yv = __builtin_amdgcn_mfma_f32_16x16x32_bf16(f3, brp, yv, 0, 0, 0);
                    { uint2 py; py.x = pack2bf(yv.x, yv.y); py.y = pack2bf(yv.z, yv.w); *(uint2*)(Yb + (tokbase + (size_t)c * RC + fr) * 1024 + h * 64 + rg * 16 + fq * 4) = py; }
#pragma unroll
                    for (int kt = 0; kt < 4; ++kt) {
                        accS[kt] = accS[kt] * pwc[kt];
                        accS[kt] = __builtin_amdgcn_mfma_f32_16x16x32_bf16(pbk[kt], f3, accS[kt], 0, 0, 0);
                        uint2 pk; pk.x = pack2bf(accS[kt].x, accS[kt].y); pk.y = pack2bf(accS[kt].z, accS[kt].w);
                        *(uint2*)((bf16_t*)(smem + RS_ST) + fr * 72 + kt * 16 + fq * 4) = pk;
                    }
                }
                if (c + 1 >= 0 && c + 1 < RNCH) {
                    const char* sn = smem + ((c + 1) & 7) * RS_SLOT;
                    const bf16_t* ATr = (const bf16_t*)(sn + RS_AT) + fr * 128;
                    pa0 = *(const bf16x8*)(ATr + ((fq) ^ fr) * 8); pa1 = *(const bf16x8*)(ATr + ((4 + fq) ^ fr) * 8);
                    pr0 = *(const bf16x8*)(ATr + ((8 + fq) ^ fr) * 8); pr1 = *(const bf16x8*)(ATr + ((12 + fq) ^ fr) * 8);
                    pakp = *(const bf16x8*)((const bf16_t*)(sn + RS_AKP) + fr * 32 + fq * 8);
                    pbrp = *(const bf16x8*)((const bf16_t*)(sn + RS_BRP) + fr * 32 + fq * 8);
                    pvt = *(const uint2*)((const bf16_t*)(sn + RS_VT) + fr * 16 + fq * 4);
#pragma unroll
                    for (int kt = 0; kt < 4; ++kt) { pbk[kt] = *(const bf16x8*)((const bf16_t*)(sn + RS_BKT) + (kt * 16 + fr) * 32 + fq * 8); pwc[kt] = *(const f32x4*)((const float*)(sn + RS_WC) + kt * 16 + fq * 4); }
                }
                asm volatile("s_waitcnt lgkmcnt(0)" ::: "memory"); __builtin_amdgcn_s_barrier(); asm volatile("" ::: "memory");
            }
            __builtin_amdgcn_s_setprio(0);
        } else {
            for (int per = 0; per < RNCH + 7; ++per) {
                const int q = per - sw;
                const int c = (q >= 0) ? 7 * (q / 7) + sw : RNCH;
                if (c < RNCH) {
                    const int part = q % 7;
                    const int sl_off = (c & 7) * RS_SLOT;
                    char* sl = smem + sl_off;
                    bf16_t* ATw = (bf16_t*)(sl + RS_AT);
                    switch (part) {
                    case 0: {
                        const size_t t0 = tokbase + (size_t)c * RC;
#pragma unroll
                        for (int i = 0; i < 4; ++i)
                            __builtin_amdgcn_global_load_lds((const unsigned*)(WdB + ((t0 + i * 4 + fq) * 1024 + h * 64) * 4 + (fr ^ (i * 4 + fq)) * 16), (XLAS unsigned*)(smem + sl_off + RS_AT + i * 1024), 16, 0, 0);
#pragma unroll
                        for (int i = 0; i < 2; ++i) {
                            const size_t o = (t0 + i * 8 + (lane >> 3)) * 1024 + h * 64 + (lane & 7) * 8;
                            __builtin_amdgcn_global_load_lds((const unsigned*)(BT2 + o), (XLAS unsigned*)(smem + scr_off + i * 1024), 16, 0, 0);
                            __builtin_amdgcn_global_load_lds((const unsigned*)(KT2 + o), (XLAS unsigned*)(smem + scr_off + 2048 + i * 1024), 16, 0, 0);
                        }
                        __builtin_amdgcn_global_load_lds((const unsigned*)((const float*)(P + (t0 + h) * RW_COLS + 3072) + lane), (XLAS unsigned*)(smem + sl_off + RS_WC), 4, 0, 0);
#pragma unroll
                        for (int i = 0; i < 3; ++i) {
                            const int idx = i * 64 + lane; int row = idx >> 3; row = row > 16 ? 16 : row; const int dwq = idx & 7;
                            int tt = c * RC - 1 + row; tt = tt < 0 ? 0 : tt;
                            __builtin_amdgcn_global_load_lds((const unsigned*)(P + (tokbase + tt) * RW_COLS + 2048 + h * 64 + rg * 16 + dwq * 2), (XLAS unsigned*)(smem + sl_off + RS_TP + i * 256), 4, 0, 0);
                        }
                    } break;
                    case 1: break;
                    case 2: {
                        asm volatile("s_waitcnt vmcnt(0)" ::: "memory");
                    } break;
                    case 3: {
                        { const unsigned short* vr = (const unsigned short*)(sl + RS_TP) + (fq * 4) * 16 + fr;
                          const float pv = (c == 0 && fq == 0) ? 0.f : bf2f(vr[0]);
                          const float v0 = bf2f(vr[16]), v1 = bf2f(vr[32]), v2 = bf2f(vr[48]), v3 = bf2f(vr[64]);
                          uint2 o; o.x = pack2bf(v0 + (pv - v0) * muv, v1 + (v0 - v1) * muv); o.y = pack2bf(v2 + (v1 - v2) * muv, v3 + (v2 - v3) * muv);
                          *(uint2*)((bf16_t*)(sl + RS_VT) + fr * 16 + fq * 4) = o; }
                        const float WC = ((const float*)(sl + RS_WC))[lane];
                        bf16_t* BKw = (bf16_t*)(sl + RS_BKT) + lane * 32;
#define RW_BKG(G) do { uint4 o; \
                            o.x = pack2bf(bf2f(BTs[(4 * (G) + 0) * 64 + lane]) * WC, bf2f(BTs[(4 * (G) + 1) * 64 + lane]) * WC); o.y = pack2bf(bf2f(BTs[(4 * (G) + 2) * 64 + lane]) * WC, bf2f(BTs[(4 * (G) + 3) * 64 + lane]) * WC); \
                            o.z = pack2bf(bf2f(KTs[(4 * (G) + 0) * 64 + lane]) * WC, bf2f(KTs[(4 * (G) + 1) * 64 + lane]) * WC); o.w = pack2bf(bf2f(KTs[(4 * (G) + 2) * 64 + lane]) * WC, bf2f(KTs[(4 * (G) + 3) * 64 + lane]) * WC); \
                            *(uint4*)(BKw + (G) * 8) = o; } while (0)
                        RW_BKG(0); RW_BKG(1); RW_BKG(2); RW_BKG(3);
#undef RW_BKG
                    } break;
                    case 4: {
                        const bf16_t* ATr = ATw + fr * 128; const bf16_t* BTr = BTs + fr * 64 + fq * 8; const bf16_t* KTr = KTs + fr * 64 + fq * 8;
                        const bf16x8 a0 = *(const bf16x8*)(ATr + ((fq) ^ fr) * 8), a1 = *(const bf16x8*)(ATr + ((4 + fq) ^ fr) * 8), r0 = *(const bf16x8*)(ATr + ((8 + fq) ^ fr) * 8), r1 = *(const bf16x8*)(ATr + ((12 + fq) ^ fr) * 8);
                        const bf16x8 b0 = *(const bf16x8*)(BTr), b1 = *(const bf16x8*)(BTr + 32), k0 = *(const bf16x8*)(KTr), k1 = *(const bf16x8*)(KTr + 32);
                        f32x4 gab = {0.f, 0.f, 0.f, 0.f}, gak = gab, grb = gab, grk = gab;
                        gab = __builtin_amdgcn_mfma_f32_16x16x32_bf16(b0, a0, gab, 0, 0, 0); gab = __builtin_amdgcn_mfma_f32_16x16x32_bf16(b1, a1, gab, 0, 0, 0);
                        gak = __builtin_amdgcn_mfma_f32_16x16x32_bf16(k0, a0, gak, 0, 0, 0); gak = __builtin_amdgcn_mfma_f32_16x16x32_bf16(k1, a1, gak, 0, 0, 0);
                        grb = __builtin_amdgcn_mfma_f32_16x16x32_bf16(b0, r0, grb, 0, 0, 0); grb = __builtin_amdgcn_mfma_f32_16x16x32_bf16(b1, r1, grb, 0, 0, 0);
                        grk = __builtin_amdgcn_mfma_f32_16x16x32_bf16(k0, r0, grk, 0, 0, 0); grk = __builtin_amdgcn_mfma_f32_16x16x32_bf16(k1, r1, grk, 0, 0, 0);
                        const int j0 = fq * 4;
                        gab.x = (j0 + 0 < fr) ? gab.x : 0.f; gab.y = (j0 + 1 < fr) ? gab.y : 0.f; gab.z = (j0 + 2 < fr) ? gab.z : 0.f; gab.w = (j0 + 3 < fr) ? gab.w : 0.f;
                        gak.x = (j0 + 0 < fr) ? gak.x : 0.f; gak.y = (j0 + 1 < fr) ? gak.y : 0.f; gak.z = (j0 + 2 < fr) ? gak.z : 0.f; gak.w = (j0 + 3 < fr) ? gak.w : 0.f;
                        grb.x = (j0 + 0 <= fr) ? grb.x : 0.f; grb.y = (j0 + 1 <= fr) ? grb.y : 0.f; grb.z = (j0 + 2 <= fr) ? grb.z : 0.f; grb.w = (j0 + 3 <= fr) ? grb.w : 0.f;
                        grk.x = (j0 + 0 <= fr) ? grk.x : 0.f; grk.y = (j0 + 1 <= fr) ? grk.y : 0.f; grk.z = (j0 + 2 <= fr) ? grk.z : 0.f; grk.w = (j0 + 3 <= fr) ? grk.w : 0.f;
                        *(uint4*)((bf16_t*)(sl + RS_AKP) + fr * 32 + fq * 8) = make_uint4(pack2bf(gak.x, gak.y), pack2bf(gak.z, gak.w), 0u, 0u);
                        *(uint4*)((bf16_t*)(sl + RS_BRP) + fr * 32 + fq * 8) = make_uint4(pack2bf(grb.x, grb.y), pack2bf(grb.z, grb.w), pack2bf(grk.x, grk.y), pack2bf(grk.z, grk.w));
                        st.gx = __float_as_int(gab.x); st.gy = __float_as_int(gab.y); st.gz = __float_as_int(gab.z); st.gw = __float_as_int(gab.w);
                    } break;
#define RW_GSEL(J) ((((J) & 3) == 0) ? st.gx : ((((J) & 3) == 1) ? st.gy : ((((J) & 3) == 2) ? st.gz : st.gw)))
#define RW_TJ2(T, J) do { if ((J) + 1 < (T)) rw_pair<(T) + 16 * ((J) >> 2), (T) + 16 * (((J) + 1) >> 2)>(acc0, acc1, RW_GSEL(J), RW_GSEL((J) + 1), Tr[(J)], Tr[((J) + 1) & 15]); \
                        else if ((J) < (T)) acc0 = fmaf(rw_nfetch<(T) + 16 * ((J) >> 2)>(RW_GSEL(J), acc0), Tr[(J)], acc0); } while (0)
#define RW_TROW(T) do { float acc0 = ((T) == fr) ? 1.f : 0.f, acc1 = 0.f; RW_TJ2(T, 0); RW_TJ2(T, 2); RW_TJ2(T, 4); RW_TJ2(T, 6); RW_TJ2(T, 8); RW_TJ2(T, 10); RW_TJ2(T, 12); RW_TJ2(T, 14); \
                        Tr[(T)] = acc0 + acc1; (void)rowdep; } while (0)
                    case 5: {
                        float Tr[16]; float rowdep = 0.f;
                        RW_TROW(0); RW_TROW(1); RW_TROW(2); RW_TROW(3); RW_TROW(4); RW_TROW(5); RW_TROW(6); RW_TROW(7); RW_TROW(8); RW_TROW(9); RW_TROW(10);
                        float* TS_ = (float*)BTs + lane;
#define RW_TSV(T) TS_[(T) * 64] = Tr[(T)]
                        RW_TSV(0); RW_TSV(1); RW_TSV(2); RW_TSV(3); RW_TSV(4); RW_TSV(5); RW_TSV(6); RW_TSV(7); RW_TSV(8); RW_TSV(9); RW_TSV(10);
#undef RW_TSV
                    } break;
                    default: {
                        float Tr[16]; float rowdep = 0.f;
                        const float* TS_ = (const float*)BTs + lane;
#define RW_TLD(T) Tr[(T)] = TS_[(T) * 64]
                        RW_TLD(0); RW_TLD(1); RW_TLD(2); RW_TLD(3); RW_TLD(4); RW_TLD(5); RW_TLD(6); RW_TLD(7); RW_TLD(8); RW_TLD(9); RW_TLD(10);
#undef RW_TLD
                        RW_TROW(11); RW_TROW(12); RW_TROW(13); RW_TROW(14); RW_TROW(15);
                        if (fq < 2) {
                            bf16_t* TPw = (bf16_t*)(sl + RS_TP) + (fr >> 2) * 8 + (fr & 3) + fq * 4;
#define RW_TPW(T) TPw[(T) * 32] = (fq == 0) ? f2bf(Tr[(T)]) : (bf16_t)0
                            RW_TPW(0); RW_TPW(1); RW_TPW(2); RW_TPW(3); RW_TPW(4); RW_TPW(5); RW_TPW(6); RW_TPW(7); RW_TPW(8); RW_TPW(9); RW_TPW(10); RW_TPW(11); RW_TPW(12); RW_TPW(13); RW_TPW(14); RW_TPW(15);
#undef RW_TPW
                        }
                    } break;
#undef RW_TROW
#undef RW_TJ2
#undef RW_GSEL
                    }
                }
                asm volatile("s_waitcnt lgkmcnt(0)" ::: "memory"); __builtin_amdgcn_s_barrier(); asm volatile("" ::: "memory");
            }
        }
    }
}
__device__ __forceinline__ void rwkv_post2_phase(const Params& p) {
    const bf16_t* P = (const bf16_t*)(p.ws + OFF_P);
    const bf16_t* Yb = (const bf16_t*)p.out;
    const float* BON = (const float*)(p.ws + OFF_LIN);
    bf16_t* Z = (bf16_t*)(p.ws + OFF_X);
    const float* mu = p.in[4];
    const int ch = otid() * 2;
    const float mv0 = mu[2048 + ch], mv1 = mu[2049 + ch], mg0 = mu[3200 + ch], mg1 = mu[3201 + ch];
    const float gg0 = p.in[12][ch], gg1 = p.in[12][ch + 1], gb0 = p.in[13][ch], gb1 = p.in[13][ch + 1];
    for (int tok = blockIdx.x; tok < M_TOK; tok += gridDim.x) {
        const bf16_t* pr = P + (size_t)tok * RW_COLS + ch;
        const unsigned uv = *(const unsigned*)(pr + 2048), ug = *(const unsigned*)(pr + 3200);
        unsigned pv_ = 0u, pg_ = 0u;
        if ((tok & (SEQ_T - 1)) != 0) { const bf16_t* pp = pr - RW_COLS; pv_ = *(const unsigned*)(pp + 2048); pg_ = *(const unsigned*)(pp + 3200); }
        const unsigned yu = *(const unsigned*)(Yb + (size_t)tok * 1024 + ch);
        const float y0 = bflo(yu), y1 = bfhi(yu);
        const float sb = BON[(size_t)tok * 16 + (ch >> 6)];
        const float v0 = bflo(uv) + (bflo(pv_) - bflo(uv)) * mv0, v1 = bfhi(uv) + (bfhi(pv_) - bfhi(uv)) * mv1;
        const float g0 = bflo(ug) + (bflo(pg_) - bflo(ug)) * mg0, g1 = bfhi(ug) + (bfhi(pg_) - bfhi(ug)) * mg1;
        const float mean = half_sum32(y0 + y1) * (1.f / 64.f);
        const float d0 = y0 - mean, d1 = y1 - mean;
        const float var = half_sum32(d0 * d0 + d1 * d1) * (1.f / 64.f);
        const float rstd = rsqrtf(var + 64e-5f);
        const float o0 = (d0 * rstd * gg0 + gb0 + sb * v0) * siluf_(g0);
        const float o1 = (d1 * rstd * gg1 + gb1 + sb * v1) * siluf_(g1);
        *(unsigned*)(Z + (size_t)tok * 1024 + ch) = pack2bf(o0, o1);
    }
}

__device__ __forceinline__ float half_sum32(float v) {
#pragma unroll
    for (int o = 1; o < 32; o <<= 1) v += __shfl_xor(v, o);
    return v;
}
__device__ __forceinline__ void rwkv_post_phase(const Params& p) {
    const bf16_t* P = (const bf16_t*)(p.ws + OFF_P);
    const unsigned short* Ai = (const unsigned short*)(p.ws + OFF_Y);
    const float* Y = p.out;
    bf16_t* Z = (bf16_t*)(p.ws + OFF_X);
    const float* mu = p.in[4];
    const int ch = otid() * 2;
    const float mr0 = mu[ch], mr1 = mu[ch + 1], mk0 = mu[1024 + ch], mk1 = mu[1025 + ch], mv0 = mu[2048 + ch], mv1 = mu[2049 + ch], mg0 = mu[3200 + ch], mg1 = mu[3201 + ch];
    const float ka0 = p.in[10][ch], ka1 = p.in[10][ch + 1], rk0 = p.in[11][ch], rk1 = p.in[11][ch + 1];
    const float gg0 = p.in[12][ch], gg1 = p.in[12][ch + 1], gb0 = p.in[13][ch], gb1 = p.in[13][ch + 1];
    for (int tok = blockIdx.x; tok < M_TOK; tok += gridDim.x) {
        const bf16_t* pr = P + (size_t)tok * RW_COLS + ch;
        const unsigned ur = *(const unsigned*)(pr), uk = *(const unsigned*)(pr + 1024), uv = *(const unsigned*)(pr + 2048), ug = *(const unsigned*)(pr + 3200);
        unsigned pr_ = 0u, pk_ = 0u, pv_ = 0u, pg_ = 0u;
        if ((tok & (SEQ_T - 1)) != 0) { const bf16_t* pp = pr - RW_COLS; pr_ = *(const unsigned*)(pp); pk_ = *(const unsigned*)(pp + 1024); pv_ = *(const unsigned*)(pp + 2048); pg_ = *(const unsigned*)(pp + 3200); }
        const unsigned ua = *(const unsigned*)(Ai + (size_t)tok * 1024 + ch);
        const float a0 = h2f((unsigned short)(ua & 0xFFFFu)), a1 = h2f((unsigned short)(ua >> 16));
        const float2 y2 = *(const float2*)(Y + (size_t)tok * 1024 + ch);
        const float r0 = bflo(ur) + (bflo(pr_) - bflo(ur)) * mr0, r1 = bfhi(ur) + (bfhi(pr_) - bfhi(ur)) * mr1;
        float k0 = bflo(uk) + (bflo(pk_) - bflo(uk)) * mk0, k1 = bfhi(uk) + (bfhi(pk_) - bfhi(uk)) * mk1;
        const float v0 = bflo(uv) + (bflo(pv_) - bflo(uv)) * mv0, v1 = bfhi(uv) + (bfhi(pv_) - bfhi(uv)) * mv1;
        const float g0 = bflo(ug) + (bflo(pg_) - bflo(ug)) * mg0, g1 = bfhi(ug) + (bfhi(pg_) - bfhi(ug)) * mg1;
        k0 = k0 * (1.f + (a0 - 1.f) * ka0); k1 = k1 * (1.f + (a1 - 1.f) * ka1);
        const float mean = half_sum32(y2.x + y2.y) * (1.f / 64.f);
        const float d0 = y2.x - mean, d1 = y2.y - mean;
        const float var = half_sum32(d0 * d0 + d1 * d1) * (1.f / 64.f);
        const float rstd = rsqrtf(var + 64e-5f);
        const float sb = half_sum32(r0 * k0 * rk0 + r1 * k1 * rk1);
        const float o0 = (d0 * rstd * gg0 + gb0 + sb * v0) * siluf_(g0);
        const float o1 = (d1 * rstd * gg1 + gb1 + sb * v1) * siluf_(g1);
        *(unsigned*)(Z + (size_t)tok * 1024 + ch) = pack2bf(o0, o1);
    }
}

constexpr int HG_TC = 32, HG_STRIDE = 272;
struct HgRaw { uint4 q, k, v; };
__device__ __forceinline__ HgRaw hg_load_raw(const bf16_t* P, size_t tok, int h, int vg, int q) {
    HgRaw r;
    const bf16_t* pr = P + tok * 4096 + h * 128 + 8 * q;
    r.q = *(const uint4*)(pr); r.k = *(const uint4*)(pr + 1024);
    r.v = *(const uint4*)(P + tok * 4096 + 2048 + h * 128 + vg * 16 + 8 * (q & 1));
    return r;
}
__device__ __forceinline__ void hg_process(const HgRaw& x, float* d, int q) {
    *(f32x4*)(d + 8 * q) = (f32x4){bflo(x.q.x), bfhi(x.q.x), bflo(x.q.y), bfhi(x.q.y)};
    *(f32x4*)(d + 8 * q + 4) = (f32x4){bflo(x.q.z), bfhi(x.q.z), bflo(x.q.w), bfhi(x.q.w)};
    *(f32x4*)(d + 128 + 8 * q) = (f32x4){h2f((unsigned short)(x.k.x & 0xFFFFu)), h2f((unsigned short)(x.k.x >> 16)), h2f((unsigned short)(x.k.y & 0xFFFFu)), h2f((unsigned short)(x.k.y >> 16))};
    *(f32x4*)(d + 128 + 8 * q + 4) = (f32x4){h2f((unsigned short)(x.k.z & 0xFFFFu)), h2f((unsigned short)(x.k.z >> 16)), h2f((unsigned short)(x.k.w & 0xFFFFu)), h2f((unsigned short)(x.k.w >> 16))};
    if (q < 2) {
        *(f32x4*)(d + 256 + 8 * q) = (f32x4){bflo(x.v.x), bfhi(x.v.x), bflo(x.v.y), bfhi(x.v.y)};
        *(f32x4*)(d + 256 + 8 * q + 4) = (f32x4){bflo(x.v.z), bfhi(x.v.z), bflo(x.v.w), bfhi(x.v.w)};
    }
}
__device__ __forceinline__ void hgrn_scan_phase(const Params& p, char* smem) {
    float* buf = (float*)smem;
    const bf16_t* P = (const bf16_t*)(p.ws + OFF_P);
    float* O = (float*)(p.ws + OFF_X);
    const int tid = otid(), lane = tid & 63, wid = __builtin_amdgcn_readfirstlane(tid >> 6);
    constexpr int NCH = SEQ_T / HG_TC;
    const int sub = lane >> 4, q = lane & 15;
    for (int unit = blockIdx.x; unit < 256; unit += gridDim.x) {
        const int bh = unit >> 3, vg = unit & 7, b = bh >> 3, h = bh & 7;
        const size_t tokbase = (size_t)b * SEQ_T;
        __syncthreads();
        if (wid >= 4) {
            const int lw = wid - 4, tl0 = lw * 4 + sub, tl1 = 16 + lw * 4 + sub;
            HgRaw x0 = hg_load_raw(P, tokbase + tl0, h, vg, q), x1 = hg_load_raw(P, tokbase + tl1, h, vg, q);
            for (int c = -1; c < NCH; ++c) {
                if (c + 1 < NCH) {
                    const int cn = c + 1; float* db = buf + (cn & 1) * (HG_TC * HG_STRIDE);
                    hg_process(x0, db + tl0 * HG_STRIDE, q);
                    hg_process(x1, db + tl1 * HG_STRIDE, q);
                    if (cn + 1 < NCH) { x0 = hg_load_raw(P, tokbase + (cn + 1) * HG_TC + tl0, h, vg, q); x1 = hg_load_raw(P, tokbase + (cn + 1) * HG_TC + tl1, h, vg, q); }
                }
                __syncthreads();
            }
        } else {
            f32x2 S[4];
#pragma unroll
            for (int e = 0; e < 4; ++e) S[e] = (f32x2){0.f, 0.f};
            const int rowl = wid * 4 + sub;
            float* obase = O + tokbase * 1024 + h * 128 + vg * 16 + rowl;
            __syncthreads();
            for (int c = 0; c < NCH; ++c) {
                const float* cb = buf + (c & 1) * (HG_TC * HG_STRIDE) + q * 8;
                const float* vb = buf + (c & 1) * (HG_TC * HG_STRIDE) + 256 + rowl;
                f32x4 q0 = *(const f32x4*)(cb), q1 = *(const f32x4*)(cb + 4), k0 = *(const f32x4*)(cb + 128), k1 = *(const f32x4*)(cb + 132);
                float vv = vb[0];
                float okeep = 0.f;
#pragma unroll
                for (int tl = 0; tl < HG_TC; ++tl) {
                    f32x4 nq0 = q0, nq1 = q1, nk0 = k0, nk1 = k1; float nv = vv;
                    if (tl + 1 < HG_TC) {
                        const float* s = cb + (tl + 1) * HG_STRIDE;
                        nq0 = *(const f32x4*)(s); nq1 = *(const f32x4*)(s + 4); nk0 = *(const f32x4*)(s + 128); nk1 = *(const f32x4*)(s + 132);
                        nv = vb[(tl + 1) * HG_STRIDE];
                    }
                    __builtin_amdgcn_sched_barrier(0);
                    const f32x2 v2 = {vv, vv};
                    S[0] = __builtin_elementwise_fma((f32x2){k0.x, k0.y}, v2 - S[0], S[0]);
                    S[1] = __builtin_elementwise_fma((f32x2){k0.z, k0.w}, v2 - S[1], S[1]);
                    S[2] = __builtin_elementwise_fma((f32x2){k1.x, k1.y}, v2 - S[2], S[2]);
                    S[3] = __builtin_elementwise_fma((f32x2){k1.z, k1.w}, v2 - S[3], S[3]);
                    f32x2 po = S[0] * (f32x2){q0.x, q0.y};
                    f32x2 pp = S[1] * (f32x2){q0.z, q0.w};
                    po = __builtin_elementwise_fma(S[2], (f32x2){q1.x, q1.y}, po);
                    pp = __builtin_elementwise_fma(S[3], (f32x2){q1.z, q1.w}, pp);
                    po = po + pp;
                    const float o = sum16(po.x + po.y);
                    okeep = (q == (tl & 15)) ? o : okeep;
                    if ((tl & 15) == 15) obase[(size_t)(c * HG_TC + (tl - 15) + q) * 1024] = okeep;
                    __builtin_amdgcn_sched_barrier(0);
                    q0 = nq0; q1 = nq1; k0 = nk0; k1 = nk1; vv = nv;
                }
                __syncthreads();
            }
        }
    }
}
constexpr int HCK = 32;
constexpr size_t OFF_ATTG = OFF_X, OFF_DLG = OFF_X + 16 * MiB;
struct HcRaw { unsigned short q[8], k[8]; };
__device__ __forceinline__ void hc_load(HcRaw& r, const bf16_t* P, size_t tok0, int h, int tid) {
    const int k = tid & 127, tg = tid >> 7;
    const bf16_t* pr = P + (tok0 + tg * 8) * 4096 + h * 128 + k;
#pragma unroll
    for (int j = 0; j < 8; ++j) { r.q[j] = pr[(size_t)j * 4096]; r.k[j] = pr[(size_t)j * 4096 + 1024]; }
}
__device__ __forceinline__ void hgrn_prep_phase(const Params& p, char* smem) {
    bf16_t* P = (bf16_t*)(p.ws + OFF_P);
    bf16_t* ATTg = (bf16_t*)(p.ws + OFF_ATTG);
    float* DLg = (float*)(p.ws + OFF_DLG);
    const int tid = otid(), lane = tid & 63, wid = __builtin_amdgcn_readfirstlane(tid >> 6), fr = lane & 15, fq = lane >> 4;
    const int kch = tid & 127, tg = tid >> 7;
    float* TOT = (float*)(smem);
    bf16_t* QM = (bf16_t*)(smem + 4096);
    bf16_t* KM = (bf16_t*)(smem + 4096 + 8704);
    const int G = gridDim.x;
    __syncthreads();
    HcRaw rawA, rawB;
    {   const int u0 = blockIdx.x, u1 = blockIdx.x + G;
        const int u1c = (u1 < 8192) ? u1 : u0;
        hc_load(rawA, P, (size_t)(u0 >> 11) * SEQ_T + (size_t)(u0 & 255) * HCK, (u0 >> 8) & 7, tid);
        hc_load(rawB, P, (size_t)(u1c >> 11) * SEQ_T + (size_t)(u1c & 255) * HCK, (u1c >> 8) & 7, tid); }
#define HP_BODY(RAW, U) do { \
        const int u_ = (U); const int h_ = (u_ >> 8) & 7; const size_t tok0 = (size_t)(u_ >> 11) * SEQ_T + (size_t)(u_ & 255) * HCK; \
        float kf[8], l[8], qf[8]; \
        { float run = 0.f; _Pragma("unroll") for (int j = 0; j < 8; ++j) { kf[j] = h2f(RAW.k[j]); qf[j] = bf2f(RAW.q[j]); run += __logf(1.0f - kf[j]); l[j] = run; } } \
        { const int un = (u_ + 2 * G < 8192) ? u_ + 2 * G : u_; hc_load(RAW, P, (size_t)(un >> 11) * SEQ_T + (size_t)(un & 255) * HCK, (un >> 8) & 7, tid); } \
        TOT[tg * 128 + kch] = l[7]; if (tg == 2) TOT[4 * 128 + kch] = l[0]; \
        __syncthreads(); \
        { const float t0 = TOT[kch], t1 = TOT[128 + kch], t2 = TOT[256 + kch], t3 = TOT[384 + kch], g16 = TOT[512 + kch]; \
          const float off = (tg > 0 ? t0 : 0.f) + (tg > 1 ? t1 : 0.f) + (tg > 2 ? t2 : 0.f); \
          const float m = t0 + t1 + g16, blast = (t0 + t1) + (t2 + t3); \
          const float em = __expf(m), elm = __expf(blast - m); \
          bf16_t* pq = P + (tok0 + tg * 8) * 4096 + h_ * 128 + kch; float ko8[8]; \
          _Pragma("unroll") for (int j = 0; j < 8; ++j) { const int t = tg * 8 + j; const float bb = off + l[j]; \
              const float e1 = __expf(bb - m), e2 = __builtin_amdgcn_rcpf(e1); const float qm = qf[j] * e1, km = kf[j] * e2; \
              QM[t * 136 + kch] = f2bf(qm); KM[t * 136 + kch] = f2bf(km); pq[(size_t)j * 4096] = f2bf(qm * em); ko8[j] = km * elm; } \
          { uint4 kt; kt.x = pack2bf(ko8[0], ko8[1]); kt.y = pack2bf(ko8[2], ko8[3]); kt.z = pack2bf(ko8[4], ko8[5]); kt.w = pack2bf(ko8[6], ko8[7]); \
            const int idx = kch * 64 + tg * 16;   \
            *(uint4*)(P + (tok0 + (idx >> 8)) * 4096 + 1024 + h_ * 128 + ((idx & 255) >> 1)) = kt; } \
          if (tg == 0) DLg[(size_t)u_ * 128 + kch] = __expf(blast); } \
        __syncthreads(); \
        if (wid < 4) { \
            const int mi = wid >> 1, ni = wid & 1; f32x4 at = {0.f, 0.f, 0.f, 0.f}; \
            if (ni <= mi) { const bf16_t* KMr = KM + (ni * 16 + fr) * 136 + fq * 8; const bf16_t* QMr = QM + (mi * 16 + fr) * 136 + fq * 8; \
                _Pragma("unroll") for (int ks = 0; ks < 4; ++ks) at = __builtin_amdgcn_mfma_f32_16x16x32_bf16(*(const bf16x8*)(KMr + ks * 32), *(const bf16x8*)(QMr + ks * 32), at, 0, 0, 0); } \
            const int t = mi * 16 + fr, s0 = ni * 16 + fq * 4; \
            at.x = (s0 + 0 <= t) ? at.x : 0.f; at.y = (s0 + 1 <= t) ? at.y : 0.f; at.z = (s0 + 2 <= t) ? at.z : 0.f; at.w = (s0 + 3 <= t) ? at.w : 0.f; \
            uint2 pk; pk.x = pack2bf(at.x, at.y); pk.y = pack2bf(at.z, at.w); \
            *(uint2*)(ATTg + (size_t)u_ * 1024 + t * 32 + s0) = pk; \
        } \
    } while (0)
    for (int u = blockIdx.x; u < 8192; u += 2 * G) { HP_BODY(rawA, u); if (u + G < 8192) HP_BODY(rawB, u + G); }
#undef HP_BODY
}
constexpr int H2_QI = 0, H2_KOT = 8704, H2_VT = 18944, H2_ATT = 20224, H2_DL = 22784, H2_PAR = 23296, H2_ST = 2 * H2_PAR, H2_STSZ = 4352;
struct H2Raw { uint4 qi, ko, v, att; f32x4 dl; };
__device__ __forceinline__ void h2_load(H2Raw& r, const bf16_t* P, const bf16_t* ATTg, const float* DLg, size_t tok0, int u, int h, int vg, int tid) {
    const int row = tid >> 4, seg = tid & 15;
    const bf16_t* pr = P + (tok0 + row) * 4096 + h * 128 + seg * 8;
    r.qi = *(const uint4*)(pr); r.ko = *(const uint4*)(pr + 1024);
    r.v = *(const uint4*)(P + (tok0 + ((tid & 63) >> 1)) * 4096 + 2048 + h * 128 + vg * 16 + (tid & 1) * 8);
    r.att = *(const uint4*)(ATTg + (size_t)u * 1024 + (tid & 127) * 8);
    r.dl = *(const f32x4*)(DLg + (size_t)u * 128 + (tid & 31) * 4);
}
__device__ __forceinline__ void hgrn_chunk_phase(const Params& p, char* smem) {
    bf16_t* P = (bf16_t*)(p.ws + OFF_P);
    const bf16_t* ATTg = (const bf16_t*)(p.ws + OFF_ATTG);
    const float* DLg = (const float*)(p.ws + OFF_DLG);
    const int tid = otid(), lane = tid & 63, wid = __builtin_amdgcn_readfirstlane(tid >> 6), fr = lane & 15, fq = lane >> 4;
    constexpr int NCH = SEQ_T / HCK;
    for (int unit = blockIdx.x; unit < 256; unit += gridDim.x) {
        const int xcd_ = unit & 7, idx_ = unit >> 3;
        const int bh = xcd_ * 4 + (idx_ >> 3), vg = idx_ & 7, b = bh >> 3, h = bh & 7;
        const size_t tokbase = (size_t)b * SEQ_T;
        __syncthreads();
        for (int i = tid; i < H2_STSZ / 4; i += NTHREADS) *(unsigned*)(smem + H2_ST + i * 4) = 0u;
        f32x4 accS = {0.f, 0.f, 0.f, 0.f};
        H2Raw rawA, rawB;
        h2_load(rawA, P, ATTg, DLg, tokbase, bh * 256, h, vg, tid);
        h2_load(rawB, P, ATTg, DLg, tokbase + HCK, bh * 256 + 1, h, vg, tid);
#define H2_BODY(RAW, C) do { \
        const int c_ = (C); char* pb = smem + (c_ & 1) * H2_PAR; \
        { const int row = tid >> 4, seg = tid & 15; \
          *(uint4*)((bf16_t*)(pb + H2_QI) + row * 136 + seg * 8) = RAW.qi; \
            \
          { uint4 kov; kov.x = RAW.ko.x; kov.y = RAW.ko.y; kov.z = RAW.ko.z; kov.w = RAW.ko.w; *(uint4*)((bf16_t*)(pb + H2_KOT) + (tid >> 2) * 40 + (tid & 3) * 8) = kov; } \
          if (tid < 64) { bf16_t* VT = (bf16_t*)(pb + H2_VT) + ((tid & 1) * 8) * 40 + (tid >> 1); \
              VT[0] = (bf16_t)(RAW.v.x & 0xFFFFu); VT[40] = (bf16_t)(RAW.v.x >> 16); VT[80] = (bf16_t)(RAW.v.y & 0xFFFFu); VT[120] = (bf16_t)(RAW.v.y >> 16); \
              VT[160] = (bf16_t)(RAW.v.z & 0xFFFFu); VT[200] = (bf16_t)(RAW.v.z >> 16); VT[240] = (bf16_t)(RAW.v.w & 0xFFFFu); VT[280] = (bf16_t)(RAW.v.w >> 16); } \
          if (tid < 128) *(uint4*)((bf16_t*)(pb + H2_ATT) + (tid >> 2) * 40 + (tid & 3) * 8) = RAW.att; \
          if (tid < 32) *(f32x4*)((float*)(pb + H2_DL) + tid * 4) = RAW.dl; } \
        { const int cn_ = (c_ + 2 < NCH) ? c_ + 2 : NCH - 1; h2_load(RAW, P, ATTg, DLg, tokbase + (size_t)cn_ * HCK, bh * 256 + cn_, h, vg, tid); } \
        __syncthreads(); \
        if (wid >= 4 && wid < 6) { \
            const int mi = wid - 4; f32x4 acco = {0.f, 0.f, 0.f, 0.f}; \
            const bf16_t* STr = (const bf16_t*)(smem + H2_ST + (c_ & 1) * H2_STSZ) + fr * 136 + fq * 8; const bf16_t* QIr = (const bf16_t*)(pb + H2_QI) + (mi * 16 + fr) * 136 + fq * 8; \
            _Pragma("unroll") for (int ks = 0; ks < 4; ++ks) acco = __builtin_amdgcn_mfma_f32_16x16x32_bf16(*(const bf16x8*)(STr + ks * 32), *(const bf16x8*)(QIr + ks * 32), acco, 0, 0, 0); \
            const bf16x8 va = *(const bf16x8*)((const bf16_t*)(pb + H2_VT) + fr * 40 + fq * 8); \
            const bf16x8 ab = *(const bf16x8*)((const bf16_t*)(pb + H2_ATT) + (mi * 16 + fr) * 40 + fq * 8); \
            acco = __builtin_amdgcn_mfma_f32_16x16x32_bf16(va, ab, acco, 0, 0, 0); \
            uint2 po; po.x = pack2bf(acco.x, acco.y); po.y = pack2bf(acco.z, acco.w); \
            *(uint2*)(P + (tokbase + (size_t)c_ * HCK + mi * 16 + fr) * 4096 + 2048 + h * 128 + vg * 16 + fq * 4) = po; \
        } \
        { const f32x4 dl = *(const f32x4*)((const float*)(pb + H2_DL) + wid * 16 + fq * 4); accS = accS * dl; \
          const bf16x8 ka = *(const bf16x8*)((const bf16_t*)(pb + H2_KOT) + (wid * 16 + fr) * 40 + fq * 8); \
          const bf16x8 vb = *(const bf16x8*)((const bf16_t*)(pb + H2_VT) + fr * 40 + fq * 8); \
          accS = __builtin_amdgcn_mfma_f32_16x16x32_bf16(ka, vb, accS, 0, 0, 0); \
          uint2 pk; pk.x = pack2bf(accS.x, accS.y); pk.y = pack2bf(accS.z, accS.w); \
          *(uint2*)((bf16_t*)(smem + H2_ST + ((c_ + 1) & 1) * H2_STSZ) + fr * 136 + wid * 16 + fq * 4) = pk; } \
    } while (0)
        for (int c = 0; c < NCH; c += 2) { H2_BODY(rawA, c); H2_BODY(rawB, c + 1); }
#undef H2_BODY
    }
}

__device__ __forceinline__ void hgrn_post_phase(const Params& p) {
    const bf16_t* P = (const bf16_t*)(p.ws + OFF_P);
    bf16_t* Z = (bf16_t*)(p.ws + OFF_Y);
    const int ch = otid() * 2;
    const float g0 = p.in[17][ch], g1 = p.in[17][ch + 1];
    for (int tok = blockIdx.x; tok < M_TOK; tok += gridDim.x) {
        const unsigned ou = *(const unsigned*)(P + (size_t)tok * 4096 + 2048 + ch);
        const float2 o2 = make_float2(bflo(ou), bfhi(ou));
        const unsigned sg = *(const unsigned*)(P + (size_t)tok * 4096 + 3072 + ch);
        const float ss = wave_sum(o2.x * o2.x + o2.y * o2.y);
        const float rs = rsqrtf(ss * (1.f / 128.f) + 1e-6f);
        *(unsigned*)(Z + (size_t)tok * 1024 + ch) = pack2bf(o2.x * rs * g0 * bflo(sg), o2.y * rs * g1 * bfhi(sg));
    }
}

__device__ __forceinline__ void conv_post_phase(const Params& p) {
    const bf16_t* Yc = (const bf16_t*)(p.ws + OFF_P);
    const bf16_t* U = Yc + (size_t)M_TOK * 1024;
    bf16_t* Z = (bf16_t*)(p.ws + OFF_X);
    const float* cw = p.in[20];
    const int ch = otid() * 2;
    const float w00 = cw[ch], w01 = cw[ch + 1], w10 = cw[1024 + ch], w11 = cw[1025 + ch], w20 = cw[2048 + ch], w21 = cw[2049 + ch];
    for (int tok = blockIdx.x; tok < M_TOK; tok += gridDim.x) {
        const int t = tok & (SEQ_T - 1);
        const unsigned y0 = *(const unsigned*)(Yc + (size_t)tok * 1024 + ch);
        unsigned y1 = 0u, y2 = 0u;
        if (t >= 1) y1 = *(const unsigned*)(Yc + (size_t)(tok - 1) * 1024 + ch);
        if (t >= 2) y2 = *(const unsigned*)(Yc + (size_t)(tok - 2) * 1024 + ch);
        const unsigned u = *(const unsigned*)(U + (size_t)tok * 1024 + ch);
        const float c0 = w00 * bflo(y2) + w10 * bflo(y1) + w20 * bflo(y0);
        const float c1 = w01 * bfhi(y2) + w11 * bfhi(y1) + w21 * bfhi(y0);
        *(unsigned*)(Z + (size_t)tok * 1024 + ch) = pack2bf(bflo(u) * c0, bfhi(u) * c1);
    }
}

constexpr int SG_LS = 136;
__device__ __forceinline__ void gmlp_spatial_phase(const Params& p, char* smem) {
    float* rsA = (float*)smem;
    bf16_t* Aw = (bf16_t*)(smem + 1024);
    bf16_t* VT = Aw + 128 * SG_LS;
    const bf16_t* P = (const bf16_t*)(p.ws + OFF_P);
    const bf16_t* Wsb = (const bf16_t*)(p.ws + OFF_WS_GMLP);
    bf16_t* Z = (bf16_t*)(p.ws + OFF_X);
    const float* vg = p.in[23]; const float* bs = p.in[25];
    const int tid = otid(), lane = tid & 63, wid = tid >> 6, wr = wid >> 1, wc = wid & 1, fr = lane & 15, fq = lane >> 4;
    for (int unit = blockIdx.x; unit < 256; unit += gridDim.x) {
        const size_t tok0 = (size_t)unit * 128;
        __syncthreads();
        for (int i = 0; i < 16; ++i) {
            const int r = wid * 16 + i;
            const bf16_t* vr = P + (tok0 + r) * 3072 + 1024 + lane * 16;
            const uint4 a = *(const uint4*)(vr), b = *(const uint4*)(vr + 8);
            const unsigned w[8] = {a.x, a.y, a.z, a.w, b.x, b.y, b.z, b.w};
            float ss = 0.f;
#pragma unroll
            for (int e = 0; e < 8; ++e) { const float lo = bflo(w[e]), hi = bfhi(w[e]); ss += lo * lo + hi * hi; }
            ss = wave_sum(ss);
            if (lane == 0) rsA[r] = rsqrtf(ss * (1.f / 1024.f) + 1e-6f);
        }
        __syncthreads();
        for (int g = 0; g < 8; ++g) {
#pragma unroll
            for (int i = 0; i < 4; ++i) {
                const int idx = tid + i * 512, row = idx >> 4, c16 = idx & 15;
                *(uint4*)(Aw + row * SG_LS + c16 * 8) = *(const uint4*)(Wsb + (size_t)g * 16384 + row * 128 + c16 * 8);
            }
            {
                const int s = tid >> 2, cp = tid & 3;
                const float rs = rsA[s];
                const bf16_t* vr = P + (tok0 + s) * 3072 + 1024 + g * 128 + cp * 32;
#pragma unroll
                for (int i = 0; i < 4; ++i) {
                    const uint4 a = *(const uint4*)(vr + i * 8);
                    const unsigned w[4] = {a.x, a.y, a.z, a.w};
#pragma unroll
                    for (int e = 0; e < 4; ++e) {
                        const int c = cp * 32 + i * 8 + e * 2;
                        const float g0 = vg[g * 128 + c], g1 = vg[g * 128 + c + 1];
                        VT[c * SG_LS + s] = f2bf(bflo(w[e]) * rs * g0);
                        VT[(c + 1) * SG_LS + s] = f2bf(bfhi(w[e]) * rs * g1);
                    }
                }
            }
            __syncthreads();
            f32x4 acc[2][4];
#pragma unroll
            for (int i = 0; i < 2; ++i)
#pragma unroll
                for (int j = 0; j < 4; ++j) acc[i][j] = (f32x4){0.f, 0.f, 0.f, 0.f};
#pragma unroll
            for (int ks = 0; ks < 4; ++ks) {
                bf16x8 af[2], bfr[4];
#pragma unroll
                for (int i = 0; i < 2; ++i) af[i] = *(const bf16x8*)(Aw + (wr * 32 + i * 16 + fr) * SG_LS + ks * 32 + fq * 8);
#pragma unroll
                for (int i = 0; i < 4; ++i) bfr[i] = *(const bf16x8*)(VT + (wc * 64 + i * 16 + fr) * SG_LS + ks * 32 + fq * 8);
#pragma unroll
                for (int mi = 0; mi < 2; ++mi)
#pragma unroll
                    for (int ni = 0; ni < 4; ++ni) acc[mi][ni] = __builtin_amdgcn_mfma_f32_16x16x32_bf16(bfr[ni], af[mi], acc[mi][ni], 0, 0, 0);
            }
#pragma unroll
            for (int mi = 0; mi < 2; ++mi) {
                const int t = wr * 32 + mi * 16 + fr;
                const float bias = bs[g * 128 + t];
                const bf16_t* pr = P + (tok0 + t) * 3072;
#pragma unroll
                for (int ni = 0; ni < 4; ++ni) {
                    const int c = g * 128 + wc * 64 + ni * 16 + fq * 4;
                    const uint2 uu = *(const uint2*)(pr + c), sg = *(const uint2*)(pr + 2048 + c);
                    const f32x4 a = acc[mi][ni];
                    uint2 pk;
                    pk.x = pack2bf(bflo(uu.x) * (a.x + bias) * bflo(sg.x), bfhi(uu.x) * (a.y + bias) * bfhi(sg.x));
                    pk.y = pack2bf(bflo(uu.y) * (a.z + bias) * bflo(sg.y), bfhi(uu.y) * (a.w + bias) * bfhi(sg.y));
                    *(uint2*)(Z + (tok0 + t) * 1024 + c) = pk;
                }
            }
            __syncthreads();
        }
    }
}


#define XB_TMO      128
#define XB_XCNT(j)  (256  + 64 * (j))
#define XB_XSUB(j)  (1280 + 64 * (j))
#define XB_XGEN(j)  (2304 + 64 * (j))
#define XB_TOP      3328
#define XB_TOPGEN   3392
#define XCD_BAR_WORDS 3456
#define XB_SPIN_CAP (1u << 20)
#define XLAS __attribute__((address_space(3)))
__device__ __forceinline__ unsigned xb_ld(unsigned* p)              { return __hip_atomic_load(p, __ATOMIC_RELAXED, __HIP_MEMORY_SCOPE_AGENT); }
__device__ __forceinline__ unsigned xb_add(unsigned* p, unsigned v) { return __hip_atomic_fetch_add(p, v, __ATOMIC_RELAXED, __HIP_MEMORY_SCOPE_AGENT); }
__device__ __forceinline__ unsigned xb_xcc_id() { return (unsigned)__builtin_amdgcn_s_getreg((3 << 11) | 20) & 0xFu; }
#define XB_SPIN(cond, bar) do { unsigned _sp = 0; while (cond) { __builtin_amdgcn_s_sleep(1); \
    if ((++_sp & 255u) == 0u) { if (xb_ld(&(bar)[XB_TMO])) break; if (_sp > XB_SPIN_CAP) { atomicAdd(&(bar)[XB_TMO], 1u); break; } } } } while (0)
struct XcdBarrier { unsigned* bar; unsigned x; volatile XLAS unsigned* st; };
__device__ __forceinline__ XcdBarrier xcd_barrier_post(unsigned* bar, volatile XLAS unsigned* st) {
    XcdBarrier b; b.bar = bar; b.x = xb_xcc_id(); b.st = st;
    if (otid() == 0) (void)xb_add(&bar[XB_XCNT(b.x)], 1u);
    return b;
}
__device__ __forceinline__ void xcd_barrier_complete(unsigned* bar, unsigned x, unsigned& nloc, unsigned& nx) {
    const unsigned G = gridDim.x * gridDim.y * gridDim.z;
    unsigned sum, cnt, mine, sp = 0u;
    for (;;) {
        sum = 0u; cnt = 0u; mine = 0u;
#pragma unroll
        for (unsigned j = 0; j < 16; ++j) { const unsigned c = xb_ld(&bar[XB_XCNT(j)]); sum += c; cnt += (c > 0u) ? 1u : 0u; mine = (j == x) ? c : mine; }
        if (sum == G) break;
        __builtin_amdgcn_s_sleep(1);
        if ((++sp & 255u) == 0u) { if (xb_ld(&bar[XB_TMO])) break; if (sp > XB_SPIN_CAP) { atomicAdd(&bar[XB_TMO], 1u); break; } }
    }
    nloc = mine > 0u ? mine : 1u; nx = cnt > 0u ? cnt : 1u;
}
__device__ __forceinline__ void xcd_barrier(const XcdBarrier& b) {
    asm volatile("s_waitcnt vmcnt(0)" ::: "memory");
    __syncthreads();
    if (otid() == 0) {
        unsigned* bar = b.bar;
        __builtin_amdgcn_s_waitcnt(0);
        unsigned nloc = b.st[0], nx = b.st[1];
        if (nloc == 0u) { xcd_barrier_complete(bar, b.x, nloc, nx); b.st[0] = nloc; b.st[1] = nx; }
        const unsigned old = xb_add(&bar[XB_XSUB(b.x)], 1u);
        const unsigned gen = old / nloc;
        if (old + 1u == (gen + 1u) * nloc) {
            __builtin_amdgcn_fence(__ATOMIC_RELEASE, "agent");
            asm volatile("s_waitcnt vmcnt(0)" ::: "memory");
            const unsigned og = xb_add(&bar[XB_TOP], 1u);
            const unsigned tg = og / nx;
            if (og + 1u == (tg + 1u) * nx) xb_add(&bar[XB_TOPGEN], 1u);
            else XB_SPIN(xb_ld(&bar[XB_TOPGEN]) == tg, bar);
            __builtin_amdgcn_fence(__ATOMIC_ACQUIRE, "agent");
            xb_add(&bar[XB_XGEN(b.x)], 1u);
            asm volatile("s_waitcnt vmcnt(0)" ::: "memory");
        } else {
            XB_SPIN(xb_ld(&bar[XB_XGEN(b.x)]) == gen, bar);
            __builtin_amdgcn_fence(__ATOMIC_ACQUIRE, "agent");
            asm volatile("s_waitcnt vmcnt(0)" ::: "memory");
        }
    }
    __syncthreads();
}

__global__ void __launch_bounds__(NTHREADS) fwd_megakernel(Params p) {
    extern __shared__ __attribute__((aligned(16))) char smem[];
    cg::grid_group grid = cg::this_grid();
    unsigned char* ws = p.ws;
    bf16_t* HN = (bf16_t*)(ws + OFF_X);
    bf16_t* Pb = (bf16_t*)(ws + OFF_P);
    bf16_t* Zx = (bf16_t*)(ws + OFF_X);
    bf16_t* Zy = (bf16_t*)(ws + OFF_Y);
    bf16_t* Lin = (bf16_t*)(ws + OFF_LIN);
    const float* ng = p.in[1];
    volatile XLAS unsigned* xst = (volatile XLAS unsigned*)(smem + LDS_STAGE);
    if (threadIdx.x == 0) { xst[0] = 0u; xst[1] = 0u; }
    __syncthreads();
    const XcdBarrier xbar = xcd_barrier_post((unsigned*)(ws + OFF_BAR), xst);

    phase_weights(p, smem);
    rmsnorm_phase<true>(p.in[0], ng, HN);
    xcd_barrier(xbar);
    if (p.out == nullptr) grid.sync();
    for (int rep = 0; rep < REP_GEMM; ++rep) {
    pg8::run(smem, HN, (const bf16_t*)(ws + OFF_WT_RWKV_IN), 4352, pg8::EStoreBf16{Pb, RW_COLS, RW_COLS});
    xcd_barrier(xbar); }
    rwkv_lin_phase(Pb, p.in[4], Lin);
    xcd_barrier(xbar);
    gemm_phase(Lin, 128, (const bf16_t*)(ws + OFF_WT_W2), 64, 1024, 64, EpiLoraW{p.in[5], (float*)(ws + OFF_X)}, smem);
    gemm_phase(Lin + 64, 128, (const bf16_t*)(ws + OFF_WT_A2), 64, 1024, 64, EpiLoraA{p.in[7], (unsigned short*)(ws + OFF_Y)}, smem);
    xcd_barrier(xbar);
    for (int rep = 0; rep < REP_RSCAN; ++rep) {
    rwkv_elem_phase(p);
    xcd_barrier(xbar);
    rwkv_chunk2_phase(p, smem);
    xcd_barrier(xbar); }
    for (int rep = 0; rep < REP_MISC; ++rep) {
    rwkv_post2_phase(p);
    xcd_barrier(xbar); }
    pg8::run(smem, Zx, (const bf16_t*)(ws + OFF_WT_RWKV_OUT), 1024, pg8::EResid{p.in[0], p.out});
    xcd_barrier(xbar);
    rmsnorm_phase<true>(p.out, ng + 1024, HN);
    xcd_barrier(xbar);
    for (int rep = 0; rep < REP_GEMM; ++rep) {
    pg8::run(smem, HN, (const bf16_t*)(ws + OFF_WT_HGRN_IN), 4096, pg8::EHgrn{Pb, (const float*)(ws + OFF_LB)});
    xcd_barrier(xbar); }
    for (int rep = 0; rep < REP_HSCAN; ++rep) {
    hgrn_prep_phase(p, smem);
    xcd_barrier(xbar);
    hgrn_chunk_phase(p, smem);
    xcd_barrier(xbar); }
    for (int rep = 0; rep < REP_MISC; ++rep) {
    hgrn_post_phase(p);
    xcd_barrier(xbar); }
    pg8::run(smem, Zy, (const bf16_t*)(ws + OFF_WT_HGRN_OUT), 1024, pg8::EResid{p.out, p.out});
    xcd_barrier(xbar);
    rmsnorm_phase<true>(p.out, ng + 2048, HN);
    xcd_barrier(xbar);
    for (int rep = 0; rep < REP_GEMM; ++rep) {
    pg8::run(smem, HN, (const bf16_t*)(ws + OFF_WT_CONV_IN), 4096, pg8::EConv{Pb, Pb + (size_t)M_TOK * 1024});
    xcd_barrier(xbar); }
    for (int rep = 0; rep < REP_MISC; ++rep) {
    conv_post_phase(p);
    xcd_barrier(xbar); }
    pg8::run(smem, Zx, (const bf16_t*)(ws + OFF_WT_CONV_OUT), 1024, pg8::EResid{p.out, p.out});
    xcd_barrier(xbar);
    rmsnorm_phase<true>(p.out, ng + 3072, HN);
    xcd_barrier(xbar);
    for (int rep = 0; rep < REP_GEMM; ++rep) {
    pg8::run(smem, HN, (const bf16_t*)(ws + OFF_WT_GMLP_IN), 3072, pg8::EGmlp{Pb});
    xcd_barrier(xbar); }
    for (int rep = 0; rep < REP_MISC; ++rep) {
    gmlp_spatial_phase(p, smem);
    xcd_barrier(xbar); }
    pg8::run(smem, Zx, (const bf16_t*)(ws + OFF_WT_GMLP_OUT), 1024, pg8::EResid{p.out, p.out});
    xcd_barrier(xbar);
    rmsnorm_phase<false>(p.out, p.in[2], p.out);
}

extern "C" void kernel_launch(void* const* d_in, const int* in_sizes, int n_in, void* d_out, int out_size, void* d_ws, size_t ws_size, hipStream_t stream) {
    static int grid = 0;
    if (grid == 0) {
        if (n_in != 27 || out_size != M_TOK * DM || ws_size < WS_END) {
            fprintf(stderr, "kernel_launch: unexpected problem (n_in %d, out %d, ws %zu, need %zu)\n", n_in, out_size, ws_size, (size_t)WS_END);
            grid = -1; return;
        }
        int dev = 0, cus = 0, per_cu = 0;
        hipGetDevice(&dev);
        hipDeviceGetAttribute(&cus, hipDeviceAttributeMultiprocessorCount, dev);
        if (hipFuncSetAttribute((const void*)fwd_megakernel, hipFuncAttributeMaxDynamicSharedMemorySize, LDS_BYTES) != hipSuccess) {
            fprintf(stderr, "kernel_launch: hipFuncSetAttribute failed\n"); grid = -1; return;
        }
        hipOccupancyMaxActiveBlocksPerMultiprocessor(&per_cu, (const void*)fwd_megakernel, NTHREADS, LDS_BYTES);
        if (per_cu < 1) { fprintf(stderr, "kernel_launch: occupancy query says %d blocks per CU\n", per_cu); per_cu = 1; }
        (void)hipGetLastError();
        grid = cus;
    }
    if (grid < 0) return;
    Params p{};
    for (int i = 0; i < 27; ++i) p.in[i] = (const float*)d_in[i];
    p.out = (float*)d_out; p.ws = (unsigned char*)d_ws;
    (void)hipMemsetAsync((unsigned char*)d_ws + OFF_BAR, 0, XCD_BAR_WORDS * 4, stream);
    void* args[] = {&p};
    hipError_t e = hipLaunchCooperativeKernel((const void*)fwd_megakernel, dim3(grid), dim3(NTHREADS), args, LDS_BYTES, stream);
    if (e != hipSuccess) fprintf(stderr, "cooperative launch failed: %s (grid %d)\n", hipGetErrorString(e), grid);
}
```
